# Optimizing an MI355X kernel written in HIP

```python
import math
import jax, jax.numpy as jnp
from jax import lax
import numpy as np

D_MODEL = 2048
BATCH = 8
SEQ = 4096
DEPTH = 4

CHUNK = 64
N_MIXERS = 3
HEAD_DIM = 128
MIX_WIDTH = (3 * D_MODEL) // 4
MIX_HEADS = MIX_WIDTH // HEAD_DIM
MEM_WIDTH = D_MODEL // 4
MEM_HEADS = MEM_WIDTH // HEAD_DIM
BRANCH_WIDTH = MIX_WIDTH + MEM_WIDTH
N_MEM = 256
GMLP_GROUP = 128
Q_BLOCK = 128
DIFF_HEAD_DIM = HEAD_DIM // 2
REL_BUCKETS = 32
REL_MAX_DIST = 128
EPS = 1e-6
NEG = -1e30
A_IN = 2 * MIX_WIDTH + MEM_WIDTH + BRANCH_WIDTH
B_IN = 3 * MIX_WIDTH + MIX_HEADS + MEM_WIDTH + BRANCH_WIDTH
C_IN = 3 * MIX_WIDTH + MEM_WIDTH + BRANCH_WIDTH
N_A = (DEPTH + 2) // 3
N_B = (DEPTH + 1) // 3
N_C = DEPTH // 3

kernel_name = 'hybrid_gmlp_fox_diffattn_memory_trunk'


def rms_norm(x, g):
    xf = x.astype(jnp.float32)
    y = xf * lax.rsqrt(jnp.mean(xf * xf, axis=-1, keepdims=True) + EPS)
    return (y * g.astype(jnp.float32)).astype(x.dtype)


def layer_norm(x, g, b):
    xf = x.astype(jnp.float32)
    mu = jnp.mean(xf, axis=-1, keepdims=True)
    var = jnp.mean(jnp.square(xf - mu), axis=-1, keepdims=True)
    y = (xf - mu) * lax.rsqrt(var + EPS) * g.astype(jnp.float32) + b.astype(jnp.float32)
    return y.astype(x.dtype)


def t5_bucket(rel):
    nb = REL_BUCKETS // 2
    max_exact = nb // 2
    ret = jnp.where(rel > 0, nb, 0)
    n = jnp.abs(rel)
    nf = jnp.maximum(n, 1).astype(jnp.float32)
    large = max_exact + (jnp.log(nf / max_exact) / math.log(REL_MAX_DIST / max_exact)
                         * (nb - max_exact)).astype(jnp.int32)
    large = jnp.minimum(large, nb - 1)
    return ret + jnp.where(n < max_exact, n, large)


def gmlp_spatial_gating(z, ln_g, ln_b, w_s, b_s):
    u, v = jnp.split(z, 2, axis=-1)
    v = layer_norm(v, ln_g, ln_b)
    B, S, _ = v.shape
    v = v.reshape(B, S // GMLP_GROUP, GMLP_GROUP, MIX_HEADS, HEAD_DIM)
    chunk_id = jnp.arange(GMLP_GROUP) // CHUNK
    mask = chunk_id[:, None] >= chunk_id[None, :]
    w = jnp.where(mask[None], w_s, jnp.zeros((), w_s.dtype))
    sv = jnp.einsum('gts,bnsgc->bntgc', w, v) + b_s.T[None, None, :, :, None]
    return u * sv.reshape(B, S, MIX_WIDTH)


def forgetting_attention(q, k, v, f_logit):
    B, S, H, D = q.shape
    c = jnp.cumsum(jax.nn.log_sigmoid(f_logit.astype(jnp.float32)), axis=1).transpose(0, 2, 1)
    scale = D ** -0.5
    outs = []
    for blk in range(S // Q_BLOCK):
        q0, q1 = blk * Q_BLOCK, (blk + 1) * Q_BLOCK
        logits = jnp.einsum('bqhd,bkhd->bhqk', q[:, q0:q1], k[:, :q1]).astype(jnp.float32) * scale
        logits = logits + c[:, :, q0:q1, None] - c[:, :, None, :q1]
        qpos = jnp.arange(q0, q1)
        kpos = jnp.arange(q1)
        logits = jnp.where(kpos[None, :] <= qpos[:, None], logits, NEG)
        p = jax.nn.softmax(logits, axis=-1).astype(v.dtype)
        outs.append(jnp.einsum('bhqk,bkhd->bqhd', p, v[:, :q1]))
    return jnp.concatenate(outs, axis=1).reshape(B, S, H * D)


def differential_attention(q, k, v, rel_bias, lam, subln_g, lam_init):
    B, S, H, _, Dd = q.shape
    lamf = lam.astype(jnp.float32)
    lam_val = (jnp.exp(jnp.sum(lamf[0] * lamf[1])) - jnp.exp(jnp.sum(lamf[2] * lamf[3])) + lam_init)
    table = rel_bias.astype(jnp.float32)
    scale = Dd ** -0.5
    outs = []
    for blk in range(S // Q_BLOCK):
        q0, q1 = blk * Q_BLOCK, (blk + 1) * Q_BLOCK
        qpos = jnp.arange(q0, q1)
        kpos = jnp.arange(q1)
        bias = table[t5_bucket(kpos[None, :] - qpos[:, None])].transpose(2, 0, 1)
        logits = jnp.einsum('bqhmd,bkhmd->bhmqk', q[:, q0:q1], k[:, :q1]).astype(jnp.float32) * scale
        logits = logits + bias[None, :, None]
        mask = (kpos[None, :] // CHUNK) <= (qpos[:, None] // CHUNK)
        p = jax.nn.softmax(jnp.where(mask, logits, NEG), axis=-1)
        a = (p[:, :, 0] - lam_val * p[:, :, 1]).astype(v.dtype)
        outs.append(jnp.einsum('bhqk,bkhe->bqhe', a, v[:, :q1]))
    o = jnp.concatenate(outs, axis=1)
    o = rms_norm(o, subln_g) * (1.0 - lam_init)
    return o.reshape(B, S, H * 2 * Dd)


def memory_attention(q, mem_k, mem_v):
    B, S = q.shape[:2]
    logits = jnp.einsum('bshd,bmhd->bhsm', q, mem_k).astype(jnp.float32) * (HEAD_DIM ** -0.5)
    p = jax.nn.softmax(logits, axis=-1).astype(mem_v.dtype)
    return jnp.einsum('bhsm,bmhd->bshd', p, mem_v).reshape(B, S, MEM_WIDTH)


def setup_inputs(seed: int = 0) -> dict:
    key = jax.random.key(seed)
    it = iter(jax.random.split(key, 32))
    nrm = lambda shape, s: s * jax.random.normal(next(it), shape, jnp.float32)
    gain = lambda shape: 1.0 + 0.05 * jax.random.normal(next(it), shape, jnp.float32)
    din = D_MODEL ** -0.5
    return {
        'x': nrm((BATCH, SEQ, D_MODEL), 1.0),
        'mem': nrm((BATCH, N_MEM, D_MODEL), 1.0),
        'mem_norm_g': gain((D_MODEL,)),
        'rel_bias': nrm((REL_BUCKETS, MIX_HEADS), 0.5),
        'norm_g': gain((DEPTH, D_MODEL)),
        'w_mem_kv': nrm((DEPTH, D_MODEL, 2 * MEM_WIDTH), din),
        'mem_q_norm_g': gain((DEPTH, HEAD_DIM)),
        'mem_k_norm_g': gain((DEPTH, HEAD_DIM)),
        'w_out': nrm((DEPTH, BRANCH_WIDTH, D_MODEL), 0.5 * BRANCH_WIDTH ** -0.5),
        'a_w_in': nrm((N_A, D_MODEL, A_IN), din),
        'a_ln_g': gain((N_A, MIX_WIDTH)),
        'a_ln_b': nrm((N_A, MIX_WIDTH), 0.02),
        'a_w_s': nrm((N_A, MIX_HEADS, GMLP_GROUP, GMLP_GROUP), GMLP_GROUP ** -0.5),
        'a_b_s': 1.0 + nrm((N_A, MIX_HEADS, GMLP_GROUP), 0.1),
        'b_w_in': nrm((N_B, D_MODEL, B_IN), din),
        'b_b_f': jax.random.uniform(next(it), (N_B, MIX_HEADS), jnp.float32, 1.0, 4.0),
        'b_q_norm_g': gain((N_B, HEAD_DIM)),
        'b_k_norm_g': gain((N_B, HEAD_DIM)),
        'c_w_in': nrm((N_C, D_MODEL, C_IN), din),
        'c_q_norm_g': gain((N_C, DIFF_HEAD_DIM)),
        'c_k_norm_g': gain((N_C, DIFF_HEAD_DIM)),
        'c_lam': nrm((N_C, 4, DIFF_HEAD_DIM), 0.1),
        'c_subln_g': gain((N_C, 2 * DIFF_HEAD_DIM)),
    }


def reference(x, mem, mem_norm_g, rel_bias, norm_g, w_mem_kv, mem_q_norm_g, mem_k_norm_g, w_out,
              a_w_in, a_ln_g, a_ln_b, a_w_s, a_b_s,
              b_w_in, b_b_f, b_q_norm_g, b_k_norm_g,
              c_w_in, c_q_norm_g, c_k_norm_g, c_lam, c_subln_g):
    B, S, _ = x.shape
    mem_n = rms_norm(mem, mem_norm_g)
    for i in range(DEPTH):
        kind, j = i % N_MIXERS, i // N_MIXERS
        h = rms_norm(x, norm_g[i])
        w_in = (a_w_in, b_w_in, c_w_in)[kind][j]
        z = h @ w_in
        n_mix = z.shape[-1] - MEM_WIDTH - BRANCH_WIDTH
        mix_in = z[..., :n_mix]
        mem_q = z[..., n_mix:n_mix + MEM_WIDTH]
        gate = z[..., n_mix + MEM_WIDTH:]
        if kind == 0:
            mix_out = gmlp_spatial_gating(jax.nn.gelu(mix_in), a_ln_g[j], a_ln_b[j], a_w_s[j], a_b_s[j])
        elif kind == 1:
            q = rms_norm(mix_in[..., :MIX_WIDTH].reshape(B, S, MIX_HEADS, HEAD_DIM), b_q_norm_g[j])
            k = rms_norm(mix_in[..., MIX_WIDTH:2 * MIX_WIDTH].reshape(B, S, MIX_HEADS, HEAD_DIM), b_k_norm_g[j])
            v = mix_in[..., 2 * MIX_WIDTH:3 * MIX_WIDTH].reshape(B, S, MIX_HEADS, HEAD_DIM)
            f_logit = mix_in[..., 3 * MIX_WIDTH:] + b_b_f[j]
            mix_out = forgetting_attention(q, k, v, f_logit)
        else:
            q = rms_norm(mix_in[..., :MIX_WIDTH].reshape(B, S, MIX_HEADS, 2, DIFF_HEAD_DIM), c_q_norm_g[j])
            k = rms_norm(mix_in[..., MIX_WIDTH:2 * MIX_WIDTH].reshape(B, S, MIX_HEADS, 2, DIFF_HEAD_DIM), c_k_norm_g[j])
            v = mix_in[..., 2 * MIX_WIDTH:].reshape(B, S, MIX_HEADS, 2 * DIFF_HEAD_DIM)
            lam_init = 0.8 - 0.6 * math.exp(-0.3 * i)
            mix_out = differential_attention(q, k, v, rel_bias, c_lam[j], c_subln_g[j], lam_init)
        kv = mem_n @ w_mem_kv[i]
        mk = rms_norm(kv[..., :MEM_WIDTH].reshape(B, N_MEM, MEM_HEADS, HEAD_DIM), mem_k_norm_g[i])
        mv = kv[..., MEM_WIDTH:].reshape(B, N_MEM, MEM_HEADS, HEAD_DIM)
        mq = rms_norm(mem_q.reshape(B, S, MEM_HEADS, HEAD_DIM), mem_q_norm_g[i])
        mem_out = memory_attention(mq, mk, mv)
        branch = jnp.concatenate([mix_out, mem_out], axis=-1) * jax.nn.silu(gate)
        x = x + branch @ w_out[i]
    return x
```

```cpp
#include <hip/hip_runtime.h>
#include <hip/hip_cooperative_groups.h>
#include <cstdio>
#include <cstdint>
namespace cg = cooperative_groups;
namespace pg8 {
#define PG8_LAS __attribute__((address_space(3)))
typedef unsigned short bf16_t;
typedef short bf16x8 __attribute__((ext_vector_type(8)));
typedef float f32x4 __attribute__((ext_vector_type(4)));
typedef unsigned u32x4 __attribute__((ext_vector_type(4)));
constexpr int BM = 256, BK = 64, HALF = 128, HTB = HALF * BK * 2  , STAGE_BYTES = 8 * HTB, NXCD = 8, WGM = 8;

__host__ __device__ __forceinline__ int lds_byte(int r, int c) { const int st = (r >> 4) * 2 + (c >> 5), rr = r & 15, cc = c & 31, ob = rr * 64 + cc * 2; return st * 1024 + (ob ^ (((ob >> 9) & 1) << 5)); }
__host__ __device__ __forceinline__ void stage_rc(int b, int& R, int& C) { const int st = b / 1024, sb = b % 1024, swz = sb ^ (((sb >> 9) & 1) << 5); R = (st >> 1) * 16 + swz / 64; C = (st & 1) * 32 + (swz % 64) / 2; }
__host__ __device__ __forceinline__ int perm32(int rho) { const int n = rho >> 4, i = rho & 15; return 8 * (i >> 2) + 4 * n + (i & 3); }

struct Unit { int pm, pn; };
struct Gemm { const bf16_t* A; const bf16_t* Bt; int M, N, K; };

struct StaticOrder {
    int nM, nN, nwg, G, c;
    __host__ __device__ void init(int M, int N, int G_, int c_) { nM = M / BM; nN = N / BM; nwg = nM * nN; G = G_; c = c_; }
    __host__ __device__ bool next(int i, Unit& u) const {
        const long L = (long)i * G + c; if (L >= nwg) return false;
        int wgid = (int)L; { const int q = nwg / NXCD, r = nwg % NXCD, xcd = wgid % NXCD, off = wgid / NXCD; wgid = (xcd < r ? xcd * (q + 1) : r * (q + 1) + (xcd - r) * q) + off; }
        const int nig = WGM * nN, gid = wgid / nig, fm = gid * WGM, gsz = (nM - fm) < WGM ? (nM - fm) : WGM;
        u.pm = fm + ((wgid % nig) % gsz); u.pn = (wgid % nig) / gsz; return true;
    }
    __device__ __forceinline__ void a_ready(const Unit&) const {}
    __device__ __forceinline__ void done(const Unit&) const {}
};
__device__ __forceinline__ unsigned cvt_pk_bf16(float lo, float hi) { unsigned r; asm volatile("v_cvt_pk_bf16_f32 %0, %1, %2" : "=v"(r) : "v"(lo), "v"(hi)); return r; }
template <class Epi, class Sched, bool ALIGN_EPI = false, bool SP2 = false>
__device__ __forceinline__ void gemm_phase(PG8_LAS unsigned char* lds, const Gemm g, const Sched& S, const Epi& E, const int tid) {
    const int wid = __builtin_amdgcn_readfirstlane(tid >> 6), lane = tid & 63, wr = wid >> 2, wc = wid & 3, fr = lane & 15, fq = lane >> 4;
    const int K = g.K, nt = K / BK;
    unsigned voffA[2], voffB[2];
#pragma unroll
    for (int i = 0; i < 2; ++i) { int R, C; stage_rc(tid * 16 + i * 8192, R, C); const int Rb = Epi::PERM ? ((R & ~31) + perm32(R & 31)) : R;
        voffA[i] = (unsigned)(R * K + C) * 2u; voffB[i] = (unsigned)(Rb * K + C) * 2u; }
    const size_t kstep = (size_t)(BK * 2);
    const size_t hstep = (size_t)HALF * K * 2;
    const size_t tstep = 2 * hstep;
    const unsigned ldsw = (unsigned)wid * 1024u;
    const int aoff = lds_byte(wr * 64 + fr, fq * 8), boff = lds_byte(wc * 32 + fr, fq * 8);
#define PG8_SA(b, h) (((b) * 2 + (h)) * HTB)
#define PG8_SB(b, h) ((4 + (b) * 2 + (h)) * HTB)
#define PG8_STAGE(bufoff, gbase, voff) do { _Pragma("unroll") for (int _i = 0; _i < 2; ++_i) \
        __builtin_amdgcn_global_load_lds((const unsigned*)((const char*)(gbase) + (voff)[_i]), (PG8_LAS unsigned*)(lds + (bufoff) + ldsw + _i * 8192), 16, 0, 0); } while (0)
#define PG8_LDA(dst, b, h) do { _Pragma("unroll") for (int m = 0; m < 4; ++m) _Pragma("unroll") for (int k = 0; k < 2; ++k) dst[m][k] = *(const PG8_LAS bf16x8*)(lds + PG8_SA(b, h) + aoff + m * 2048 + k * 1024); } while (0)
#define PG8_LDB(dst, b, h) do { _Pragma("unroll") for (int n = 0; n < 2; ++n) _Pragma("unroll") for (int k = 0; k < 2; ++k) dst[n][k] = *(const PG8_LAS bf16x8*)(lds + PG8_SB(b, h) + boff + n * 2048 + k * 1024); } while (0)
#define PG8_MMA(ai, bj, At, Bt) do { __builtin_amdgcn_s_setprio(1); _Pragma("unroll") for (int m = 0; m < 4; ++m) _Pragma("unroll") for (int n = 0; n < 2; ++n) _Pragma("unroll") for (int k = 0; k < 2; ++k) \
        acc[ai][bj][m][n] = __builtin_amdgcn_mfma_f32_16x16x32_bf16(Bt[n][k], At[m][k], acc[ai][bj][m][n], 0, 0, 0); __builtin_amdgcn_s_setprio(0); } while (0)
#define PG8_WAIT_V(n) asm volatile("s_waitcnt vmcnt(" #n ")" ::: "memory")
#define PG8_WAIT_L(n) asm volatile("s_waitcnt lgkmcnt(" #n ")" ::: "memory")
#define PG8_BAR __builtin_amdgcn_s_barrier()
#define PG8_SCHED __builtin_amdgcn_sched_barrier(0)
    Unit cur, nxt; int ui = 0;
    if (!S.next(0, cur)) return;
    f32x4 acc[2][2][4][2];
#pragma unroll
    for (int a = 0; a < 2; ++a)
#pragma unroll
        for (int b = 0; b < 2; ++b)
#pragma unroll
            for (int m = 0; m < 4; ++m)
#pragma unroll
                for (int n = 0; n < 2; ++n) acc[a][b][m][n] = (f32x4){0.f, 0.f, 0.f, 0.f};
    bf16x8 At[4][2], B0[2][2], B1[2][2];
    const char* cA = (const char*)g.A + (size_t)cur.pm * tstep; const char* cB = (const char*)g.Bt + (size_t)cur.pn * tstep;
    S.a_ready(cur);
    if constexpr (SP2) {
        PG8_STAGE(PG8_SB(0, 0), cB, voffB); PG8_STAGE(PG8_SB(0, 1), cB + hstep, voffB); PG8_STAGE(PG8_SA(0, 0), cA, voffA); PG8_STAGE(PG8_SA(0, 1), cA + hstep, voffA);
        if (wr == 1) PG8_BAR;
        PG8_WAIT_V(2); PG8_BAR;
        PG8_STAGE(PG8_SB(1, 0), cB + kstep, voffB); PG8_STAGE(PG8_SA(1, 0), cA + kstep, voffA); PG8_STAGE(PG8_SB(1, 1), cB + hstep + kstep, voffB);
        PG8_WAIT_V(6); PG8_BAR;
    } else {
        PG8_STAGE(PG8_SB(0, 0), cB, voffB); PG8_STAGE(PG8_SA(0, 0), cA, voffA); PG8_STAGE(PG8_SB(0, 1), cB + hstep, voffB); PG8_STAGE(PG8_SA(0, 1), cA + hstep, voffA);
        if (wr == 1) PG8_BAR;
        PG8_WAIT_V(4); PG8_BAR;
        PG8_STAGE(PG8_SB(1, 0), cB + kstep, voffB); PG8_STAGE(PG8_SA(1, 0), cA + kstep, voffA); PG8_STAGE(PG8_SB(1, 1), cB + hstep + kstep, voffB);
        PG8_WAIT_V(6); PG8_BAR;
    }
    for (;;) {
        const bool has_next = S.next(ui + 1, nxt);
        const char* nA = has_next ? (const char*)g.A + (size_t)nxt.pm * tstep : cA; const char* nB = has_next ? (const char*)g.Bt + (size_t)nxt.pn * tstep : cB;
        for (int t = 0; t < nt; t += 2) {
            const bool last = (t == nt - 2);
            const char* a1 = cA + (size_t)(t + 1) * kstep;
            const char* a2 = last ? nA : cA + (size_t)(t + 2) * kstep; const char* b2 = last ? nB : cB + (size_t)(t + 2) * kstep;
            const char* a3 = a2 + kstep; const char* b3 = b2 + kstep;
            if (last && has_next) S.a_ready(nxt);
            if constexpr (SP2) {
            PG8_LDB(B0, 0, 0); PG8_LDB(B1, 0, 1); PG8_SCHED; PG8_LDA(At, 0, 0); PG8_STAGE(PG8_SA(1, 1), a1 + hstep, voffA);
            PG8_WAIT_V(8); PG8_WAIT_L(0); PG8_BAR; PG8_MMA(0, 0, At, B0); PG8_MMA(0, 1, At, B1); PG8_BAR; PG8_SCHED;
            PG8_LDA(At, 0, 1); PG8_STAGE(PG8_SB(0, 0), b2, voffB); PG8_STAGE(PG8_SB(0, 1), b2 + hstep, voffB); PG8_STAGE(PG8_SA(0, 0), a2, voffA);
            PG8_WAIT_V(8); PG8_WAIT_L(0); PG8_BAR; PG8_MMA(1, 0, At, B0); PG8_MMA(1, 1, At, B1); PG8_BAR; PG8_SCHED;
            PG8_LDB(B0, 1, 0); PG8_LDB(B1, 1, 1); PG8_SCHED; PG8_LDA(At, 1, 0); PG8_STAGE(PG8_SA(0, 1), a2 + hstep, voffA);
            PG8_WAIT_V(8); PG8_WAIT_L(0); PG8_BAR; PG8_MMA(0, 0, At, B0); PG8_MMA(0, 1, At, B1); PG8_BAR; PG8_SCHED;
            PG8_LDA(At, 1, 1); PG8_STAGE(PG8_SB(1, 0), b3, voffB); PG8_STAGE(PG8_SB(1, 1), b3 + hstep, voffB); PG8_STAGE(PG8_SA(1, 0), a3, voffA);
            PG8_WAIT_V(8); PG8_WAIT_L(0); PG8_BAR; PG8_MMA(1, 0, At, B0); PG8_MMA(1, 1, At, B1); PG8_BAR; PG8_SCHED;
            } else {
            PG8_LDB(B0, 0, 0); PG8_SCHED; PG8_LDA(At, 0, 0); PG8_STAGE(PG8_SA(1, 1), a1 + hstep, voffA);
            PG8_WAIT_L(8); PG8_BAR; PG8_WAIT_L(0); PG8_MMA(0, 0, At, B0); PG8_BAR; PG8_SCHED;
            PG8_LDB(B1, 0, 1); PG8_STAGE(PG8_SB(0, 0), b2, voffB);
            PG8_BAR; PG8_WAIT_L(0); PG8_MMA(0, 1, At, B1); PG8_BAR;
            PG8_LDA(At, 0, 1); PG8_STAGE(PG8_SA(0, 0), a2, voffA);
            PG8_BAR; PG8_WAIT_L(0); PG8_MMA(1, 0, At, B0); PG8_BAR; PG8_SCHED;
            PG8_STAGE(PG8_SB(0, 1), b2 + hstep, voffB);
            PG8_WAIT_V(6); PG8_BAR; PG8_MMA(1, 1, At, B1); PG8_BAR;
            PG8_LDB(B0, 1, 0); PG8_SCHED; PG8_LDA(At, 1, 0); PG8_STAGE(PG8_SA(0, 1), a2 + hstep, voffA);
            PG8_WAIT_L(8); PG8_BAR; PG8_WAIT_L(0); PG8_MMA(0, 0, At, B0); PG8_BAR; PG8_SCHED;
            PG8_LDB(B1, 1, 1); PG8_STAGE(PG8_SB(1, 0), b3, voffB);
            PG8_BAR; PG8_WAIT_L(0); PG8_MMA(0, 1, At, B1); PG8_BAR;
            PG8_LDA(At, 1, 1); PG8_STAGE(PG8_SA(1, 0), a3, voffA);
            PG8_BAR; PG8_WAIT_L(0); PG8_MMA(1, 0, At, B0); PG8_BAR; PG8_SCHED;
            PG8_STAGE(PG8_SB(1, 1), b3 + hstep, voffB);
            PG8_WAIT_V(6); PG8_BAR; PG8_MMA(1, 1, At, B1); PG8_BAR;
            }
        }
        if constexpr (ALIGN_EPI) { if (wr == 0) PG8_BAR; }
        if constexpr (!Epi::AFTER_DRAIN) { E(acc, cur, wr, wc, fr, fq); S.done(cur); }
        if (!has_next) break;
#pragma unroll
        for (int a = 0; a < 2; ++a)
#pragma unroll
            for (int b = 0; b < 2; ++b)
#pragma unroll
                for (int m = 0; m < 4; ++m)
#pragma unroll
                    for (int n = 0; n < 2; ++n) acc[a][b][m][n] = (f32x4){0.f, 0.f, 0.f, 0.f};
        cur = nxt; cA = nA; cB = nB; ++ui;
        if constexpr (ALIGN_EPI) { if (wr == 1) PG8_BAR; }
    }
    PG8_WAIT_V(0);
    if constexpr (!ALIGN_EPI) { if (wr == 0) PG8_BAR; }
    PG8_BAR;
    if constexpr (Epi::AFTER_DRAIN) { E.fused(acc, cur, wr, wc, fr, fq, lds, wid, lane); S.done(cur); }
#undef PG8_SA
#undef PG8_SB
#undef PG8_STAGE
#undef PG8_LDA
#undef PG8_LDB
#undef PG8_MMA
#undef PG8_WAIT_V
#undef PG8_WAIT_L
#undef PG8_BAR
#undef PG8_SCHED
}
}
using pg8::bf16_t; using pg8::bf16x8; using pg8::f32x4; using pg8::u32x4; using pg8::cvt_pk_bf16;
#define LAS __attribute__((address_space(3)))
typedef short s16x4 __attribute__((ext_vector_type(4)));
typedef float f32x16 __attribute__((ext_vector_type(16)));
typedef unsigned u32x2 __attribute__((ext_vector_type(2)));
#define MFMA32(a, b, c) __builtin_amdgcn_mfma_f32_32x32x16_bf16((a), (b), (c), 0, 0, 0)

constexpr int DM = 2048, NB = 8, SEQ = 4096, NTOK = NB * SEQ, NMEM = 256, NLAYER = 4;
constexpr int NZ0 = 5632, NZ1 = 7424, NZ2 = 7168, NSRC1 = 7180;
constexpr float LOG2E = 1.4426950408889634f;
constexpr float EPS = 1e-6f;
constexpr size_t MiB = 1u << 20;
constexpr size_t WS_WIN0 = 0, WS_WIN1 = 22 * MiB, WS_WIN2 = 51 * MiB, WS_WIN3 = 79 * MiB, WS_WOUT = 101 * MiB, WS_WKV = 133 * MiB, WS_MEMN = 149 * MiB,
                 WS_KVM = 157 * MiB, WS_LS = 173 * MiB, WS_SSQ = 175 * MiB, WS_GT = 176 * MiB, WS_HB = 177 * MiB, WS_BR = 305 * MiB, WS_Z = 433 * MiB, WS_END = 897 * MiB;
constexpr int LDS_MISC = 131072;
constexpr int LDS_PART = 131072;
constexpr int LDS_BYTES = 131072 + 8192 + 4096;

struct Params {
    const float *x, *mem, *mem_norm_g, *rel_bias, *norm_g, *w_mem_kv, *mem_q_norm_g, *mem_k_norm_g, *w_out, *a_w_in, *a_ln_g, *a_ln_b, *a_w_s, *a_b_s,
                *b_w_in, *b_b_f, *b_q_norm_g, *b_k_norm_g, *c_w_in, *c_q_norm_g, *c_k_norm_g, *c_lam, *c_subln_g;
    float* out; unsigned char* ws; int ph_lo, ph_hi;
};

__device__ __forceinline__ unsigned off_b(unsigned row, unsigned ch) { return 256u * row + 16u * (ch ^ (((row & 3u) << 2) | ((row >> 2) & 3u))); }
__device__ __forceinline__ float bf2f(unsigned short v) { return __uint_as_float(((unsigned)v) << 16); }
__device__ __forceinline__ float bflo(unsigned w) { return __uint_as_float(w << 16); }
__device__ __forceinline__ float bfhi(unsigned w) { return __uint_as_float(w & 0xffff0000u); }
__device__ __forceinline__ unsigned f2bf(float f) { unsigned u = __float_as_uint(f); return (u + 0x7fffu + ((u >> 16) & 1u)) >> 16; }
typedef float f32x2v __attribute__((ext_vector_type(2)));
typedef __bf16 bf16x2v __attribute__((ext_vector_type(2)));
__device__ __forceinline__ unsigned pk2(float lo, float hi) { const f32x2v v = {lo, hi}; return __builtin_bit_cast(unsigned, __builtin_convertvector(v, bf16x2v)); }
__device__ __forceinline__ float fast_exp2(float x) { return __builtin_amdgcn_exp2f(x); }
__device__ __forceinline__ float fast_rcp(float x) { return __builtin_amdgcn_rcpf(x); }
__device__ __forceinline__ float silu_f(float g) { return g * fast_rcp(1.f + fast_exp2(-g * LOG2E)); }
__device__ __forceinline__ float gelu_tanh_f(float x) { const float u = 0.7978845608028654f * (x + 0.044715f * x * x * x); return x * fast_rcp(1.f + fast_exp2(-2.f * LOG2E * u)); }
__device__ __forceinline__ float wave_sum(float v) {
#pragma unroll
    for (int o = 1; o < 64; o <<= 1) v += __shfl_xor(v, o);
    return v;
}

struct EpiZ {
    static constexpr bool PERM = true, AFTER_DRAIN = false;
    unsigned char* ws; LAS float* part; int ldc; int kind; int L;
    __device__ __forceinline__ void operator()(const f32x4 (&acc)[2][2][4][2], const pg8::Unit& u, int wr, int wc, int fr, int fq) const {
        asm volatile("" : "+v"(fr), "+v"(fq));
        const int lrow0 = wr * 64 + fr, row0 = u.pm * 256 + lrow0, colt = u.pn * 256, pn = u.pn;
        bf16_t* const Z = (bf16_t*)(ws + (kind == 3 ? WS_KVM : WS_Z)); float* const LS = (float*)(ws + WS_LS);
        const float* const ssq = (kind == 3) ? nullptr : (const float*)(ws + WS_SSQ) + (size_t)L * NTOK;
        const float* const gt = (const float*)(ws + WS_GT);
        const float* const bfp = gt + 2048; const float* const gq = gt + 384 * L; const float* const gk = gq + 128; const float* const gm = (kind == 3) ? gt + 1536 : gq + 256;
        if (kind == 1 && pn == 28) {
            if (wc == 0) {
#pragma unroll
                for (int ai = 0; ai < 2; ++ai)
#pragma unroll
                    for (int m = 0; m < 4; ++m) { const int row = row0 + ai * 128 + m * 16;
#pragma unroll
                        for (int n = 0; n < 2; ++n)
#pragma unroll
                            for (int j = 0; j < 4; ++j) { const int col = 8 * fq + 4 * n + j;
                                if (col < 12) { const float xv = acc[ai][0][m][n][j] * rsqrtf(ssq[row] * (1.f / DM) + EPS) + bfp[col]; LS[(size_t)row * 16 + col] = fminf(xv, 0.f) - log1pf(expf(-fabsf(xv))); } } }
            }
            return;
        }
        int W = 0; const float* g = nullptr;
        if (kind == 0) { if (pn == 12 || pn == 13) { W = 128; g = gm; } }
        else if (kind == 3) { if ((pn & 3) < 2) { W = 128; g = gm + (pn >> 2) * 128; } }
        else { if (pn < 6) { W = (kind == 1) ? 128 : 64; g = gq; } else if (pn < 12) { W = (kind == 1) ? 128 : 64; g = gk; } else if (pn == 18 || pn == 19) { W = 128; g = gm; } }
        const bool act = (kind == 0) && (pn < 12);
        f32x4 g0 = (f32x4){1.f, 1.f, 1.f, 1.f}, g1 = g0;
        if (W) {
#pragma unroll
            for (int ai = 0; ai < 2; ++ai)
#pragma unroll
                for (int m = 0; m < 4; ++m)
#pragma unroll
                    for (int bj = 0; bj < 2; ++bj) { const f32x4 a0 = acc[ai][bj][m][0], a1 = acc[ai][bj][m][1];
                        float ss = (a0[0] * a0[0] + a0[1] * a0[1]) + (a0[2] * a0[2] + a0[3] * a0[3]) + (a1[0] * a1[0] + a1[1] * a1[1]) + (a1[2] * a1[2] + a1[3] * a1[3]);
                        ss += __shfl_xor(ss, 16); ss += __shfl_xor(ss, 32);
                        if (fq == 0) part[(lrow0 + ai * 128 + m * 16) * 8 + bj * 4 + wc] = ss; }
            asm volatile("s_waitcnt lgkmcnt(0)" ::: "memory"); __builtin_amdgcn_s_barrier(); asm volatile("" ::: "memory");
            const float* gp = g + ((32 * wc + 8 * fq) & (W - 1));
            g0 = *(const f32x4*)gp; g1 = *(const f32x4*)(gp + 4);
        }
        const float invW = W ? 1.f / (float)W : 0.f;
        const int col0 = colt + wc * 32 + 8 * fq;
#pragma unroll
        for (int ai = 0; ai < 2; ++ai) {
            float rsv[4];
#pragma unroll
            for (int m = 0; m < 4; ++m) rsv[m] = ssq ? rsqrtf(ssq[row0 + ai * 128 + m * 16] * (1.f / DM) + EPS) : 1.f;
#pragma unroll
            for (int m = 0; m < 4; ++m) { bf16_t* rowp = Z + (size_t)(row0 + ai * 128 + m * 16) * ldc + col0;
                const float rs = rsv[m];
#pragma unroll
                for (int bj = 0; bj < 2; ++bj) { float mm = rs;
                    if (W) { const f32x4 pp = *(const LAS f32x4*)(part + (lrow0 + ai * 128 + m * 16) * 8 + bj * 4);
                        const float tot = (W == 128) ? ((pp[0] + pp[1]) + (pp[2] + pp[3])) : (wc < 2 ? pp[0] + pp[1] : pp[2] + pp[3]);
                        mm = rs * rsqrtf(tot * rs * rs * invW + EPS); }
                    f32x4 v0 = acc[ai][bj][m][0] * mm * g0, v1 = acc[ai][bj][m][1] * mm * g1;
                    if (act) {
#pragma unroll
                        for (int j = 0; j < 4; ++j) { v0[j] = gelu_tanh_f(v0[j]); v1[j] = gelu_tanh_f(v1[j]); } }
                    u32x4 w; w.x = cvt_pk_bf16(v0[0], v0[1]); w.y = cvt_pk_bf16(v0[2], v0[3]); w.z = cvt_pk_bf16(v1[0], v1[1]); w.w = cvt_pk_bf16(v1[2], v1[3]);
                    *(u32x4*)(rowp + bj * 128) = w; } } }
    }
};
struct EpiOut {
    static constexpr bool PERM = false, AFTER_DRAIN = false;
    const float* Xin; float* Out; bf16_t* HBo; float* ssq;
    __device__ __forceinline__ void operator()(const f32x4 (&acc)[2][2][4][2], const pg8::Unit& u, int wr, int wc, int fr, int fq) const {
        asm volatile("" : "+v"(fr), "+v"(fq));
        const int row0 = u.pm * 256 + wr * 64 + fr, col0 = u.pn * 256 + wc * 32 + 4 * fq;
        f32x4 xr[3][4];
#define EO_LOAD(rr, slot) do { const size_t o_ = (size_t)(row0 + ((rr) >> 2) * 128 + ((rr) & 3) * 16) * DM + col0; _Pragma("unroll") for (int q_ = 0; q_ < 4; ++q_) xr[slot][q_] = *(const f32x4*)(Xin + o_ + (q_ >> 1) * 128 + (q_ & 1) * 16); } while (0)
        EO_LOAD(0, 0); EO_LOAD(1, 1);
#pragma unroll
        for (int rr = 0; rr < 8; ++rr) { const int ai = rr >> 2, m = rr & 3, row = row0 + ai * 128 + m * 16; const size_t o = (size_t)row * DM + col0; float s = 0.f;
            if (rr + 2 < 8) EO_LOAD(rr + 2, (rr + 2) % 3);
#pragma unroll
            for (int q = 0; q < 4; ++q) { const int bj = q >> 1, n = q & 1; const size_t idx = o + bj * 128 + n * 16; const f32x4 v = xr[rr % 3][q] + acc[ai][bj][m][n]; *(f32x4*)(Out + idx) = v;
                if (ssq) { u32x2 w; w.x = cvt_pk_bf16(v[0], v[1]); w.y = cvt_pk_bf16(v[2], v[3]); *(u32x2*)(HBo + idx) = w; s += (v[0] * v[0] + v[1] * v[1]) + (v[2] * v[2] + v[3] * v[3]); } }
            if (ssq) { s += __shfl_xor(s, 16); s += __shfl_xor(s, 32); if (fq == 0) atomicAdd(ssq + row, s); } }
#undef EO_LOAD
    }
};
#ifndef AT_KD
#define AT_KD 4
#endif
#ifndef AT_VD
#define AT_VD 3
#endif
struct AttnArgs {
    const bf16_t *Q, *K, *V, *G; bf16_t* O;
    int ldq, ldkv, ldg, ldo, q0, ntiles;
    const float* c;
    const float* lutsrc;
    const float* subg;
    float sc, lam, outmul, m2;
};
constexpr int A_CS = 65536, A_LUT = 65536 + 16384;

template <int MODE>
__device__ __forceinline__ void attn_item(LAS unsigned char* lds, const AttnArgs& a, const int tid) {
    const int wave = __builtin_amdgcn_readfirstlane(tid >> 6), lane = tid & 63, r = lane & 31, h = lane >> 5;
    constexpr int NKS = (MODE == 2) ? 4 : 8;
    const int map = (MODE == 2) ? (wave >> 2) : 0;
    const int qw0 = a.q0 + 32 * ((MODE == 2) ? (wave & 3) : wave);
    const int tw = (MODE == 0) ? (a.ntiles - 1) : (MODE == 1 ? ((qw0 + 31) >> 6) : (qw0 >> 6));
    __syncthreads();
    if (MODE == 2) {
        if (tid < 255) { const int rel = tid - 191; const int n = rel < 0 ? -rel : rel; int bkt;
            if (n < 8) bkt = n; else { const float nf = (float)n; int lg = 8 + (int)(logf(nf / 8.0f) / 2.772588722239781f * 8.0f); bkt = lg < 15 ? lg : 15; }
            if (rel > 0) bkt += 16;
            ((LAS float*)(lds + A_LUT))[tid] = a.lutsrc[bkt * 12] * LOG2E - a.m2; }
    }
    bf16x8 qf[NKS];
    { const bf16_t* qrow = a.Q + (size_t)(qw0 + r) * a.ldq + map * 64 + 8 * h;
#pragma unroll
      for (int ks = 0; ks < NKS; ++ks) qf[ks] = *(const bf16x8*)(qrow + 16 * ks); }
    if (MODE == 1) {
        LAS float* cl = (LAS float*)(lds + A_CS); LAS float* wtot = (LAS float*)(lds + A_LUT);
        const int n = a.q0 + 256; const bool on = 8 * tid < n;
        float v[8]; float run = 0.f;
        const float* lp = a.c + (size_t)(8 * tid) * 16;
#pragma unroll
        for (int e = 0; e < 8; ++e) { if (on) run += lp[e * 16]; v[e] = run; }
        float incl = run;
#pragma unroll
        for (int o = 1; o < 64; o <<= 1) { const float x = __shfl_up(incl, o); if (lane >= o) incl += x; }
        if (lane == 63) wtot[wave] = incl;
        __syncthreads();
        float pre = incl - run;
        for (int w = 0; w < wave; ++w) pre += wtot[w];
        if (on) {
#pragma unroll
            for (int e = 0; e < 8; ++e) cl[8 * tid + e] = -(pre + v[e]) * LOG2E; }
    }
    unsigned kaddr[NKS];
    { const unsigned X = ((r & 3u) << 2) | ((r >> 2) & 3u);
#pragma unroll
      for (int ks = 0; ks < NKS; ++ks) kaddr[ks] = 256u * r + 16u * ((unsigned)(2 * (map * 4 + ks) + h) ^ X); }
    unsigned vaddr[4][2];
    { const unsigned q = (lane & 15) >> 2, p = lane & 3, blk = (lane >> 4) & 1;
#pragma unroll
      for (int dt = 0; dt < 4; ++dt)
#pragma unroll
          for (int t2 = 0; t2 < 2; ++t2) vaddr[dt][t2] = 16384u + off_b(8 * t2 + 4 * h + q, 4 * dt + 2 * blk + (p >> 1)) + 8u * (p & 1); }
    const unsigned sX = ((unsigned)(lane >> 4) << 2) | (unsigned)(wave & 3);
    const size_t sgoff = (size_t)(4 * wave + (lane >> 4)) * a.ldkv + (size_t)(((unsigned)(lane & 15) ^ sX) * 8u);
    const bf16_t* kg = a.K + sgoff; const bf16_t* vg = a.V + sgoff;
    const size_t tstep = (size_t)64 * a.ldkv, hstep = (size_t)32 * a.ldkv;
#define AT_DMA1(gp, la) asm volatile("s_mov_b32 m0, %1\n\ts_nop 0\n\tglobal_load_lds_dwordx4 %0, off" :: "v"(gp), "s"(la) : "memory", "m0")
#define AT_DMA(t, b) do { const bf16_t* kp = kg + (size_t)(t) * tstep; const bf16_t* vp = vg + (size_t)(t) * tstep; const unsigned la = (unsigned)(size_t)(lds + (b) * 32768 + wave * 1024); \
        AT_DMA1(kp, la); AT_DMA1(kp + hstep, la + 8192u); AT_DMA1(vp, la + 16384u); AT_DMA1(vp + hstep, la + 16384u + 8192u); } while (0)
    float l = 0.f;
    f32x16 o[4];
#pragma unroll
    for (int dt = 0; dt < 4; ++dt)
#pragma unroll
        for (int i = 0; i < 16; ++i) o[dt][i] = 0.f;
    AT_DMA(0, 0);
    asm volatile("s_waitcnt vmcnt(0)" ::: "memory");
    __syncthreads();
#pragma unroll
    for (int ks = 0; ks < NKS; ++ks) asm volatile("" : "+v"(qf[ks]));
    float b15 = 0.f; if (MODE == 2) b15 = ((LAS float*)(lds + A_LUT))[0];
    float addc = -a.m2; if (MODE == 1) addc = -((LAS float*)(lds + A_CS))[qw0 + r] - a.m2; if (MODE == 2) addc = b15;
    const int nt = a.ntiles;
    for (int t = 0; t < nt; ++t) {
        const int b = t & 1;
        if (t + 1 < nt) AT_DMA(t + 1, b ^ 1);
        if (t <= tw) {
            LAS unsigned char* kb = lds + b * 32768;
            f32x16 s[2];
#pragma unroll
            for (int i = 0; i < 16; ++i) { s[0][i] = 0.f; s[1][i] = 0.f; }
            constexpr int KD = AT_KD, VD = AT_VD;
            bf16x8 kf[KD];
#define AT_KLD(i) (*(LAS bf16x8*)(kb + kaddr[(i) >> 1] + ((i) & 1) * 8192))
#pragma unroll
            for (int i = 0; i < KD; ++i) kf[i] = AT_KLD(i);
#pragma unroll
            for (int i = 0; i < 2 * NKS; ++i) { s[i & 1] = MFMA32(kf[i % KD], qf[i >> 1], s[i & 1]); if (i + KD < 2 * NKS) kf[i % KD] = AT_KLD(i + KD); }
#undef AT_KLD
            bf16x8 vf[VD];
#define AT_VLD(j) do { const s16x4 lo_ = __builtin_amdgcn_ds_read_tr16_b64_v4i16((LAS s16x4*)(kb + vaddr[(j) & 3][0] + (32 * ((j) >> 3) + 16 * (((j) >> 2) & 1)) * 256)); \
                const s16x4 hi_ = __builtin_amdgcn_ds_read_tr16_b64_v4i16((LAS s16x4*)(kb + vaddr[(j) & 3][1] + (32 * ((j) >> 3) + 16 * (((j) >> 2) & 1)) * 256)); \
                vf[(j) % VD] = __builtin_shufflevector(lo_, hi_, 0, 1, 2, 3, 4, 5, 6, 7); } while (0)
#pragma unroll
            for (int j = 0; j < VD; ++j) AT_VLD(j);
            const float sc = a.sc;
            const bool diag = (MODE == 1) && (t * 64 + 63 > qw0);
            const bool near = (MODE == 2) && (t >= tw - 2);
            bf16x8 pf[2];
#pragma unroll
            for (int kt = 0; kt < 2; ++kt) {
                if (MODE == 1) {
                    const LAS float* csb = (const LAS float*)(lds + A_CS) + t * 64 + 32 * kt + 4 * h;
                    const int mb = t * 64 + 32 * kt + 4 * h - (qw0 + r);
#pragma unroll
                    for (int g = 0; g < 4; ++g) { const f32x4 cv = *(const LAS f32x4*)(csb + 8 * g);
#pragma unroll
                        for (int e = 0; e < 4; ++e) { float x = fmaf(s[kt][4 * g + e], sc, addc) + cv[e]; if (diag && (mb + 8 * g + e > 0)) x = -1e30f; s[kt][4 * g + e] = x; } }
                } else if (MODE == 2) {
                    if (near) {
                        const LAS float* lut = (const LAS float*)(lds + A_LUT) + (t * 64 + 32 * kt + 4 * h - (qw0 + r) + 191);
#pragma unroll
                        for (int i = 0; i < 16; ++i) s[kt][i] = fmaf(s[kt][i], sc, lut[8 * (i >> 2) + (i & 3)]);
                    } else {
#pragma unroll
                        for (int i = 0; i < 16; ++i) s[kt][i] = fmaf(s[kt][i], sc, addc);
                    }
                } else {
#pragma unroll
                    for (int i = 0; i < 16; ++i) s[kt][i] = fmaf(s[kt][i], sc, addc);
                }
                float ls = 0.f;
#pragma unroll
                for (int i = 0; i < 16; ++i) { const float pv = fast_exp2(s[kt][i]); s[kt][i] = pv; ls += pv; }
                l += ls;
#pragma unroll
                for (int ss = 0; ss < 2; ++ss) { u32x4 w;
                    w.x = pk2(s[kt][8 * ss + 0], s[kt][8 * ss + 1]); w.y = pk2(s[kt][8 * ss + 2], s[kt][8 * ss + 3]);
                    w.z = pk2(s[kt][8 * ss + 4], s[kt][8 * ss + 5]); w.w = pk2(s[kt][8 * ss + 6], s[kt][8 * ss + 7]);
                    pf[ss] = __builtin_bit_cast(bf16x8, w); }
#pragma unroll
                for (int jj = 0; jj < 8; ++jj) { const int j = 8 * kt + jj;
                    o[jj & 3] = MFMA32(vf[j % VD], pf[jj >> 2], o[jj & 3]);
                    if (j + VD < 16) AT_VLD(j + VD); }
            }
#undef AT_VLD
        }
        asm volatile("s_waitcnt vmcnt(0)" ::: "memory");
        __syncthreads();
    }
#undef AT_DMA
#undef AT_DMA1
    l += __shfl_xor(l, 32);
    const float inv = 1.f / l;
    const size_t qrow = (size_t)(qw0 + r);
    u32x2 gwv[16];
#pragma unroll
    for (int k = 0; k < 16; ++k) gwv[k] = *(const u32x2*)(a.G + qrow * a.ldg + 32 * (k >> 2) + 8 * (k & 3) + 4 * h);
    if (MODE != 2) {
#pragma unroll
        for (int dt = 0; dt < 4; ++dt)
#pragma unroll
            for (int g = 0; g < 4; ++g) { const int d = 32 * dt + 8 * g + 4 * h;
                const u32x2 gw = gwv[dt * 4 + g];
                const float v0 = o[dt][4 * g + 0] * inv * silu_f(bflo(gw.x)), v1 = o[dt][4 * g + 1] * inv * silu_f(bfhi(gw.x));
                const float v2 = o[dt][4 * g + 2] * inv * silu_f(bflo(gw.y)), v3 = o[dt][4 * g + 3] * inv * silu_f(bfhi(gw.y));
                u32x2 w; w.x = pk2(v0, v1); w.y = pk2(v2, v3);
                *(u32x2*)(a.O + qrow * a.ldo + d) = w; }
    } else {
        LAS float* xb = (LAS float*)(lds + (wave & 3) * 16384);
        if (map == 1) {
            const float f = inv * a.lam;
#pragma unroll
            for (int dt = 0; dt < 4; ++dt)
#pragma unroll
                for (int i = 0; i < 16; ++i) xb[(dt * 16 + i) * 64 + lane] = o[dt][i] * f;
        }
        __syncthreads();
        if (map == 0) {
            float ssq = 0.f;
#pragma unroll
            for (int dt = 0; dt < 4; ++dt)
#pragma unroll
                for (int i = 0; i < 16; ++i) { const float v = o[dt][i] * inv - xb[(dt * 16 + i) * 64 + lane]; o[dt][i] = v; ssq += v * v; }
            ssq += __shfl_xor(ssq, 32);
            const float rn = rsqrtf(ssq * (1.f / 128.f) + EPS) * a.outmul;
#pragma unroll
            for (int dt = 0; dt < 4; ++dt)
#pragma unroll
                for (int g = 0; g < 4; ++g) { const int d = 32 * dt + 8 * g + 4 * h;
                    const u32x2 gw = gwv[dt * 4 + g];
                    const f32x4 sg = *(const f32x4*)(a.subg + d);
                    const float v0 = o[dt][4 * g + 0] * rn * sg[0] * silu_f(bflo(gw.x)), v1 = o[dt][4 * g + 1] * rn * sg[1] * silu_f(bfhi(gw.x));
                    const float v2 = o[dt][4 * g + 2] * rn * sg[2] * silu_f(bflo(gw.y)), v3 = o[dt][4 * g + 3] * rn * sg[3] * silu_f(bfhi(gw.y));
                    u32x2 w; w.x = pk2(v0, v1); w.y = pk2(v2, v3);
                    *(u32x2*)(a.O + qrow * a.ldo + d) = w; }
        }
    }
}
__device__ __forceinline__ void tr_item(const float* W, int N, bf16_t* WT, int item, int lane, LAS float* scr, int fox, const float* gk) {
    const int nblk = (N + 31) >> 5, kb = item / nblk, nb = item - kb * nblk, k0 = 64 * kb, n0 = 32 * nb;
    const int nq = lane & 7, kr = lane >> 3, nc = n0 + 4 * nq;
    f32x4 wv[8];
#pragma unroll
    for (int i = 0; i < 8; ++i) wv[i] = (nc < N) ? *(const f32x4*)(W + (size_t)(k0 + kr + 8 * i) * N + nc) : (f32x4){0.f, 0.f, 0.f, 0.f};
#pragma unroll
    for (int i = 0; i < 8; ++i) { const int kk = kr + 8 * i; const float gg = gk ? gk[k0 + kk] : 1.f;
#pragma unroll
        for (int e2 = 0; e2 < 4; ++e2) scr[kk * 33 + 4 * nq + e2] = wv[i][e2] * gg; }
    asm volatile("s_waitcnt lgkmcnt(0)" ::: "memory");
    const int c = lane & 7;
#pragma unroll
    for (int j = 0; j < 4; ++j) { const int nl = (lane >> 3) + 8 * j, n = n0 + nl; const LAS float* s = scr + (8 * c) * 33 + nl;
        if (n < N) { int nd = n; if (fox) { if (n >= 4620) nd = n - 12; else if (n >= 4608) nd = n - 4608 + 7168; }
            u32x4 o; o.x = pk2(s[0 * 33], s[1 * 33]); o.y = pk2(s[2 * 33], s[3 * 33]); o.z = pk2(s[4 * 33], s[5 * 33]); o.w = pk2(s[6 * 33], s[7 * 33]);
            *(u32x4*)(WT + (size_t)nd * DM + k0 + 8 * c) = o; } }
    asm volatile("s_waitcnt lgkmcnt(0)" ::: "memory");
}
__device__ __forceinline__ void rms_row_to_bf16(const float* xrow, const float* g, bf16_t* orow, int lane) {
    const f32x4* xr = (const f32x4*)xrow + lane; const f32x4* gr = (const f32x4*)g + lane;
    f32x4 v[8]; float s = 0.f;
#pragma unroll
    for (int j = 0; j < 8; ++j) { v[j] = xr[64 * j]; s += (v[j][0] * v[j][0] + v[j][1] * v[j][1]) + (v[j][2] * v[j][2] + v[j][3] * v[j][3]); }
    const float rstd = rsqrtf(wave_sum(s) * (1.f / DM) + EPS);
    u32x2* o8 = (u32x2*)orow + lane;
#pragma unroll
    for (int j = 0; j < 8; ++j) { const f32x4 gg = gr[64 * j]; u32x2 w; w.x = pk2(v[j][0] * rstd * gg[0], v[j][1] * rstd * gg[1]); w.y = pk2(v[j][2] * rstd * gg[2], v[j][3] * rstd * gg[3]); o8[64 * j] = w; }
}
__device__ __forceinline__ void row_to_bf16_ssq(const float* xrow, bf16_t* orow, float* ssq, int lane) {
    const f32x4* xr = (const f32x4*)xrow + lane; u32x2* o8 = (u32x2*)orow + lane; float s = 0.f;
#pragma unroll
    for (int j = 0; j < 8; ++j) { const f32x4 v = xr[64 * j]; s += (v[0] * v[0] + v[1] * v[1]) + (v[2] * v[2] + v[3] * v[3]);
        u32x2 w; w.x = pk2(v[0], v[1]); w.y = pk2(v[2], v[3]); o8[64 * j] = w; }
    s = wave_sum(s);
    if (lane == 0) *ssq = s;
}
template <int W>
__device__ __forceinline__ void seg_norm512(bf16_t* p, const float* g, int lane) {
    u32x4 w = *(const u32x4*)(p + 8 * lane);
    float f[8] = {bflo(w.x), bfhi(w.x), bflo(w.y), bfhi(w.y), bflo(w.z), bfhi(w.z), bflo(w.w), bfhi(w.w)};
    float s = 0.f;
#pragma unroll
    for (int j = 0; j < 8; ++j) s += f[j] * f[j];
#pragma unroll
    for (int o = 1; o < W / 8; o <<= 1) s += __shfl_xor(s, o);
    const float rstd = rsqrtf(s * (1.f / W) + EPS);
    const float* gp = g + ((8 * lane) & (W - 1));
    const f32x4 g0 = *(const f32x4*)gp, g1 = *(const f32x4*)(gp + 4);
    w.x = pk2(f[0] * rstd * g0[0], f[1] * rstd * g0[1]); w.y = pk2(f[2] * rstd * g0[2], f[3] * rstd * g0[3]);
    w.z = pk2(f[4] * rstd * g1[0], f[5] * rstd * g1[1]); w.w = pk2(f[6] * rstd * g1[2], f[7] * rstd * g1[3]);
    *(u32x4*)(p + 8 * lane) = w;
}

__device__ __forceinline__ void gmlp_item(LAS unsigned char* lds, const bf16_t* Zt  , bf16_t* BRt  , const float* ws_, const float* bs_, const float* lng, const float* lnb, const int tid) {
    const int wave = __builtin_amdgcn_readfirstlane(tid >> 6), lane = tid & 63, r = lane & 31, h = lane >> 5;
    LAS float* st = (LAS float*)(lds + 65536);
    __syncthreads();
    for (int tq = 0; tq < 4; ++tq) {
        u32x4 w[4][3];
#pragma unroll
        for (int u = 0; u < 4; ++u)
#pragma unroll
            for (int c = 0; c < 3; ++c) w[u][c] = *(const u32x4*)(Zt + (size_t)(16 * wave + 4 * tq + u) * NZ0 + 1536 + 8 * (lane + 64 * c));
#pragma unroll
        for (int u = 0; u < 4; ++u) { float s = 0.f, s2 = 0.f;
#pragma unroll
            for (int c = 0; c < 3; ++c) { const float f[8] = {bflo(w[u][c].x), bfhi(w[u][c].x), bflo(w[u][c].y), bfhi(w[u][c].y), bflo(w[u][c].z), bfhi(w[u][c].z), bflo(w[u][c].w), bfhi(w[u][c].w)};
#pragma unroll
                for (int j = 0; j < 8; ++j) { s += f[j]; s2 += f[j] * f[j]; } }
            s = wave_sum(s); s2 = wave_sum(s2);
            const float mean = s * (1.f / 1536.f), var = fmaxf(s2 * (1.f / 1536.f) - mean * mean, 0.f);
            const int tok = 16 * wave + 4 * tq + u;
            if (lane == 0) { st[2 * tok] = mean; st[2 * tok + 1] = rsqrtf(var + EPS); } } }
    __syncthreads();
    const int tt = wave & 3, cp = wave >> 2;
    const unsigned q = (lane & 15) >> 2, p = lane & 3, blk = (lane >> 4) & 1;
    unsigned aaddr[8], baddr[2][2];
#pragma unroll
    for (int ks = 0; ks < 8; ++ks) aaddr[ks] = tt * 8192 + off_b(r, 2 * ks + h);
#pragma unroll
    for (int cc = 0; cc < 2; ++cc)
#pragma unroll
        for (int t2 = 0; t2 < 2; ++t2) baddr[cc][t2] = 32768u + off_b(8 * h + 4 * t2 + q, 4 * (2 * cp + cc) + 2 * blk + (p >> 1)) + 8u * (p & 1);
    for (int g = 0; g < 12; ++g) {
        const float* Wg = ws_ + (size_t)g * 16384;
        { const int ch = tid & 15, t0 = tid >> 4;
          f32x4 wa[4][2]; u32x4 vw[4];
#pragma unroll
          for (int i = 0; i < 4; ++i) { const int t = t0 + 32 * i; wa[i][0] = *(const f32x4*)(Wg + t * 128 + 8 * ch); wa[i][1] = *(const f32x4*)(Wg + t * 128 + 8 * ch + 4);
              vw[i] = *(const u32x4*)(Zt + (size_t)t * NZ0 + 1536 + g * 128 + 8 * ch); }
          const float* gp = lng + g * 128 + 8 * ch; const float* bp = lnb + g * 128 + 8 * ch;
          const f32x4 g0 = *(const f32x4*)gp, g1 = *(const f32x4*)(gp + 4), b0 = *(const f32x4*)bp, b1 = *(const f32x4*)(bp + 4);
#pragma unroll
          for (int i = 0; i < 4; ++i) { const int t = t0 + 32 * i;
              f32x4 a0 = wa[i][0], a1 = wa[i][1];
              if (t < 64 && ch >= 8) { a0 = (f32x4){0.f, 0.f, 0.f, 0.f}; a1 = a0; }
              u32x4 w; w.x = pk2(a0[0], a0[1]); w.y = pk2(a0[2], a0[3]); w.z = pk2(a1[0], a1[1]); w.w = pk2(a1[2], a1[3]);
              *(LAS u32x4*)(lds + off_b(t, ch)) = w;
              const float mean = st[2 * t], rstd = st[2 * t + 1];
              u32x4 o;
              o.x = pk2((bflo(vw[i].x) - mean) * rstd * g0[0] + b0[0], (bfhi(vw[i].x) - mean) * rstd * g0[1] + b0[1]);
              o.y = pk2((bflo(vw[i].y) - mean) * rstd * g0[2] + b0[2], (bfhi(vw[i].y) - mean) * rstd * g0[3] + b0[3]);
              o.z = pk2((bflo(vw[i].z) - mean) * rstd * g1[0] + b1[0], (bfhi(vw[i].z) - mean) * rstd * g1[1] + b1[1]);
              o.w = pk2((bflo(vw[i].w) - mean) * rstd * g1[2] + b1[2], (bfhi(vw[i].w) - mean) * rstd * g1[3] + b1[3]);
              *(LAS u32x4*)(lds + 32768 + off_b(t, ch)) = o; } }
        __syncthreads();
        f32x16 acc[2];
#pragma unroll
        for (int i = 0; i < 16; ++i) { acc[0][i] = 0.f; acc[1][i] = 0.f; }
#pragma unroll
        for (int ks = 0; ks < 8; ++ks) {
            const bf16x8 af = *(LAS bf16x8*)(lds + aaddr[ks]);
#pragma unroll
            for (int cc = 0; cc < 2; ++cc) {
                const s16x4 lo = __builtin_amdgcn_ds_read_tr16_b64_v4i16((LAS s16x4*)(lds + baddr[cc][0] + ks * 4096));
                const s16x4 hi = __builtin_amdgcn_ds_read_tr16_b64_v4i16((LAS s16x4*)(lds + baddr[cc][1] + ks * 4096));
                const bf16x8 bfv = __builtin_shufflevector(lo, hi, 0, 1, 2, 3, 4, 5, 6, 7);
                acc[cc] = MFMA32(bfv, af, acc[cc]); }
        }
        int r2 = r, h2 = h; asm volatile("" : "+v"(r2), "+v"(h2));
        { const int t = 32 * tt + r2; const float bsv = bs_[g * 128 + t];
          const bf16_t* zrow = Zt + (size_t)t * NZ0 + g * 128; bf16_t* brow = BRt + (size_t)t * DM + g * 128;
          u32x2 uw[8], gw[8];
#pragma unroll
          for (int k8 = 0; k8 < 8; ++k8) { const int c = 32 * (2 * cp + (k8 >> 2)) + 8 * (k8 & 3) + 4 * h2; uw[k8] = *(const u32x2*)(zrow + c); gw[k8] = *(const u32x2*)(zrow + 3584 + c); }
#pragma unroll
          for (int k8 = 0; k8 < 8; ++k8) { const int cc = k8 >> 2, q4 = k8 & 3, c = 32 * (2 * cp + cc) + 8 * q4 + 4 * h2;
              const float v0 = bflo(uw[k8].x) * (acc[cc][4 * q4 + 0] + bsv) * silu_f(bflo(gw[k8].x)), v1 = bfhi(uw[k8].x) * (acc[cc][4 * q4 + 1] + bsv) * silu_f(bfhi(gw[k8].x));
              const float v2 = bflo(uw[k8].y) * (acc[cc][4 * q4 + 2] + bsv) * silu_f(bflo(gw[k8].y)), v3 = bfhi(uw[k8].y) * (acc[cc][4 * q4 + 3] + bsv) * silu_f(bfhi(gw[k8].y));
              u32x2 w; w.x = pk2(v0, v1); w.y = pk2(v2, v3);
              *(u32x2*)(brow + c) = w; } }
        __syncthreads();
    }
}
constexpr int NPHASE = 1 + 3 * NLAYER;
#ifndef MK_PER_PHASE
#define MK_PER_PHASE 0
#endif

__device__ __forceinline__ void grid_bar(unsigned* base, unsigned k  , int tid) {
    __syncthreads();
    if (tid == 0) {
        __builtin_amdgcn_fence(__ATOMIC_RELEASE, "agent");
        const unsigned G = gridDim.x, x = blockIdx.x & 7u, gsize = (G - x + 7u) >> 3, ngroups = G < 8u ? G : 8u;
        const unsigned prev = __hip_atomic_fetch_add(base + 64 * (1 + x), 1u, __ATOMIC_RELAXED, __HIP_MEMORY_SCOPE_AGENT);
        if (prev + 1u == k * gsize) __hip_atomic_fetch_add(base, 1u, __ATOMIC_RELAXED, __HIP_MEMORY_SCOPE_AGENT);
        while (__hip_atomic_load(base, __ATOMIC_RELAXED, __HIP_MEMORY_SCOPE_AGENT) < k * ngroups) __builtin_amdgcn_s_sleep(1);
        __builtin_amdgcn_fence(__ATOMIC_ACQUIRE, "agent");
    }
    __syncthreads();
}

__global__ void __launch_bounds__(512) mk_fwd(Params P) {
    extern __shared__ __attribute__((aligned(16))) unsigned char shm[];
    LAS unsigned char* lds = (LAS unsigned char*)shm;
    cg::grid_group grid = cg::this_grid();
    const int G = gridDim.x, NGW = G * 8;
    int redo = 0; (void)redo;
    for (int ph = P.ph_lo; ph < P.ph_hi; ++ph) {
        int tid = threadIdx.x; asm volatile("" : "+v"(tid));
        const int wave = __builtin_amdgcn_readfirstlane(tid >> 6), lane = tid & 63, gw = blockIdx.x * 8 + wave;
        unsigned char* ws = P.ws; asm volatile("" : "+s"(ws));
        bf16_t* const WOUT = (bf16_t*)(ws + WS_WOUT); bf16_t* const WKV = (bf16_t*)(ws + WS_WKV); bf16_t* const MEMN = (bf16_t*)(ws + WS_MEMN);
        bf16_t* const KVM = (bf16_t*)(ws + WS_KVM); float* const LS = (float*)(ws + WS_LS); float* const SSQ = (float*)(ws + WS_SSQ);
        bf16_t* const HB = (bf16_t*)(ws + WS_HB); bf16_t* const BR = (bf16_t*)(ws + WS_BR); bf16_t* const Z = (bf16_t*)(ws + WS_Z);

        if (ph == 0) {
            LAS float* scr = (LAS float*)(lds + wave * 16384);
            constexpr int I0 = 32 * 176, I1 = 32 * 225, I2 = 32 * 224, IO = 32 * 64, IK = 32 * 32;
            constexpr int NIT = 2 * I0 + I1 + I2 + 4 * IO + 4 * IK;
            for (int it = gw; it < NIT; it += NGW) {
                int r = it;
                if (r < I0) { tr_item(P.a_w_in, NZ0, (bf16_t*)(ws + WS_WIN0), r, lane, scr, 0, P.norm_g); continue; } r -= I0;
                if (r < I1) { tr_item(P.b_w_in, NSRC1, (bf16_t*)(ws + WS_WIN1), r, lane, scr, 1, P.norm_g + DM); continue; } r -= I1;
                if (r < I2) { tr_item(P.c_w_in, NZ2, (bf16_t*)(ws + WS_WIN2), r, lane, scr, 0, P.norm_g + 2 * DM); continue; } r -= I2;
                if (r < I0) { tr_item(P.a_w_in + (size_t)DM * NZ0, NZ0, (bf16_t*)(ws + WS_WIN3), r, lane, scr, 0, P.norm_g + 3 * DM); continue; } r -= I0;
                if (r < 4 * IO) { const int L = r / IO; tr_item(P.w_out + (size_t)L * DM * DM, DM, WOUT + (size_t)L * DM * DM, r - L * IO, lane, scr, 0, nullptr); continue; } r -= 4 * IO;
                { const int L = r / IK; tr_item(P.w_mem_kv + (size_t)L * DM * 1024, 1024, WKV + (size_t)L * 1024 * DM, r - L * IK, lane, scr, 0, nullptr); }
            }
            { u32x4* zp = (u32x4*)((bf16_t*)(ws + WS_WIN1) + (size_t)NSRC1 * DM); const int nz = (NZ1 - NSRC1) * DM / 8;
              for (int i = blockIdx.x * 512 + tid; i < nz; i += G * 512) zp[i] = (u32x4){0u, 0u, 0u, 0u}; }
            for (int m = gw; m < NB * NMEM; m += NGW) rms_row_to_bf16(P.mem + (size_t)m * DM, P.mem_norm_g, MEMN + (size_t)m * DM, lane);
            for (int m = gw; m < NTOK; m += NGW) row_to_bf16_ssq(P.x + (size_t)m * DM, HB + (size_t)m * DM, SSQ + m, lane);
            for (int i = blockIdx.x * 512 + tid; i < 3 * NTOK; i += G * 512) SSQ[NTOK + i] = 0.f;
            if (blockIdx.x == 0) { float* gt = (float*)(ws + WS_GT);
                if (tid < 9) { ((unsigned*)(ws + WS_GT))[4096 + 64 * tid] = 0u; ((unsigned*)(ws + WS_GT))[8192 + 64 * tid] = 0u; }
                for (int i = tid; i < 2064; i += 512) { float v = 0.f;
                    if (i < 1536) { const int Lq = i / 384, w = (i % 384) / 128, d = i & 127, kd = Lq % 3;
                        if (w == 2) v = P.mem_q_norm_g[Lq * 128 + d];
                        else if (kd == 1) v = (w == 0 ? P.b_q_norm_g : P.b_k_norm_g)[d];
                        else if (kd == 2) v = (w == 0 ? P.c_q_norm_g : P.c_k_norm_g)[d & 63];
                    } else if (i < 2048) v = P.mem_k_norm_g[i - 1536];
                    else if (i < 2060) v = P.b_b_f[i - 2048];
                    gt[i] = v; }
                if (tid < 19) {
                    float v = 0.f;
                    if (tid < 16) { const int Lq = tid >> 2, w = tid & 3, kd = Lq % 3;
                        if (w == 2) { for (int i = 0; i < 128; ++i) v = fmaxf(v, fabsf(P.mem_q_norm_g[Lq * 128 + i])); }
                        else if (w == 3) { for (int i = 0; i < 128; ++i) v = fmaxf(v, fabsf(P.mem_k_norm_g[Lq * 128 + i])); }
                        else if (kd == 1) { const float* gsrc = (w == 0) ? P.b_q_norm_g : P.b_k_norm_g; for (int i = 0; i < 128; ++i) v = fmaxf(v, fabsf(gsrc[i])); }
                        else if (kd == 2) { const float* gsrc = (w == 0) ? P.c_q_norm_g : P.c_k_norm_g; for (int i = 0; i < 64; ++i) v = fmaxf(v, fabsf(gsrc[i])); }
                    } else if (tid == 16) { for (int i = 0; i < 384; ++i) v = fmaxf(v, P.rel_bias[i]); }
                    else if (tid == 17) { for (int i = 0; i < 64; ++i) v += P.c_lam[i] * P.c_lam[64 + i]; }
                    else { for (int i = 0; i < 64; ++i) v += P.c_lam[128 + i] * P.c_lam[192 + i]; }
                    gt[2080 + tid] = v; } }
        } else {
            const int L = (ph - 1) / 3, sub = (ph - 1) % 3, kind = L % 3;
            const int NZ = (kind == 0) ? NZ0 : (kind == 1 ? NZ1 : NZ2);
            const int memq_off = (kind == 0) ? 3072 : 4608;
            if (sub == 0) {
                for (int jb = (L == 0 ? 0 : 1); jb < 2; ++jb) {
                    pg8::Gemm g; EpiZ E;
                    LAS float* part = (LAS float*)(lds + LDS_PART);
                    if (jb == 0) { g = pg8::Gemm{MEMN, WKV, NB * NMEM, 4096, DM}; E = EpiZ{ws, part, 4096, 3, 0}; }
                    else { bf16_t* wt = (bf16_t*)(ws + (L == 0 ? WS_WIN0 : L == 1 ? WS_WIN1 : L == 2 ? WS_WIN2 : WS_WIN3));
                           g = pg8::Gemm{HB, wt, NTOK, NZ, DM}; E = EpiZ{ws, part, NZ, kind, L}; }
                    pg8::StaticOrder S; S.init(g.M, g.N, G, (int)blockIdx.x);
                    pg8::gemm_phase<EpiZ, pg8::StaticOrder, true, true>(lds, g, S, E, tid);
                }
            } else if (sub == 1) {
                const int gate_off = memq_off + 512;
                const float* gx = (const float*)(ws + WS_GT) + 2080;
                const float gqm = gx[4 * L], gkm = gx[4 * L + 1], gmq = gx[4 * L + 2], gmk = gx[4 * L + 3];
                const float m2_mem = 11.3137085f * gmq * gmk * 1.01f * LOG2E;
                if (kind == 0) {
                    const int j = L / 3;
#ifdef REP_GM
                    for (int rep_ = 0; rep_ < 2; ++rep_)
#endif
                    for (int it = blockIdx.x; it < NTOK / 128; it += G)
                        gmlp_item(lds, Z + (size_t)it * 128 * NZ0, BR + (size_t)it * 128 * DM, P.a_w_s + (size_t)j * 12 * 16384, P.a_b_s + j * 1536, P.a_ln_g + j * 1536, P.a_ln_b + j * 1536, tid);
                } else if (kind == 1) {
                    for (int it = blockIdx.x; it < 1536; it += G) {
                        const int c = it & 255, rr = it >> 8, bh = rr * 16 + (c & 7) * 2 + (c >> 7); int j = (c >> 3) & 15; if (rr & 1) j = 15 - j;
                        const int b = bh / 12, hh = bh - b * 12;
                        const bf16_t* Zb = Z + (size_t)b * SEQ * NZ1;
                        AttnArgs a; a.Q = Zb + hh * 128; a.K = Zb + 1536 + hh * 128; a.V = Zb + 3072 + hh * 128; a.G = Zb + gate_off + hh * 128; a.O = BR + (size_t)b * SEQ * DM + hh * 128;
                        a.ldq = NZ1; a.ldkv = NZ1; a.ldg = NZ1; a.ldo = DM; a.q0 = 256 * j; a.ntiles = 4 * j + 4; a.c = LS + (size_t)b * SEQ * 16 + hh; a.lutsrc = nullptr; a.subg = nullptr;
                        a.sc = 0.08838834764831845f * LOG2E; a.lam = 0.f; a.outmul = 1.f; a.m2 = 11.3137085f * gqm * gkm * 1.01f * LOG2E;
                        attn_item<1>(lds, a, tid);
                    }
                } else {
                    const float d01 = gx[17], d23 = gx[18];
                    const float lam_init = 0.8f - 0.6f * expf(-0.3f * (float)L);
                    const float lam_val = expf(d01) - expf(d23) + lam_init;
                    const float bmax = gx[16];
                    const float m2_diff = (8.f * gqm * gkm * 1.01f + bmax) * LOG2E;
                    for (int it = blockIdx.x; it < 3072; it += G) {
                        const int c = it & 255, rr = it >> 8, bh = rr * 8 + (c & 7); int j = c >> 3; if (rr & 1) j = 31 - j;
                        const int b = bh / 12, hh = bh - b * 12;
                        const bf16_t* Zb = Z + (size_t)b * SEQ * NZ2;
                        AttnArgs a; a.Q = Zb + hh * 128; a.K = Zb + 1536 + hh * 128; a.V = Zb + 3072 + hh * 128; a.G = Zb + gate_off + hh * 128; a.O = BR + (size_t)b * SEQ * DM + hh * 128;
                        a.ldq = NZ2; a.ldkv = NZ2; a.ldg = NZ2; a.ldo = DM; a.q0 = 128 * j; a.ntiles = 2 * j + 2; a.c = nullptr; a.lutsrc = P.rel_bias + hh; a.subg = P.c_subln_g;
                        a.sc = 0.125f * LOG2E; a.lam = lam_val; a.outmul = 1.f - lam_init; a.m2 = m2_diff;
                        attn_item<2>(lds, a, tid);
                    }
                }
#ifdef REP_MEM
                for (int rep_ = 0; rep_ < 2; ++rep_)
#endif
                for (int it = blockIdx.x; it < 512; it += G) {
                    const int qb = it & 15, hm = (it >> 4) & 3, b = it >> 6;
                    const bf16_t* Zb = Z + (size_t)b * SEQ * NZ;
                    AttnArgs a; a.Q = Zb + memq_off + hm * 128; a.K = KVM + (size_t)b * NMEM * 4096 + L * 1024 + hm * 128; a.V = a.K + 512; a.G = Zb + gate_off + 1536 + hm * 128;
                    a.O = BR + (size_t)b * SEQ * DM + 1536 + hm * 128;
                    a.ldq = NZ; a.ldkv = 4096; a.ldg = NZ; a.ldo = DM; a.q0 = 256 * qb; a.ntiles = 4; a.c = nullptr; a.lutsrc = nullptr; a.subg = nullptr;
                    a.sc = 0.08838834764831845f * LOG2E; a.lam = 0.f; a.outmul = 1.f; a.m2 = m2_mem;
                    attn_item<0>(lds, a, tid);
                }
                __syncthreads();
            } else {
                pg8::Gemm g{BR, WOUT + (size_t)L * DM * DM, NTOK, DM, DM};
                EpiOut E{L == 0 ? P.x : P.out, P.out, HB, (L + 1 < NLAYER) ? SSQ + (size_t)(L + 1) * NTOK : nullptr};
#ifdef REP_OUT0
                if (redo) E.ssq = nullptr;
#endif
                pg8::StaticOrder S; S.init(g.M, g.N, G, (int)blockIdx.x);
                pg8::gemm_phase<EpiOut, pg8::StaticOrder, true, true>(lds, g, S, E, tid);
            }
        }
#ifdef REP_P0
        if (ph == 0 && !redo) { redo = 1; __syncthreads(); --ph; continue; }
        redo = 0;
#endif
#ifdef REP_OUT0
        if (ph == 3 && !redo) { redo = 1; __syncthreads(); --ph; continue; }
        redo = 0;
#endif
#ifdef REP_SUB
        if (ph > 0 && (ph - 1) % 3 == REP_SUB && ((REP_L >> ((ph - 1) / 3)) & 1) && !redo) { redo = 1; __syncthreads(); --ph; continue; }
        redo = 0;
#endif
        if (ph + 1 < P.ph_hi) { if (ph == 0) grid.sync(); else grid_bar((unsigned*)(ws + WS_GT) + 4096, (unsigned)ph, tid); }
#ifdef REP_SYNC
        if (ph == 0) for (int i_ = 0; i_ < 10; ++i_) grid.sync();
#endif
#ifdef REP_BAR
        if (ph == 0) { for (int i_ = 0; i_ < 10; ++i_) grid_bar((unsigned*)(ws + WS_GT) + 8192, (unsigned)(i_ + 1), tid); }
#endif
    }
}

extern "C" void kernel_launch(void* const* d_in, const int* in_sizes, int n_in, void* d_out, int out_size, void* d_ws, size_t ws_size, hipStream_t stream) {
    static int grid = 0;
    if (grid == 0) {
        if (n_in != 23 || ws_size < WS_END) { fprintf(stderr, "kernel_launch: unexpected inputs (n_in %d, ws %zu)\n", n_in, ws_size); grid = -1; return; }
        int dev = 0, cus = 0, per_cu = 0;
        hipGetDevice(&dev); hipDeviceGetAttribute(&cus, hipDeviceAttributeMultiprocessorCount, dev);
        if (hipFuncSetAttribute((const void*)mk_fwd, hipFuncAttributeMaxDynamicSharedMemorySize, LDS_BYTES) != hipSuccess) fprintf(stderr, "kernel_launch: hipFuncSetAttribute failed\n");
        if (hipOccupancyMaxActiveBlocksPerMultiprocessor(&per_cu, (const void*)mk_fwd, 512, LDS_BYTES) != hipSuccess || per_cu < 1) { fprintf(stderr, "kernel_launch: occupancy query says %d\n", per_cu); per_cu = 1; }
        (void)hipGetLastError();
        grid = cus * per_cu;
        fprintf(stderr, "kernel_launch: grid %d (cus %d x %d)\n", grid, cus, per_cu);
    }
    if (grid < 0) return;
    Params p{};
    const float** pp = (const float**)&p;
    for (int i = 0; i < 23; ++i) pp[i] = (const float*)d_in[i];
    p.out = (float*)d_out; p.ws = (unsigned char*)d_ws;
#if MK_PER_PHASE
    for (int ph = 0; ph < NPHASE; ++ph) { p.ph_lo = ph; p.ph_hi = ph + 1; hipLaunchKernelGGL(mk_fwd, dim3(grid), dim3(512), LDS_BYTES, stream, p); }
#else
    p.ph_lo = 0; p.ph_hi = NPHASE;
    void* args[] = {&p};
    hipError_t e = hipLaunchCooperativeKernel((void*)mk_fwd, dim3(grid), dim3(512), args, LDS_BYTES, stream);
    if (e != hipSuccess) fprintf(stderr, "cooperative launch failed: %s (grid %d)\n", hipGetErrorString(e), grid);
#endif
}
```

```cpp
#include <hip/hip_runtime.h>
#include <hip/hip_cooperative_groups.h>
#include <cstdio>
#include <cstdint>
namespace cg = cooperative_groups;
namespace pg8 {
#define PG8_LAS __attribute__((address_space(3)))
typedef unsigned short bf16_t;
typedef short bf16x8 __attribute__((ext_vector_type(8)));
typedef float f32x4 __attribute__((ext_vector_type(4)));
typedef unsigned u32x4 __attribute__((ext_vector_type(4)));
constexpr int BM = 256, BK = 64, HALF = 128, HTB = HALF * BK * 2  , STAGE_BYTES = 8 * HTB, NXCD = 8, WGM = 8;

__host__ __device__ __forceinline__ int lds_byte(int r, int c) { const int st = (r >> 4) * 2 + (c >> 5), rr = r & 15, cc = c & 31, ob = rr * 64 + cc * 2; return st * 1024 + (ob ^ (((ob >> 9) & 1) << 5)); }
__host__ __device__ __forceinline__ void stage_rc(int b, int& R, int& C) { const int st = b / 1024, sb = b % 1024, swz = sb ^ (((sb >> 9) & 1) << 5); R = (st >> 1) * 16 + swz / 64; C = (st & 1) * 32 + (swz % 64) / 2; }
__host__ __device__ __forceinline__ int perm32(int rho) { const int n = rho >> 4, i = rho & 15; return 8 * (i >> 2) + 4 * n + (i & 3); }

struct Unit { int pm, pn; };
struct Gemm { const bf16_t* A; const bf16_t* Bt; int M, N, K; };

struct StaticOrder {
    int nM, nN, nwg, G, c;
    __host__ __device__ void init(int M, int N, int G_, int c_) { nM = M / BM; nN = N / BM; nwg = nM * nN; G = G_; c = c_; }
    __host__ __device__ bool next(int i, Unit& u) const {
        const long L = (long)i * G + c; if (L >= nwg) return false;
        int wgid = (int)L; { const int q = nwg / NXCD, r = nwg % NXCD, xcd = wgid % NXCD, off = wgid / NXCD; wgid = (xcd < r ? xcd * (q + 1) : r * (q + 1) + (xcd - r) * q) + off; }
        const int nig = WGM * nN, gid = wgid / nig, fm = gid * WGM, gsz = (nM - fm) < WGM ? (nM - fm) : WGM;
        u.pm = fm + ((wgid % nig) % gsz); u.pn = (wgid % nig) / gsz; return true;
    }
    __device__ __forceinline__ void a_ready(const Unit&) const {}
    __device__ __forceinline__ void done(const Unit&) const {}
};
__device__ __forceinline__ unsigned cvt_pk_bf16(float lo, float hi) { unsigned r; asm volatile("v_cvt_pk_bf16_f32 %0, %1, %2" : "=v"(r) : "v"(lo), "v"(hi)); return r; }
template <class Epi, class Sched, bool ALIGN_EPI = false, bool SP2 = false>
__device__ __forceinline__ void gemm_phase(PG8_LAS unsigned char* lds, const Gemm g, const Sched& S, const Epi& E, const int tid) {
    const int wid = __builtin_amdgcn_readfirstlane(tid >> 6), lane = tid & 63, wr = wid >> 2, wc = wid & 3, fr = lane & 15, fq = lane >> 4;
    const int K = g.K, nt = K / BK;
    unsigned voffA[2], voffB[2];
#pragma unroll
    for (int i = 0; i < 2; ++i) { int R, C; stage_rc(tid * 16 + i * 8192, R, C); const int Rb = Epi::PERM ? ((R & ~31) + perm32(R & 31)) : R;
        voffA[i] = (unsigned)(R * K + C) * 2u; voffB[i] = (unsigned)(Rb * K + C) * 2u; }
    const size_t kstep = (size_t)(BK * 2);
    const size_t hstep = (size_t)HALF * K * 2;
    const size_t tstep = 2 * hstep;
    const unsigned ldsw = (unsigned)wid * 1024u;
    const int aoff = lds_byte(wr * 64 + fr, fq * 8), boff = lds_byte(wc * 32 + fr, fq * 8);
#define PG8_SA(b, h) (((b) * 2 + (h)) * HTB)
#define PG8_SB(b, h) ((4 + (b) * 2 + (h)) * HTB)
#define PG8_STAGE(bufoff, gbase, voff) do { _Pragma("unroll") for (int _i = 0; _i < 2; ++_i) \
        __builtin_amdgcn_global_load_lds((const unsigned*)((const char*)(gbase) + (voff)[_i]), (PG8_LAS unsigned*)(lds + (bufoff) + ldsw + _i * 8192), 16, 0, 0); } while (0)
#define PG8_LDA(dst, b, h) do { _Pragma("unroll") for (int m = 0; m < 4; ++m) _Pragma("unroll") for (int k = 0; k < 2; ++k) dst[m][k] = *(const PG8_LAS bf16x8*)(lds + PG8_SA(b, h) + aoff + m * 2048 + k * 1024); } while (0)
#define PG8_LDB(dst, b, h) do { _Pragma("unroll") for (int n = 0; n < 2; ++n) _Pragma("unroll") for (int k = 0; k < 2; ++k) dst[n][k] = *(const PG8_LAS bf16x8*)(lds + PG8_SB(b, h) + boff + n * 2048 + k * 1024); } while (0)
#define PG8_MMA(ai, bj, At, Bt) do { __builtin_amdgcn_s_setprio(1); _Pragma("unroll") for (int m = 0; m < 4; ++m) _Pragma("unroll") for (int n = 0; n < 2; ++n) _Pragma("unroll") for (int k = 0; k < 2; ++k) \
        acc[ai][bj][m][n] = __builtin_amdgcn_mfma_f32_16x16x32_bf16(Bt[n][k], At[m][k], acc[ai][bj][m][n], 0, 0, 0); __builtin_amdgcn_s_setprio(0); } while (0)
#define PG8_WAIT_V(n) asm volatile("s_waitcnt vmcnt(" #n ")" ::: "memory")
#define PG8_WAIT_L(n) asm volatile("s_waitcnt lgkmcnt(" #n ")" ::: "memory")
#define PG8_BAR __builtin_amdgcn_s_barrier()
#define PG8_SCHED __builtin_amdgcn_sched_barrier(0)
    Unit cur, nxt; int ui = 0;
    if (!S.next(0, cur)) return;
    f32x4 acc[2][2][4][2];
#pragma unroll
    for (int a = 0; a < 2; ++a)
#pragma unroll
        for (int b = 0; b < 2; ++b)
#pragma unroll
            for (int m = 0; m < 4; ++m)
#pragma unroll
                for (int n = 0; n < 2; ++n) acc[a][b][m][n] = (f32x4){0.f, 0.f, 0.f, 0.f};
    bf16x8 At[4][2], B0[2][2], B1[2][2];
    const char* cA = (const char*)g.A + (size_t)cur.pm * tstep; const char* cB = (const char*)g.Bt + (size_t)cur.pn * tstep;
    S.a_ready(cur);
    if constexpr (SP2) {
        PG8_STAGE(PG8_SB(0, 0), cB, voffB); PG8_STAGE(PG8_SB(0, 1), cB + hstep, voffB); PG8_STAGE(PG8_SA(0, 0), cA, voffA); PG8_STAGE(PG8_SA(0, 1), cA + hstep, voffA);
        if (wr == 1) PG8_BAR;
        PG8_WAIT_V(2); PG8_BAR;
        PG8_STAGE(PG8_SB(1, 0), cB + kstep, voffB); PG8_STAGE(PG8_SA(1, 0), cA + kstep, voffA); PG8_STAGE(PG8_SB(1, 1), cB + hstep + kstep, voffB);
        PG8_WAIT_V(6); PG8_BAR;
    } else {
        PG8_STAGE(PG8_SB(0, 0), cB, voffB); PG8_STAGE(PG8_SA(0, 0), cA, voffA); PG8_STAGE(PG8_SB(0, 1), cB + hstep, voffB); PG8_STAGE(PG8_SA(0, 1), cA + hstep, voffA);
        if (wr == 1) PG8_BAR;
        PG8_WAIT_V(4); PG8_BAR;
        PG8_STAGE(PG8_SB(1, 0), cB + kstep, voffB); PG8_STAGE(PG8_SA(1, 0), cA + kstep, voffA); PG8_STAGE(PG8_SB(1, 1), cB + hstep + kstep, voffB);
        PG8_WAIT_V(6); PG8_BAR;
    }
    for (;;) {
        const bool has_next = S.next(ui + 1, nxt);
        const char* nA = has_next ? (const char*)g.A + (size_t)nxt.pm * tstep : cA; const char* nB = has_next ? (const char*)g.Bt + (size_t)nxt.pn * tstep : cB;
        for (int t = 0; t < nt; t += 2) {
            const bool last = (t == nt - 2);
            const char* a1 = cA + (size_t)(t + 1) * kstep;
            const char* a2 = last ? nA : cA + (size_t)(t + 2) * kstep; const char* b2 = last ? nB : cB + (size_t)(t + 2) * kstep;
            const char* a3 = a2 + kstep; const char* b3 = b2 + kstep;
            if (last && has_next) S.a_ready(nxt);
            if constexpr (SP2) {
            PG8_LDB(B0, 0, 0); PG8_LDB(B1, 0, 1); PG8_SCHED; PG8_LDA(At, 0, 0); PG8_STAGE(PG8_SA(1, 1), a1 + hstep, voffA);
            PG8_WAIT_V(8); PG8_WAIT_L(0); PG8_BAR; PG8_MMA(0, 0, At, B0); PG8_MMA(0, 1, At, B1); PG8_BAR; PG8_SCHED;
            PG8_LDA(At, 0, 1); PG8_STAGE(PG8_SB(0, 0), b2, voffB); PG8_STAGE(PG8_SB(0, 1), b2 + hstep, voffB); PG8_STAGE(PG8_SA(0, 0), a2, voffA);
            PG8_WAIT_V(8); PG8_WAIT_L(0); PG8_BAR; PG8_MMA(1, 0, At, B0); PG8_MMA(1, 1, At, B1); PG8_BAR; PG8_SCHED;
            PG8_LDB(B0, 1, 0); PG8_LDB(B1, 1, 1); PG8_SCHED; PG8_LDA(At, 1, 0); PG8_STAGE(PG8_SA(0, 1), a2 + hstep, voffA);
            PG8_WAIT_V(8); PG8_WAIT_L(0); PG8_BAR; PG8_MMA(0, 0, At, B0); PG8_MMA(0, 1, At, B1); PG8_BAR; PG8_SCHED;
            PG8_LDA(At, 1, 1); PG8_STAGE(PG8_SB(1, 0), b3, voffB); PG8_STAGE(PG8_SB(1, 1), b3 + hstep, voffB); PG8_STAGE(PG8_SA(1, 0), a3, voffA);
            PG8_WAIT_V(8); PG8_WAIT_L(0); PG8_BAR; PG8_MMA(1, 0, At, B0); PG8_MMA(1, 1, At, B1); PG8_BAR; PG8_SCHED;
            } else {
            PG8_LDB(B0, 0, 0); PG8_SCHED; PG8_LDA(At, 0, 0); PG8_STAGE(PG8_SA(1, 1), a1 + hstep, voffA);
            PG8_WAIT_L(8); PG8_BAR; PG8_WAIT_L(0); PG8_MMA(0, 0, At, B0); PG8_BAR; PG8_SCHED;
            PG8_LDB(B1, 0, 1); PG8_STAGE(PG8_SB(0, 0), b2, voffB);
            PG8_BAR; PG8_WAIT_L(0); PG8_MMA(0, 1, At, B1); PG8_BAR;
            PG8_LDA(At, 0, 1); PG8_STAGE(PG8_SA(0, 0), a2, voffA);
            PG8_BAR; PG8_WAIT_L(0); PG8_MMA(1, 0, At, B0); PG8_BAR; PG8_SCHED;
            PG8_STAGE(PG8_SB(0, 1), b2 + hstep, voffB);
            PG8_WAIT_V(6); PG8_BAR; PG8_MMA(1, 1, At, B1); PG8_BAR;
            PG8_LDB(B0, 1, 0); PG8_SCHED; PG8_LDA(At, 1, 0); PG8_STAGE(PG8_SA(0, 1), a2 + hstep, voffA);
            PG8_WAIT_L(8); PG8_BAR; PG8_WAIT_L(0); PG8_MMA(0, 0, At, B0); PG8_BAR; PG8_SCHED;
            PG8_LDB(B1, 1, 1); PG8_STAGE(PG8_SB(1, 0), b3, voffB);
            PG8_BAR; PG8_WAIT_L(0); PG8_MMA(0, 1, At, B1); PG8_BAR;
            PG8_LDA(At, 1, 1); PG8_STAGE(PG8_SA(1, 0), a3, voffA);
            PG8_BAR; PG8_WAIT_L(0); PG8_MMA(1, 0, At, B0); PG8_BAR; PG8_SCHED;
            PG8_STAGE(PG8_SB(1, 1), b3 + hstep, voffB);
            PG8_WAIT_V(6); PG8_BAR; PG8_MMA(1, 1, At, B1); PG8_BAR;
            }
        }
        if constexpr (ALIGN_EPI) { if (wr == 0) PG8_BAR; }
        if constexpr (!Epi::AFTER_DRAIN) { E(acc, cur, wr, wc, fr, fq); S.done(cur); }
        if (!has_next) break;
#pragma unroll
        for (int a = 0; a < 2; ++a)
#pragma unroll
            for (int b = 0; b < 2; ++b)
#pragma unroll
                for (int m = 0; m < 4; ++m)
#pragma unroll
                    for (int n = 0; n < 2; ++n) acc[a][b][m][n] = (f32x4){0.f, 0.f, 0.f, 0.f};
        cur = nxt; cA = nA; cB = nB; ++ui;
        if constexpr (ALIGN_EPI) { if (wr == 1) PG8_BAR; }
    }
    PG8_WAIT_V(0);
    if constexpr (!ALIGN_EPI) { if (wr == 0) PG8_BAR; }
    PG8_BAR;
    if constexpr (Epi::AFTER_DRAIN) { E.fused(acc, cur, wr, wc, fr, fq, lds, wid, lane); S.done(cur); }
#undef PG8_SA
#undef PG8_SB
#undef PG8_STAGE
#undef PG8_LDA
#undef PG8_LDB
#undef PG8_MMA
#undef PG8_WAIT_V
#undef PG8_WAIT_L
#undef PG8_BAR
#undef PG8_SCHED
}
}
using pg8::bf16_t; using pg8::bf16x8; using pg8::f32x4; using pg8::u32x4; using pg8::cvt_pk_bf16;
#define LAS __attribute__((address_space(3)))
typedef short s16x4 __attribute__((ext_vector_type(4)));
typedef float f32x16 __attribute__((ext_vector_type(16)));
typedef unsigned u32x2 __attribute__((ext_vector_type(2)));
#define MFMA32(a, b, c) __builtin_amdgcn_mfma_f32_32x32x16_bf16((a), (b), (c), 0, 0, 0)

constexpr int DM = 2048, NB = 8, SEQ = 4096, NTOK = NB * SEQ, NMEM = 256, NLAYER = 4;
constexpr int NZ0 = 5632, NZ1 = 7424, NZ2 = 7168, NSRC1 = 7180;
constexpr float LOG2E = 1.4426950408889634f;
constexpr float EPS = 1e-6f;
constexpr size_t MiB = 1u << 20;
constexpr size_t WS_WIN0 = 0, WS_WIN1 = 22 * MiB, WS_WIN2 = 51 * MiB, WS_WIN3 = 79 * MiB, WS_WOUT = 101 * MiB, WS_WKV = 133 * MiB, WS_MEMN = 149 * MiB,
                 WS_KVM = 157 * MiB, WS_LS = 173 * MiB, WS_SSQ = 175 * MiB, WS_GT = 176 * MiB, WS_HB = 177 * MiB, WS_BR = 305 * MiB, WS_Z = 433 * MiB, WS_END = 897 * MiB;
constexpr int LDS_MISC = 131072;
constexpr int LDS_PART = 131072;
constexpr int LDS_BYTES = 131072 + 8192 + 4096;

struct Params {
    const float *x, *mem, *mem_norm_g, *rel_bias, *norm_g, *w_mem_kv, *mem_q_norm_g, *mem_k_norm_g, *w_out, *a_w_in, *a_ln_g, *a_ln_b, *a_w_s, *a_b_s,
                *b_w_in, *b_b_f, *b_q_norm_g, *b_k_norm_g, *c_w_in, *c_q_norm_g, *c_k_norm_g, *c_lam, *c_subln_g;
    float* out; unsigned char* ws; int ph_lo, ph_hi;
};

__device__ __forceinline__ unsigned off_b(unsigned row, unsigned ch) { return 256u * row + 16u * (ch ^ (((row & 3u) << 2) | ((row >> 2) & 3u))); }
__device__ __forceinline__ float bf2f(unsigned short v) { return __uint_as_float(((unsigned)v) << 16); }
__device__ __forceinline__ float bflo(unsigned w) { return __uint_as_float(w << 16); }
__device__ __forceinline__ float bfhi(unsigned w) { return __uint_as_float(w & 0xffff0000u); }
__device__ __forceinline__ unsigned f2bf(float f) { unsigned u = __float_as_uint(f); return (u + 0x7fffu + ((u >> 16) & 1u)) >> 16; }
typedef float f32x2v __attribute__((ext_vector_type(2)));
typedef __bf16 bf16x2v __attribute__((ext_vector_type(2)));
__device__ __forceinline__ unsigned pk2(float lo, float hi) { const f32x2v v = {lo, hi}; return __builtin_bit_cast(unsigned, __builtin_convertvector(v, bf16x2v)); }
__device__ __forceinline__ float fast_exp2(float x) { return __builtin_amdgcn_exp2f(x); }
__device__ __forceinline__ float fast_rcp(float x) { return __builtin_amdgcn_rcpf(x); }
__device__ __forceinline__ float silu_f(float g) { return g * fast_rcp(1.f + fast_exp2(-g * LOG2E)); }
__device__ __forceinline__ float gelu_tanh_f(float x) { const float u = 0.7978845608028654f * (x + 0.044715f * x * x * x); return x * fast_rcp(1.f + fast_exp2(-2.f * LOG2E * u)); }
__device__ __forceinline__ float wave_sum(float v) {
#pragma unroll
    for (int o = 1; o < 64; o <<= 1) v += __shfl_xor(v, o);
    return v;
}

struct EpiZ {
    static constexpr bool PERM = true, AFTER_DRAIN = false;
    unsigned char* ws; LAS float* part; int ldc; int kind; int L;
    __device__ __forceinline__ void operator()(const f32x4 (&acc)[2][2][4][2], const pg8::Unit& u, int wr, int wc, int fr, int fq) const {
        asm volatile("" : "+v"(fr), "+v"(fq));
        const int lrow0 = wr * 64 + fr, row0 = u.pm * 256 + lrow0, colt = u.pn * 256, pn = u.pn;
        bf16_t* const Z = (bf16_t*)(ws + (kind == 3 ? WS_KVM : WS_Z)); float* const LS = (float*)(ws + WS_LS);
        const float* const ssq = (kind == 3) ? nullptr : (const float*)(ws + WS_SSQ) + (size_t)L * NTOK;
        const float* const gt = (const float*)(ws + WS_GT);
        const float* const bfp = gt + 2048; const float* const gq = gt + 384 * L; const float* const gk = gq + 128; const float* const gm = (kind == 3) ? gt + 1536 : gq + 256;
        if (kind == 1 && pn == 28) {
            if (wc == 0) {
#pragma unroll
                for (int ai = 0; ai < 2; ++ai)
#pragma unroll
                    for (int m = 0; m < 4; ++m) { const int row = row0 + ai * 128 + m * 16;
#pragma unroll
                        for (int n = 0; n < 2; ++n)
#pragma unroll
                            for (int j = 0; j < 4; ++j) { const int col = 8 * fq + 4 * n + j;
                                if (col < 12) { const float xv = acc[ai][0][m][n][j] * rsqrtf(ssq[row] * (1.f / DM) + EPS) + bfp[col]; LS[(size_t)row * 16 + col] = fminf(xv, 0.f) - log1pf(expf(-fabsf(xv))); } } }
            }
            return;
        }
        int W = 0; const float* g = nullptr;
        if (kind == 0) { if (pn == 12 || pn == 13) { W = 128; g = gm; } }
        else if (kind == 3) { if ((pn & 3) < 2) { W = 128; g = gm + (pn >> 2) * 128; } }
        else { if (pn < 6) { W = (kind == 1) ? 128 : 64; g = gq; } else if (pn < 12) { W = (kind == 1) ? 128 : 64; g = gk; } else if (pn == 18 || pn == 19) { W = 128; g = gm; } }
        const bool act = (kind == 0) && (pn < 12);
        f32x4 g0 = (f32x4){1.f, 1.f, 1.f, 1.f}, g1 = g0;
        if (W) {
#pragma unroll
            for (int ai = 0; ai < 2; ++ai)
#pragma unroll
                for (int m = 0; m < 4; ++m)
#pragma unroll
                    for (int bj = 0; bj < 2; ++bj) { const f32x4 a0 = acc[ai][bj][m][0], a1 = acc[ai][bj][m][1];
                        float ss = (a0[0] * a0[0] + a0[1] * a0[1]) + (a0[2] * a0[2] + a0[3] * a0[3]) + (a1[0] * a1[0] + a1[1] * a1[1]) + (a1[2] * a1[2] + a1[3] * a1[3]);
                        ss += __shfl_xor(ss, 16); ss += __shfl_xor(ss, 32);
                        if (fq == 0) part[(lrow0 + ai * 128 + m * 16) * 8 + bj * 4 + wc] = ss; }
            asm volatile("s_waitcnt lgkmcnt(0)" ::: "memory"); __builtin_amdgcn_s_barrier(); asm volatile("" ::: "memory");
            const float* gp = g + ((32 * wc + 8 * fq) & (W - 1));
            g0 = *(const f32x4*)gp; g1 = *(const f32x4*)(gp + 4);
        }
        const float invW = W ? 1.f / (float)W : 0.f;
        const int col0 = colt + wc * 32 + 8 * fq;
#pragma unroll
        for (int ai = 0; ai < 2; ++ai) {
            float rsv[4];
#pragma unroll
            for (int m = 0; m < 4; ++m) rsv[m] = ssq ? rsqrtf(ssq[row0 + ai * 128 + m * 16] * (1.f / DM) + EPS) : 1.f;
#pragma unroll
            for (int m = 0; m < 4; ++m) { bf16_t* rowp = Z + (size_t)(row0 + ai * 128 + m * 16) * ldc + col0;
                const float rs = rsv[m];
#pragma unroll
                for (int bj = 0; bj < 2; ++bj) { float mm = rs;
                    if (W) { const f32x4 pp = *(const LAS f32x4*)(part + (lrow0 + ai * 128 + m * 16) * 8 + bj * 4);
                        const float tot = (W == 128) ? ((pp[0] + pp[1]) + (pp[2] + pp[3])) : (wc < 2 ? pp[0] + pp[1] : pp[2] + pp[3]);
                        mm = rs * rsqrtf(tot * rs * rs * invW + EPS); }
                    f32x4 v0 = acc[ai][bj][m][0] * mm * g0, v1 = acc[ai][bj][m][1] * mm * g1;
                    if (act) {
#pragma unroll
                        for (int j = 0; j < 4; ++j) { v0[j] = gelu_tanh_f(v0[j]); v1[j] = gelu_tanh_f(v1[j]); } }
                    u32x4 w; w.x = cvt_pk_bf16(v0[0], v0[1]); w.y = cvt_pk_bf16(v0[2], v0[3]); w.z = cvt_pk_bf16(v1[0], v1[1]); w.w = cvt_pk_bf16(v1[2], v1[3]);
                    *(u32x4*)(rowp + bj * 128) = w; } } }
    }
};
struct EpiOut {
    static constexpr bool PERM = false, AFTER_DRAIN = false;
    const float* Xin; float* Out; bf16_t* HBo; float* ssq;
    __device__ __forceinline__ void operator()(const f32x4 (&acc)[2][2][4][2], const pg8::Unit& u, int wr, int wc, int fr, int fq) const {
        asm volatile("" : "+v"(fr), "+v"(fq));
        const int row0 = u.pm * 256 + wr * 64 + fr, col0 = u.pn * 256 + wc * 32 + 4 * fq;
        f32x4 xr[3][4];
#define EO_LOAD(rr, slot) do { const size_t o_ = (size_t)(row0 + ((rr) >> 2) * 128 + ((rr) & 3) * 16) * DM + col0; _Pragma("unroll") for (int q_ = 0; q_ < 4; ++q_) xr[slot][q_] = *(const f32x4*)(Xin + o_ + (q_ >> 1) * 128 + (q_ & 1) * 16); } while (0)
        EO_LOAD(0, 0); EO_LOAD(1, 1);
#pragma unroll
        for (int rr = 0; rr < 8; ++rr) { const int ai = rr >> 2, m = rr & 3, row = row0 + ai * 128 + m * 16; const size_t o = (size_t)row * DM + col0; float s = 0.f;
            if (rr + 2 < 8) EO_LOAD(rr + 2, (rr + 2) % 3);
#pragma unroll
            for (int q = 0; q < 4; ++q) { const int bj = q >> 1, n = q & 1; const size_t idx = o + bj * 128 + n * 16; const f32x4 v = xr[rr % 3][q] + acc[ai][bj][m][n]; *(f32x4*)(Out + idx) = v;
                if (ssq) { u32x2 w; w.x = cvt_pk_bf16(v[0], v[1]); w.y = cvt_pk_bf16(v[2], v[3]); *(u32x2*)(HBo + idx) = w; s += (v[0] * v[0] + v[1] * v[1]) + (v[2] * v[2] + v[3] * v[3]); } }
            if (ssq) { s += __shfl_xor(s, 16); s += __shfl_xor(s, 32); if (fq == 0) atomicAdd(ssq + row, s); } }
#undef EO_LOAD
    }
};
#ifndef AT_KD
#define AT_KD 4
#endif
#ifndef AT_VD
#define AT_VD 3
#endif
struct AttnArgs {
    const bf16_t *Q, *K, *V, *G; bf16_t* O;
    int ldq, ldkv, ldg, ldo, q0, ntiles;
    const float* c;
    const float* lutsrc;
    const float* subg;
    float sc, lam, outmul, m2;
};
constexpr int A_CS = 65536, A_LUT = 65536 + 16384;

template <int MODE>
__device__ __forceinline__ void attn_item(LAS unsigned char* lds, const AttnArgs& a, const int tid) {
    const int wave = __builtin_amdgcn_readfirstlane(tid >> 6), lane = tid & 63, r = lane & 31, h = lane >> 5;
    constexpr int NKS = (MODE == 2) ? 4 : 8;
    const int map = (MODE == 2) ? (wave >> 2) : 0;
    const int qw0 = a.q0 + 32 * ((MODE == 2) ? (wave & 3) : wave);
    const int tw = (MODE == 0) ? (a.ntiles - 1) : (MODE == 1 ? ((qw0 + 31) >> 6) : (qw0 >> 6));
    __syncthreads();
    if (MODE == 2) {
        if (tid < 255) { const int rel = tid - 191; const int n = rel < 0 ? -rel : rel; int bkt;
            if (n < 8) bkt = n; else { const float nf = (float)n; int lg = 8 + (int)(logf(nf / 8.0f) / 2.772588722239781f * 8.0f); bkt = lg < 15 ? lg : 15; }
            if (rel > 0) bkt += 16;
            ((LAS float*)(lds + A_LUT))[tid] = a.lutsrc[bkt * 12] * LOG2E - a.m2; }
    }
    bf16x8 qf[NKS];
    { const bf16_t* qrow = a.Q + (size_t)(qw0 + r) * a.ldq + map * 64 + 8 * h;
#pragma unroll
      for (int ks = 0; ks < NKS; ++ks) qf[ks] = *(const bf16x8*)(qrow + 16 * ks); }
    if (MODE == 1) {
        LAS float* cl = (LAS float*)(lds + A_CS); LAS float* wtot = (LAS float*)(lds + A_LUT);
        const int n = a.q0 + 256; const bool on = 8 * tid < n;
        float v[8]; float run = 0.f;
        const float* lp = a.c + (size_t)(8 * tid) * 16;
#pragma unroll
        for (int e = 0; e < 8; ++e) { if (on) run += lp[e * 16]; v[e] = run; }
        float incl = run;
#pragma unroll
        for (int o = 1; o < 64; o <<= 1) { const float x = __shfl_up(incl, o); if (lane >= o) incl += x; }
        if (lane == 63) wtot[wave] = incl;
        __syncthreads();
        float pre = incl - run;
        for (int w = 0; w < wave; ++w) pre += wtot[w];
        if (on) {
#pragma unroll
            for (int e = 0; e < 8; ++e) cl[8 * tid + e] = -(pre + v[e]) * LOG2E; }
    }
    unsigned kaddr[NKS];
    { const unsigned X = ((r & 3u) << 2) | ((r >> 2) & 3u);
#pragma unroll
      for (int ks = 0; ks < NKS; ++ks) kaddr[ks] = 256u * r + 16u * ((unsigned)(2 * (map * 4 + ks) + h) ^ X); }
    unsigned vaddr[4][2];
    { const unsigned q = (lane & 15) >> 2, p = lane & 3, blk = (lane >> 4) & 1;
#pragma unroll
      for (int dt = 0; dt < 4; ++dt)
#pragma unroll
          for (int t2 = 0; t2 < 2; ++t2) vaddr[dt][t2] = 16384u + off_b(8 * t2 + 4 * h + q, 4 * dt + 2 * blk + (p >> 1)) + 8u * (p & 1); }
    const unsigned sX = ((unsigned)(lane >> 4) << 2) | (unsigned)(wave & 3);
    const size_t sgoff = (size_t)(4 * wave + (lane >> 4)) * a.ldkv + (size_t)(((unsigned)(lane & 15) ^ sX) * 8u);
    const bf16_t* kg = a.K + sgoff; const bf16_t* vg = a.V + sgoff;
    const size_t tstep = (size_t)64 * a.ldkv, hstep = (size_t)32 * a.ldkv;
#define AT_DMA1(gp, la) asm volatile("s_mov_b32 m0, %1\n\ts_nop 0\n\tglobal_load_lds_dwordx4 %0, off" :: "v"(gp), "s"(la) : "memory", "m0")
#define AT_DMA(t, b) do { const bf16_t* kp = kg + (size_t)(t) * tstep; const bf16_t* vp = vg + (size_t)(t) * tstep; const unsigned la = (unsigned)(size_t)(lds + (b) * 32768 + wave * 1024); \
        AT_DMA1(kp, la); AT_DMA1(kp + hstep, la + 8192u); AT_DMA1(vp, la + 16384u); AT_DMA1(vp + hstep, la + 16384u + 8192u); } while (0)
    float l = 0.f;
    f32x16 o[4];
#pragma unroll
    for (int dt = 0; dt < 4; ++dt)
#pragma unroll
        for (int i = 0; i < 16; ++i) o[dt][i] = 0.f;
    AT_DMA(0, 0);
    asm volatile("s_waitcnt vmcnt(0)" ::: "memory");
    __syncthreads();
#pragma unroll
    for (int ks = 0; ks < NKS; ++ks) asm volatile("" : "+v"(qf[ks]));
    float b15 = 0.f; if (MODE == 2) b15 = ((LAS float*)(lds + A_LUT))[0];
    float addc = -a.m2; if (MODE == 1) addc = -((LAS float*)(lds + A_CS))[qw0 + r] - a.m2; if (MODE == 2) addc = b15;
    const int nt = a.ntiles;
    for (int tt2 = 0; tt2 < nt; tt2 += 2)
#pragma unroll
    for (int bb = 0; bb < 2; ++bb) {
        const int t = tt2 + bb;
        constexpr int dummy_ = 0; (void)dummy_;
        const int b = bb;
        if (t + 1 < nt) AT_DMA(t + 1, b ^ 1);
        if (t <= tw) {
            LAS unsigned char* kb = lds + b * 32768;
            f32x16 s[2];
#pragma unroll
            for (int i = 0; i < 16; ++i) { s[0][i] = 0.f; s[1][i] = 0.f; }
            constexpr int KD = AT_KD, VD = AT_VD;
            bf16x8 kf[KD];
#define AT_KLD(i) (*(LAS bf16x8*)(kb + kaddr[(i) >> 1] + ((i) & 1) * 8192))
#pragma unroll
            for (int i = 0; i < KD; ++i) kf[i] = AT_KLD(i);
#pragma unroll
            for (int i = 0; i < 2 * NKS; ++i) { s[i & 1] = MFMA32(kf[i % KD], qf[i >> 1], s[i & 1]); if (i + KD < 2 * NKS) kf[i % KD] = AT_KLD(i + KD); }
#undef AT_KLD
            bf16x8 vf[VD];
#define AT_VLD(j) do { const s16x4 lo_ = __builtin_amdgcn_ds_read_tr16_b64_v4i16((LAS s16x4*)(kb + vaddr[(j) & 3][0] + (32 * ((j) >> 3) + 16 * (((j) >> 2) & 1)) * 256)); \
                const s16x4 hi_ = __builtin_amdgcn_ds_read_tr16_b64_v4i16((LAS s16x4*)(kb + vaddr[(j) & 3][1] + (32 * ((j) >> 3) + 16 * (((j) >> 2) & 1)) * 256)); \
                vf[(j) % VD] = __builtin_shufflevector(lo_, hi_, 0, 1, 2, 3, 4, 5, 6, 7); } while (0)
#pragma unroll
            for (int j = 0; j < VD; ++j) AT_VLD(j);
            const float sc = a.sc;
            const bool diag = (MODE == 1) && (t * 64 + 63 > qw0);
            const bool near = (MODE == 2) && (t >= tw - 2);
            bf16x8 pf[2];
#pragma unroll
            for (int kt = 0; kt < 2; ++kt) {
                if (MODE == 1) {
                    const LAS float* csb = (const LAS float*)(lds + A_CS) + t * 64 + 32 * kt + 4 * h;
                    const int mb = t * 64 + 32 * kt + 4 * h - (qw0 + r);
#pragma unroll
                    for (int g = 0; g < 4; ++g) { const f32x4 cv = *(const LAS f32x4*)(csb + 8 * g);
#pragma unroll
                        for (int e = 0; e < 4; ++e) { float x = fmaf(s[kt][4 * g + e], sc, addc) + cv[e]; if (diag && (mb + 8 * g + e > 0)) x = -1e30f; s[kt][4 * g + e] = x; } }
                } else if (MODE == 2) {
                    if (near) {
                        const LAS float* lut = (const LAS float*)(lds + A_LUT) + (t * 64 + 32 * kt + 4 * h - (qw0 + r) + 191);
#pragma unroll
                        for (int i = 0; i < 16; ++i) s[kt][i] = fmaf(s[kt][i], sc, lut[8 * (i >> 2) + (i & 3)]);
                    } else {
#pragma unroll
                        for (int i = 0; i < 16; ++i) s[kt][i] = fmaf(s[kt][i], sc, addc);
                    }
                } else {
#pragma unroll
                    for (int i = 0; i < 16; ++i) s[kt][i] = fmaf(s[kt][i], sc, addc);
                }
                float ls = 0.f;
#pragma unroll
                for (int i = 0; i < 16; ++i) { const float pv = fast_exp2(s[kt][i]); s[kt][i] = pv; ls += pv; }
                l += ls;
#pragma unroll
                for (int ss = 0; ss < 2; ++ss) { u32x4 w;
                    w.x = pk2(s[kt][8 * ss + 0], s[kt][8 * ss + 1]); w.y = pk2(s[kt][8 * ss + 2], s[kt][8 * ss + 3]);
                    w.z = pk2(s[kt][8 * ss + 4], s[kt][8 * ss + 5]); w.w = pk2(s[kt][8 * ss + 6], s[kt][8 * ss + 7]);
                    pf[ss] = __builtin_bit_cast(bf16x8, w); }
#pragma unroll
                for (int jj = 0; jj < 8; ++jj) { const int j = 8 * kt + jj;
                    o[jj & 3] = MFMA32(vf[j % VD], pf[jj >> 2], o[jj & 3]);
                    if (j + VD < 16) AT_VLD(j + VD); }
            }
#undef AT_VLD
        }
        asm volatile("s_waitcnt vmcnt(0)" ::: "memory");
        __syncthreads();
    }
#undef AT_DMA
#undef AT_DMA1
    l += __shfl_xor(l, 32);
    const float inv = 1.f / l;
    const size_t qrow = (size_t)(qw0 + r);
    u32x2 gwv[16];
#pragma unroll
    for (int k = 0; k < 16; ++k) gwv[k] = *(const u32x2*)(a.G + qrow * a.ldg + 32 * (k >> 2) + 8 * (k & 3) + 4 * h);
    if (MODE != 2) {
#pragma unroll
        for (int dt = 0; dt < 4; ++dt)
#pragma unroll
            for (int g = 0; g < 4; ++g) { const int d = 32 * dt + 8 * g + 4 * h;
                const u32x2 gw = gwv[dt * 4 + g];
                const float v0 = o[dt][4 * g + 0] * inv * silu_f(bflo(gw.x)), v1 = o[dt][4 * g + 1] * inv * silu_f(bfhi(gw.x));
                const float v2 = o[dt][4 * g + 2] * inv * silu_f(bflo(gw.y)), v3 = o[dt][4 * g + 3] * inv * silu_f(bfhi(gw.y));
                u32x2 w; w.x = pk2(v0, v1); w.y = pk2(v2, v3);
                *(u32x2*)(a.O + qrow * a.ldo + d) = w; }
    } else {
        LAS float* xb = (LAS float*)(lds + (wave & 3) * 16384);
        if (map == 1) {
            const float f = inv * a.lam;
#pragma unroll
            for (int dt = 0; dt < 4; ++dt)
#pragma unroll
                for (int i = 0; i < 16; ++i) xb[(dt * 16 + i) * 64 + lane] = o[dt][i] * f;
        }
        __syncthreads();
        if (map == 0) {
            float ssq = 0.f;
#pragma unroll
            for (int dt = 0; dt < 4; ++dt)
#pragma unroll
                for (int i = 0; i < 16; ++i) { const float v = o[dt][i] * inv - xb[(dt * 16 + i) * 64 + lane]; o[dt][i] = v; ssq += v * v; }
            ssq += __shfl_xor(ssq, 32);
            const float rn = rsqrtf(ssq * (1.f / 128.f) + EPS) * a.outmul;
#pragma unroll
            for (int dt = 0; dt < 4; ++dt)
#pragma unroll
                for (int g = 0; g < 4; ++g) { const int d = 32 * dt + 8 * g + 4 * h;
                    const u32x2 gw = gwv[dt * 4 + g];
                    const f32x4 sg = *(const f32x4*)(a.subg + d);
                    const float v0 = o[dt][4 * g + 0] * rn * sg[0] * silu_f(bflo(gw.x)), v1 = o[dt][4 * g + 1] * rn * sg[1] * silu_f(bfhi(gw.x));
                    const float v2 = o[dt][4 * g + 2] * rn * sg[2] * silu_f(bflo(gw.y)), v3 = o[dt][4 * g + 3] * rn * sg[3] * silu_f(bfhi(gw.y));
                    u32x2 w; w.x = pk2(v0, v1); w.y = pk2(v2, v3);
                    *(u32x2*)(a.O + qrow * a.ldo + d) = w; }
        }
    }
}
__device__ __forceinline__ void tr_item(const float* W, int N, bf16_t* WT, int item, int lane, LAS float* scr, int fox, const float* gk) {
    const int nblk = (N + 31) >> 5, kb = item / nblk, nb = item - kb * nblk, k0 = 64 * kb, n0 = 32 * nb;
    const int nq = lane & 7, kr = lane >> 3, nc = n0 + 4 * nq;
    f32x4 wv[8];
#pragma unroll
    for (int i = 0; i < 8; ++i) wv[i] = (nc < N) ? *(const f32x4*)(W + (size_t)(k0 + kr + 8 * i) * N + nc) : (f32x4){0.f, 0.f, 0.f, 0.f};
#pragma unroll
    for (int i = 0; i < 8; ++i) { const int kk = kr + 8 * i; const float gg = gk ? gk[k0 + kk] : 1.f;
#pragma unroll
        for (int e2 = 0; e2 < 4; ++e2) scr[kk * 33 + 4 * nq + e2] = wv[i][e2] * gg; }
    asm volatile("s_waitcnt lgkmcnt(0)" ::: "memory");
    const int c = lane & 7;
#pragma unroll
    for (int j = 0; j < 4; ++j) { const int nl = (lane >> 3) + 8 * j, n = n0 + nl; const LAS float* s = scr + (8 * c) * 33 + nl;
        if (n < N) { int nd = n; if (fox) { if (n >= 4620) nd = n - 12; else if (n >= 4608) nd = n - 4608 + 7168; }
            u32x4 o; o.x = pk2(s[0 * 33], s[1 * 33]); o.y = pk2(s[2 * 33], s[3 * 33]); o.z = pk2(s[4 * 33], s[5 * 33]); o.w = pk2(s[6 * 33], s[7 * 33]);
            *(u32x4*)(WT + (size_t)nd * DM + k0 + 8 * c) = o; } }
    asm volatile("s_waitcnt lgkmcnt(0)" ::: "memory");
}
__device__ __forceinline__ void rms_row_to_bf16(const float* xrow, const float* g, bf16_t* orow, int lane) {
    const f32x4* xr = (const f32x4*)xrow + lane; const f32x4* gr = (const f32x4*)g + lane;
    f32x4 v[8]; float s = 0.f;
#pragma unroll
    for (int j = 0; j < 8; ++j) { v[j] = xr[64 * j]; s += (v[j][0] * v[j][0] + v[j][1] * v[j][1]) + (v[j][2] * v[j][2] + v[j][3] * v[j][3]); }
    const float rstd = rsqrtf(wave_sum(s) * (1.f / DM) + EPS);
    u32x2* o8 = (u32x2*)orow + lane;
#pragma unroll
    for (int j = 0; j < 8; ++j) { const f32x4 gg = gr[64 * j]; u32x2 w; w.x = pk2(v[j][0] * rstd * gg[0], v[j][1] * rstd * gg[1]); w.y = pk2(v[j][2] * rstd * gg[2], v[j][3] * rstd * gg[3]); o8[64 * j] = w; }
}
__device__ __forceinline__ void row_to_bf16_ssq(const float* xrow, bf16_t* orow, float* ssq, int lane) {
    const f32x4* xr = (const f32x4*)xrow + lane; u32x2* o8 = (u32x2*)orow + lane; float s = 0.f;
#pragma unroll
    for (int j = 0; j < 8; ++j) { const f32x4 v = xr[64 * j]; s += (v[0] * v[0] + v[1] * v[1]) + (v[2] * v[2] + v[3] * v[3]);
        u32x2 w; w.x = pk2(v[0], v[1]); w.y = pk2(v[2], v[3]); o8[64 * j] = w; }
    s = wave_sum(s);
    if (lane == 0) *ssq = s;
}
template <int W>
__device__ __forceinline__ void seg_norm512(bf16_t* p, const float* g, int lane) {
    u32x4 w = *(const u32x4*)(p + 8 * lane);
    float f[8] = {bflo(w.x), bfhi(w.x), bflo(w.y), bfhi(w.y), bflo(w.z), bfhi(w.z), bflo(w.w), bfhi(w.w)};
    float s = 0.f;
#pragma unroll
    for (int j = 0; j < 8; ++j) s += f[j] * f[j];
#pragma unroll
    for (int o = 1; o < W / 8; o <<= 1) s += __shfl_xor(s, o);
    const float rstd = rsqrtf(s * (1.f / W) + EPS);
    const float* gp = g + ((8 * lane) & (W - 1));
    const f32x4 g0 = *(const f32x4*)gp, g1 = *(const f32x4*)(gp + 4);
    w.x = pk2(f[0] * rstd * g0[0], f[1] * rstd * g0[1]); w.y = pk2(f[2] * rstd * g0[2], f[3] * rstd * g0[3]);
    w.z = pk2(f[4] * rstd * g1[0], f[5] * rstd * g1[1]); w.w = pk2(f[6] * rstd * g1[2], f[7] * rstd * g1[3]);
    *(u32x4*)(p + 8 * lane) = w;
}

__device__ __forceinline__ void gmlp_item(LAS unsigned char* lds, const bf16_t* Zt  , bf16_t* BRt  , const float* ws_, const float* bs_, const float* lng, const float* lnb, const int tid) {
    const int wave = __builtin_amdgcn_readfirstlane(tid >> 6), lane = tid & 63, r = lane & 31, h = lane >> 5;
    LAS float* st = (LAS float*)(lds + 65536);
    __syncthreads();
    for (int tq = 0; tq < 4; ++tq) {
        u32x4 w[4][3];
#pragma unroll
        for (int u = 0; u < 4; ++u)
#pragma unroll
            for (int c = 0; c < 3; ++c) w[u][c] = *(const u32x4*)(Zt + (size_t)(16 * wave + 4 * tq + u) * NZ0 + 1536 + 8 * (lane + 64 * c));
#pragma unroll
        for (int u = 0; u < 4; ++u) { float s = 0.f, s2 = 0.f;
#pragma unroll
            for (int c = 0; c < 3; ++c) { const float f[8] = {bflo(w[u][c].x), bfhi(w[u][c].x), bflo(w[u][c].y), bfhi(w[u][c].y), bflo(w[u][c].z), bfhi(w[u][c].z), bflo(w[u][c].w), bfhi(w[u][c].w)};
#pragma unroll
                for (int j = 0; j < 8; ++j) { s += f[j]; s2 += f[j] * f[j]; } }
            s = wave_sum(s); s2 = wave_sum(s2);
            const float mean = s * (1.f / 1536.f), var = fmaxf(s2 * (1.f / 1536.f) - mean * mean, 0.f);
            const int tok = 16 * wave + 4 * tq + u;
            if (lane == 0) { st[2 * tok] = mean; st[2 * tok + 1] = rsqrtf(var + EPS); } } }
    __syncthreads();
    const int tt = wave & 3, cp = wave >> 2;
    const unsigned q = (lane & 15) >> 2, p = lane & 3, blk = (lane >> 4) & 1;
    unsigned aaddr[8], baddr[2][2];
#pragma unroll
    for (int ks = 0; ks < 8; ++ks) aaddr[ks] = tt * 8192 + off_b(r, 2 * ks + h);
#pragma unroll
    for (int cc = 0; cc < 2; ++cc)
#pragma unroll
        for (int t2 = 0; t2 < 2; ++t2) baddr[cc][t2] = 32768u + off_b(8 * h + 4 * t2 + q, 4 * (2 * cp + cc) + 2 * blk + (p >> 1)) + 8u * (p & 1);
    for (int g = 0; g < 12; ++g) {
        const float* Wg = ws_ + (size_t)g * 16384;
        { const int ch = tid & 15, t0 = tid >> 4;
          f32x4 wa[4][2]; u32x4 vw[4];
#pragma unroll
          for (int i = 0; i < 4; ++i) { const int t = t0 + 32 * i; wa[i][0] = *(const f32x4*)(Wg + t * 128 + 8 * ch); wa[i][1] = *(const f32x4*)(Wg + t * 128 + 8 * ch + 4);
              vw[i] = *(const u32x4*)(Zt + (size_t)t * NZ0 + 1536 + g * 128 + 8 * ch); }
          const float* gp = lng + g * 128 + 8 * ch; const float* bp = lnb + g * 128 + 8 * ch;
          const f32x4 g0 = *(const f32x4*)gp, g1 = *(const f32x4*)(gp + 4), b0 = *(const f32x4*)bp, b1 = *(const f32x4*)(bp + 4);
#pragma unroll
          for (int i = 0; i < 4; ++i) { const int t = t0 + 32 * i;
              f32x4 a0 = wa[i][0], a1 = wa[i][1];
              if (t < 64 && ch >= 8) { a0 = (f32x4){0.f, 0.f, 0.f, 0.f}; a1 = a0; }
              u32x4 w; w.x = pk2(a0[0], a0[1]); w.y = pk2(a0[2], a0[3]); w.z = pk2(a1[0], a1[1]); w.w = pk2(a1[2], a1[3]);
              *(LAS u32x4*)(lds + off_b(t, ch)) = w;
              const float mean = st[2 * t], rstd = st[2 * t + 1];
              u32x4 o;
              o.x = pk2((bflo(vw[i].x) - mean) * rstd * g0[0] + b0[0], (bfhi(vw[i].x) - mean) * rstd * g0[1] + b0[1]);
              o.y = pk2((bflo(vw[i].y) - mean) * rstd * g0[2] + b0[2], (bfhi(vw[i].y) - mean) * rstd * g0[3] + b0[3]);
              o.z = pk2((bflo(vw[i].z) - mean) * rstd * g1[0] + b1[0], (bfhi(vw[i].z) - mean) * rstd * g1[1] + b1[1]);
              o.w = pk2((bflo(vw[i].w) - mean) * rstd * g1[2] + b1[2], (bfhi(vw[i].w) - mean) * rstd * g1[3] + b1[3]);
              *(LAS u32x4*)(lds + 32768 + off_b(t, ch)) = o; } }
        __syncthreads();
        f32x16 acc[2];
#pragma unroll
        for (int i = 0; i < 16; ++i) { acc[0][i] = 0.f; acc[1][i] = 0.f; }
#pragma unroll
        for (int ks = 0; ks < 8; ++ks) {
            const bf16x8 af = *(LAS bf16x8*)(lds + aaddr[ks]);
#pragma unroll
            for (int cc = 0; cc < 2; ++cc) {
                const s16x4 lo = __builtin_amdgcn_ds_read_tr16_b64_v4i16((LAS s16x4*)(lds + baddr[cc][0] + ks * 4096));
                const s16x4 hi = __builtin_amdgcn_ds_read_tr16_b64_v4i16((LAS s16x4*)(lds + baddr[cc][1] + ks * 4096));
                const bf16x8 bfv = __builtin_shufflevector(lo, hi, 0, 1, 2, 3, 4, 5, 6, 7);
                acc[cc] = MFMA32(bfv, af, acc[cc]); }
        }
        int r2 = r, h2 = h; asm volatile("" : "+v"(r2), "+v"(h2));
        { const int t = 32 * tt + r2; const float bsv = bs_[g * 128 + t];
          const bf16_t* zrow = Zt + (size_t)t * NZ0 + g * 128; bf16_t* brow = BRt + (size_t)t * DM + g * 128;
          u32x2 uw[8], gw[8];
#pragma unroll
          for (int k8 = 0; k8 < 8; ++k8) { const int c = 32 * (2 * cp + (k8 >> 2)) + 8 * (k8 & 3) + 4 * h2; uw[k8] = *(const u32x2*)(zrow + c); gw[k8] = *(const u32x2*)(zrow + 3584 + c); }
#pragma unroll
          for (int k8 = 0; k8 < 8; ++k8) { const int cc = k8 >> 2, q4 = k8 & 3, c = 32 * (2 * cp + cc) + 8 * q4 + 4 * h2;
              const float v0 = bflo(uw[k8].x) * (acc[cc][4 * q4 + 0] + bsv) * silu_f(bflo(gw[k8].x)), v1 = bfhi(uw[k8].x) * (acc[cc][4 * q4 + 1] + bsv) * silu_f(bfhi(gw[k8].x));
              const float v2 = bflo(uw[k8].y) * (acc[cc][4 * q4 + 2] + bsv) * silu_f(bflo(gw[k8].y)), v3 = bfhi(uw[k8].y) * (acc[cc][4 * q4 + 3] + bsv) * silu_f(bfhi(gw[k8].y));
              u32x2 w; w.x = pk2(v0, v1); w.y = pk2(v2, v3);
              *(u32x2*)(brow + c) = w; } }
        __syncthreads();
    }
}
constexpr int NPHASE = 1 + 3 * NLAYER;
#ifndef MK_PER_PHASE
#define MK_PER_PHASE 0
#endif

__device__ __forceinline__ void grid_bar(unsigned* base, unsigned k  , int tid) {
    __syncthreads();
    if (tid == 0) {
        __builtin_amdgcn_fence(__ATOMIC_RELEASE, "agent");
        const unsigned G = gridDim.x, x = blockIdx.x & 7u, gsize = (G - x + 7u) >> 3, ngroups = G < 8u ? G : 8u;
        const unsigned prev = __hip_atomic_fetch_add(base + 64 * (1 + x), 1u, __ATOMIC_RELAXED, __HIP_MEMORY_SCOPE_AGENT);
        if (prev + 1u == k * gsize) __hip_atomic_fetch_add(base, 1u, __ATOMIC_RELAXED, __HIP_MEMORY_SCOPE_AGENT);
        while (__hip_atomic_load(base, __ATOMIC_RELAXED, __HIP_MEMORY_SCOPE_AGENT) < k * ngroups) __builtin_amdgcn_s_sleep(1);
        __builtin_amdgcn_fence(__ATOMIC_ACQUIRE, "agent");
    }
    __syncthreads();
}

__global__ void __launch_bounds__(512) mk_fwd(Params P) {
    extern __shared__ __attribute__((aligned(16))) unsigned char shm[];
    LAS unsigned char* lds = (LAS unsigned char*)shm;
    cg::grid_group grid = cg::this_grid();
    const int G = gridDim.x, NGW = G * 8;
    int redo = 0; (void)redo;
    for (int ph = P.ph_lo; ph < P.ph_hi; ++ph) {
        int tid = threadIdx.x; asm volatile("" : "+v"(tid));
        const int wave = __builtin_amdgcn_readfirstlane(tid >> 6), lane = tid & 63, gw = blockIdx.x * 8 + wave;
        unsigned char* ws = P.ws; asm volatile("" : "+s"(ws));
        bf16_t* const WOUT = (bf16_t*)(ws + WS_WOUT); bf16_t* const WKV = (bf16_t*)(ws + WS_WKV); bf16_t* const MEMN = (bf16_t*)(ws + WS_MEMN);
        bf16_t* const KVM = (bf16_t*)(ws + WS_KVM); float* const LS = (float*)(ws + WS_LS); float* const SSQ = (float*)(ws + WS_SSQ);
        bf16_t* const HB = (bf16_t*)(ws + WS_HB); bf16_t* const BR = (bf16_t*)(ws + WS_BR); bf16_t* const Z = (bf16_t*)(ws + WS_Z);

        if (ph == 0) {
            LAS float* scr = (LAS float*)(lds + wave * 16384);
            constexpr int I0 = 32 * 176, I1 = 32 * 225, I2 = 32 * 224, IO = 32 * 64, IK = 32 * 32;
            constexpr int NIT = 2 * I0 + I1 + I2 + 4 * IO + 4 * IK;
            for (int it = gw; it < NIT; it += NGW) {
                int r = it;
                if (r < I0) { tr_item(P.a_w_in, NZ0, (bf16_t*)(ws + WS_WIN0), r, lane, scr, 0, P.norm_g); continue; } r -= I0;
                if (r < I1) { tr_item(P.b_w_in, NSRC1, (bf16_t*)(ws + WS_WIN1), r, lane, scr, 1, P.norm_g + DM); continue; } r -= I1;
                if (r < I2) { tr_item(P.c_w_in, NZ2, (bf16_t*)(ws + WS_WIN2), r, lane, scr, 0, P.norm_g + 2 * DM); continue; } r -= I2;
                if (r < I0) { tr_item(P.a_w_in + (size_t)DM * NZ0, NZ0, (bf16_t*)(ws + WS_WIN3), r, lane, scr, 0, P.norm_g + 3 * DM); continue; } r -= I0;
                if (r < 4 * IO) { const int L = r / IO; tr_item(P.w_out + (size_t)L * DM * DM, DM, WOUT + (size_t)L * DM * DM, r - L * IO, lane, scr, 0, nullptr); continue; } r -= 4 * IO;
                { const int L = r / IK; tr_item(P.w_mem_kv + (size_t)L * DM * 1024, 1024, WKV + (size_t)L * 1024 * DM, r - L * IK, lane, scr, 0, nullptr); }
            }
            { u32x4* zp = (u32x4*)((bf16_t*)(ws + WS_WIN1) + (size_t)NSRC1 * DM); const int nz = (NZ1 - NSRC1) * DM / 8;
              for (int i = blockIdx.x * 512 + tid; i < nz; i += G * 512) zp[i] = (u32x4){0u, 0u, 0u, 0u}; }
            for (int m = gw; m < NB * NMEM; m += NGW) rms_row_to_bf16(P.mem + (size_t)m * DM, P.mem_norm_g, MEMN + (size_t)m * DM, lane);
            for (int m = gw; m < NTOK; m += NGW) row_to_bf16_ssq(P.x + (size_t)m * DM, HB + (size_t)m * DM, SSQ + m, lane);
            for (int i = blockIdx.x * 512 + tid; i < 3 * NTOK; i += G * 512) SSQ[NTOK + i] = 0.f;
            if (blockIdx.x == 0) { float* gt = (float*)(ws + WS_GT);
                if (tid < 9) { ((unsigned*)(ws + WS_GT))[4096 + 64 * tid] = 0u; ((unsigned*)(ws + WS_GT))[8192 + 64 * tid] = 0u; }
                for (int i = tid; i < 2064; i += 512) { float v = 0.f;
                    if (i < 1536) { const int Lq = i / 384, w = (i % 384) / 128, d = i & 127, kd = Lq % 3;
                        if (w == 2) v = P.mem_q_norm_g[Lq * 128 + d];
                        else if (kd == 1) v = (w == 0 ? P.b_q_norm_g : P.b_k_norm_g)[d];
                        else if (kd == 2) v = (w == 0 ? P.c_q_norm_g : P.c_k_norm_g)[d & 63];
                    } else if (i < 2048) v = P.mem_k_norm_g[i - 1536];
                    else if (i < 2060) v = P.b_b_f[i - 2048];
                    gt[i] = v; }
                if (tid < 19) {
                    float v = 0.f;
                    if (tid < 16) { const int Lq = tid >> 2, w = tid & 3, kd = Lq % 3;
                        if (w == 2) { for (int i = 0; i < 128; ++i) v = fmaxf(v, fabsf(P.mem_q_norm_g[Lq * 128 + i])); }
                        else if (w == 3) { for (int i = 0; i < 128; ++i) v = fmaxf(v, fabsf(P.mem_k_norm_g[Lq * 128 + i])); }
                        else if (kd == 1) { const float* gsrc = (w == 0) ? P.b_q_norm_g : P.b_k_norm_g; for (int i = 0; i < 128; ++i) v = fmaxf(v, fabsf(gsrc[i])); }
                        else if (kd == 2) { const float* gsrc = (w == 0) ? P.c_q_norm_g : P.c_k_norm_g; for (int i = 0; i < 64; ++i) v = fmaxf(v, fabsf(gsrc[i])); }
                    } else if (tid == 16) { for (int i = 0; i < 384; ++i) v = fmaxf(v, P.rel_bias[i]); }
                    else if (tid == 17) { for (int i = 0; i < 64; ++i) v += P.c_lam[i] * P.c_lam[64 + i]; }
                    else { for (int i = 0; i < 64; ++i) v += P.c_lam[128 + i] * P.c_lam[192 + i]; }
                    gt[2080 + tid] = v; } }
        } else {
            const int L = (ph - 1) / 3, sub = (ph - 1) % 3, kind = L % 3;
            const int NZ = (kind == 0) ? NZ0 : (kind == 1 ? NZ1 : NZ2);
            const int memq_off = (kind == 0) ? 3072 : 4608;
            if (sub == 0) {
                for (int jb = (L == 0 ? 0 : 1); jb < 2; ++jb) {
                    pg8::Gemm g; EpiZ E;
                    LAS float* part = (LAS float*)(lds + LDS_PART);
                    if (jb == 0) { g = pg8::Gemm{MEMN, WKV, NB * NMEM, 4096, DM}; E = EpiZ{ws, part, 4096, 3, 0}; }
                    else { bf16_t* wt = (bf16_t*)(ws + (L == 0 ? WS_WIN0 : L == 1 ? WS_WIN1 : L == 2 ? WS_WIN2 : WS_WIN3));
                           g = pg8::Gemm{HB, wt, NTOK, NZ, DM}; E = EpiZ{ws, part, NZ, kind, L}; }
                    pg8::StaticOrder S; S.init(g.M, g.N, G, (int)blockIdx.x);
                    pg8::gemm_phase<EpiZ, pg8::StaticOrder, true, true>(lds, g, S, E, tid);
                }
            } else if (sub == 1) {
                const int gate_off = memq_off + 512;
                const float* gx = (const float*)(ws + WS_GT) + 2080;
                const float gqm = gx[4 * L], gkm = gx[4 * L + 1], gmq = gx[4 * L + 2], gmk = gx[4 * L + 3];
                const float m2_mem = 11.3137085f * gmq * gmk * 1.01f * LOG2E;
                if (kind == 0) {
                    const int j = L / 3;
#ifdef REP_GM
                    for (int rep_ = 0; rep_ < 2; ++rep_)
#endif
                    for (int it = blockIdx.x; it < NTOK / 128; it += G)
                        gmlp_item(lds, Z + (size_t)it * 128 * NZ0, BR + (size_t)it * 128 * DM, P.a_w_s + (size_t)j * 12 * 16384, P.a_b_s + j * 1536, P.a_ln_g + j * 1536, P.a_ln_b + j * 1536, tid);
                } else if (kind == 1) {
                    for (int it = blockIdx.x; it < 1536; it += G) {
                        const int c = it & 255, rr = it >> 8, bh = rr * 16 + (c & 7) * 2 + (c >> 7); int j = (c >> 3) & 15; if (rr & 1) j = 15 - j;
                        const int b = bh / 12, hh = bh - b * 12;
                        const bf16_t* Zb = Z + (size_t)b * SEQ * NZ1;
                        AttnArgs a; a.Q = Zb + hh * 128; a.K = Zb + 1536 + hh * 128; a.V = Zb + 3072 + hh * 128; a.G = Zb + gate_off + hh * 128; a.O = BR + (size_t)b * SEQ * DM + hh * 128;
                        a.ldq = NZ1; a.ldkv = NZ1; a.ldg = NZ1; a.ldo = DM; a.q0 = 256 * j; a.ntiles = 4 * j + 4; a.c = LS + (size_t)b * SEQ * 16 + hh; a.lutsrc = nullptr; a.subg = nullptr;
                        a.sc = 0.08838834764831845f * LOG2E; a.lam = 0.f; a.outmul = 1.f; a.m2 = 11.3137085f * gqm * gkm * 1.01f * LOG2E;
                        attn_item<1>(lds, a, tid);
                    }
                } else {
                    const float d01 = gx[17], d23 = gx[18];
                    const float lam_init = 0.8f - 0.6f * expf(-0.3f * (float)L);
                    const float lam_val = expf(d01) - expf(d23) + lam_init;
                    const float bmax = gx[16];
                    const float m2_diff = (8.f * gqm * gkm * 1.01f + bmax) * LOG2E;
                    for (int it = blockIdx.x; it < 3072; it += G) {
                        const int c = it & 255, rr = it >> 8, bh = rr * 8 + (c & 7); int j = c >> 3; if (rr & 1) j = 31 - j;
                        const int b = bh / 12, hh = bh - b * 12;
                        const bf16_t* Zb = Z + (size_t)b * SEQ * NZ2;
                        AttnArgs a; a.Q = Zb + hh * 128; a.K = Zb + 1536 + hh * 128; a.V = Zb + 3072 + hh * 128; a.G = Zb + gate_off + hh * 128; a.O = BR + (size_t)b * SEQ * DM + hh * 128;
                        a.ldq = NZ2; a.ldkv = NZ2; a.ldg = NZ2; a.ldo = DM; a.q0 = 128 * j; a.ntiles = 2 * j + 2; a.c = nullptr; a.lutsrc = P.rel_bias + hh; a.subg = P.c_subln_g;
                        a.sc = 0.125f * LOG2E; a.lam = lam_val; a.outmul = 1.f - lam_init; a.m2 = m2_diff;
                        attn_item<2>(lds, a, tid);
                    }
                }
#ifdef REP_MEM
                for (int rep_ = 0; rep_ < 2; ++rep_)
#endif
                for (int it = blockIdx.x; it < 512; it += G) {
                    const int qb = it & 15, hm = (it >> 4) & 3, b = it >> 6;
                    const bf16_t* Zb = Z + (size_t)b * SEQ * NZ;
                    AttnArgs a; a.Q = Zb + memq_off + hm * 128; a.K = KVM + (size_t)b * NMEM * 4096 + L * 1024 + hm * 128; a.V = a.K + 512; a.G = Zb + gate_off + 1536 + hm * 128;
                    a.O = BR + (size_t)b * SEQ * DM + 1536 + hm * 128;
                    a.ldq = NZ; a.ldkv = 4096; a.ldg = NZ; a.ldo = DM; a.q0 = 256 * qb; a.ntiles = 4; a.c = nullptr; a.lutsrc = nullptr; a.subg = nullptr;
                    a.sc = 0.08838834764831845f * LOG2E; a.lam = 0.f; a.outmul = 1.f; a.m2 = m2_mem;
                    attn_item<0>(lds, a, tid);
                }
                __syncthreads();
            } else {
                pg8::Gemm g{BR, WOUT + (size_t)L * DM * DM, NTOK, DM, DM};
                EpiOut E{L == 0 ? P.x : P.out, P.out, HB, (L + 1 < NLAYER) ? SSQ + (size_t)(L + 1) * NTOK : nullptr};
#ifdef REP_OUT0
                if (redo) E.ssq = nullptr;
#endif
                pg8::StaticOrder S; S.init(g.M, g.N, G, (int)blockIdx.x);
                pg8::gemm_phase<EpiOut, pg8::StaticOrder, true, true>(lds, g, S, E, tid);
            }
        }
#ifdef REP_P0
        if (ph == 0 && !redo) { redo = 1; __syncthreads(); --ph; continue; }
        redo = 0;
#endif
#ifdef REP_OUT0
        if (ph == 3 && !redo) { redo = 1; __syncthreads(); --ph; continue; }
        redo = 0;
#endif
#ifdef REP_SUB
        if (ph > 0 && (ph - 1) % 3 == REP_SUB && ((REP_L >> ((ph - 1) / 3)) & 1) && !redo) { redo = 1; __syncthreads(); --ph; continue; }
        redo = 0;
#endif
        if (ph + 1 < P.ph_hi) { if (ph == 0) grid.sync(); else grid_bar((unsigned*)(ws + WS_GT) + 4096, (unsigned)ph, tid); }
#ifdef REP_SYNC
        if (ph == 0) for (int i_ = 0; i_ < 10; ++i_) grid.sync();
#endif
#ifdef REP_BAR
        if (ph == 0) { for (int i_ = 0; i_ < 10; ++i_) grid_bar((unsigned*)(ws + WS_GT) + 8192, (unsigned)(i_ + 1), tid); }
#endif
    }
}

extern "C" void kernel_launch(void* const* d_in, const int* in_sizes, int n_in, void* d_out, int out_size, void* d_ws, size_t ws_size, hipStream_t stream) {
    static int grid = 0;
    if (grid == 0) {
        if (n_in != 23 || ws_size < WS_END) { fprintf(stderr, "kernel_launch: unexpected inputs (n_in %d, ws %zu)\n", n_in, ws_size); grid = -1; return; }
        int dev = 0, cus = 0, per_cu = 0;
        hipGetDevice(&dev); hipDeviceGetAttribute(&cus, hipDeviceAttributeMultiprocessorCount, dev);
        if (hipFuncSetAttribute((const void*)mk_fwd, hipFuncAttributeMaxDynamicSharedMemorySize, LDS_BYTES) != hipSuccess) fprintf(stderr, "kernel_launch: hipFuncSetAttribute failed\n");
        if (hipOccupancyMaxActiveBlocksPerMultiprocessor(&per_cu, (const void*)mk_fwd, 512, LDS_BYTES) != hipSuccess || per_cu < 1) { fprintf(stderr, "kernel_launch: occupancy query says %d\n", per_cu); per_cu = 1; }
        (void)hipGetLastError();
        grid = cus * per_cu;
        fprintf(stderr, "kernel_launch: grid %d (cus %d x %d)\n", grid, cus, per_cu);
    }
    if (grid < 0) return;
    Params p{};
    const float** pp = (const float**)&p;
    for (int i = 0; i < 23; ++i) pp[i] = (const float*)d_in[i];
    p.out = (float*)d_out; p.ws = (unsigned char*)d_ws;
#if MK_PER_PHASE
    for (int ph = 0; ph < NPHASE; ++ph) { p.ph_lo = ph; p.ph_hi = ph + 1; hipLaunchKernelGGL(mk_fwd, dim3(grid), dim3(512), LDS_BYTES, stream, p); }
#else
    p.ph_lo = 0; p.ph_hi = NPHASE;
    void* args[] = {&p};
    hipError_t e = hipLaunchCooperativeKernel((void*)mk_fwd, dim3(grid), dim3(512), args, LDS_BYTES, stream);
    if (e != hipSuccess) fprintf(stderr, "cooperative launch failed: %s (grid %d)\n", hipGetErrorString(e), grid);
#endif
}
```

```cpp
#include <hip/hip_runtime.h>
#include <hip/hip_cooperative_groups.h>
#include <cstdio>
#include <cstdint>
namespace cg = cooperative_groups;
namespace pg8 {
#define PG8_LAS __attribute__((address_space(3)))
typedef unsigned short bf16_t;
typedef short bf16x8 __attribute__((ext_vector_type(8)));
typedef float f32x4 __attribute__((ext_vector_type(4)));
typedef unsigned u32x4 __attribute__((ext_vector_type(4)));
constexpr int BM = 256, BK = 64, HALF = 128, HTB = HALF * BK * 2  , STAGE_BYTES = 8 * HTB, NXCD = 8, WGM = 8;

__host__ __device__ __forceinline__ int lds_byte(int r, int c) { const int st = (r >> 4) * 2 + (c >> 5), rr = r & 15, cc = c & 31, ob = rr * 64 + cc * 2; return st * 1024 + (ob ^ (((ob >> 9) & 1) << 5)); }
__host__ __device__ __forceinline__ void stage_rc(int b, int& R, int& C) { const int st = b / 1024, sb = b % 1024, swz = sb ^ (((sb >> 9) & 1) << 5); R = (st >> 1) * 16 + swz / 64; C = (st & 1) * 32 + (swz % 64) / 2; }
__host__ __device__ __forceinline__ int perm32(int rho) { const int n = rho >> 4, i = rho & 15; return 8 * (i >> 2) + 4 * n + (i & 3); }

struct Unit { int pm, pn; };
struct Gemm { const bf16_t* A; const bf16_t* Bt; int M, N, K; };

struct StaticOrder {
    int nM, nN, nwg, G, c;
    __host__ __device__ void init(int M, int N, int G_, int c_) { nM = M / BM; nN = N / BM; nwg = nM * nN; G = G_; c = c_; }
    __host__ __device__ bool next(int i, Unit& u) const {
        const long L = (long)i * G + c; if (L >= nwg) return false;
        int wgid = (int)L; { const int q = nwg / NXCD, r = nwg % NXCD, xcd = wgid % NXCD, off = wgid / NXCD; wgid = (xcd < r ? xcd * (q + 1) : r * (q + 1) + (xcd - r) * q) + off; }
        const int nig = WGM * nN, gid = wgid / nig, fm = gid * WGM, gsz = (nM - fm) < WGM ? (nM - fm) : WGM;
        u.pm = fm + ((wgid % nig) % gsz); u.pn = (wgid % nig) / gsz; return true;
    }
    __device__ __forceinline__ void a_ready(const Unit&) const {}
    __device__ __forceinline__ void done(const Unit&) const {}
};
__device__ __forceinline__ unsigned cvt_pk_bf16(float lo, float hi) { unsigned r; asm volatile("v_cvt_pk_bf16_f32 %0, %1, %2" : "=v"(r) : "v"(lo), "v"(hi)); return r; }
template <class Epi, class Sched, bool ALIGN_EPI = false, bool SP2 = false>
__device__ __forceinline__ void gemm_phase(PG8_LAS unsigned char* lds, const Gemm g, const Sched& S, const Epi& E, const int tid) {
    const int wid = __builtin_amdgcn_readfirstlane(tid >> 6), lane = tid & 63, wr = wid >> 2, wc = wid & 3, fr = lane & 15, fq = lane >> 4;
    const int K = g.K, nt = K / BK;
    unsigned voffA[2], voffB[2];
#pragma unroll
    for (int i = 0; i < 2; ++i) { int R, C; stage_rc(tid * 16 + i * 8192, R, C); const int Rb = Epi::PERM ? ((R & ~31) + perm32(R & 31)) : R;
        voffA[i] = (unsigned)(R * K + C) * 2u; voffB[i] = (unsigned)(Rb * K + C) * 2u; }
    const size_t kstep = (size_t)(BK * 2);
    const size_t hstep = (size_t)HALF * K * 2;
    const size_t tstep = 2 * hstep;
    const unsigned ldsw = (unsigned)wid * 1024u;
    const int aoff = lds_byte(wr * 64 + fr, fq * 8), boff = lds_byte(wc * 32 + fr, fq * 8);
#define PG8_SA(b, h) (((b) * 2 + (h)) * HTB)
#define PG8_SB(b, h) ((4 + (b) * 2 + (h)) * HTB)
#define PG8_STAGE(bufoff, gbase, voff) do { _Pragma("unroll") for (int _i = 0; _i < 2; ++_i) \
        __builtin_amdgcn_global_load_lds((const unsigned*)((const char*)(gbase) + (voff)[_i]), (PG8_LAS unsigned*)(lds + (bufoff) + ldsw + _i * 8192), 16, 0, 0); } while (0)
#define PG8_LDA(dst, b, h) do { _Pragma("unroll") for (int m = 0; m < 4; ++m) _Pragma("unroll") for (int k = 0; k < 2; ++k) dst[m][k] = *(const PG8_LAS bf16x8*)(lds + PG8_SA(b, h) + aoff + m * 2048 + k * 1024); } while (0)
#define PG8_LDB(dst, b, h) do { _Pragma("unroll") for (int n = 0; n < 2; ++n) _Pragma("unroll") for (int k = 0; k < 2; ++k) dst[n][k] = *(const PG8_LAS bf16x8*)(lds + PG8_SB(b, h) + boff + n * 2048 + k * 1024); } while (0)
#define PG8_MMA(ai, bj, At, Bt) do { __builtin_amdgcn_s_setprio(1); _Pragma("unroll") for (int m = 0; m < 4; ++m) _Pragma("unroll") for (int n = 0; n < 2; ++n) _Pragma("unroll") for (int k = 0; k < 2; ++k) \
        acc[ai][bj][m][n] = __builtin_amdgcn_mfma_f32_16x16x32_bf16(Bt[n][k], At[m][k], acc[ai][bj][m][n], 0, 0, 0); __builtin_amdgcn_s_setprio(0); } while (0)
#define PG8_WAIT_V(n) asm volatile("s_waitcnt vmcnt(" #n ")" ::: "memory")
#define PG8_WAIT_L(n) asm volatile("s_waitcnt lgkmcnt(" #n ")" ::: "memory")
#define PG8_BAR __builtin_amdgcn_s_barrier()
#define PG8_SCHED __builtin_amdgcn_sched_barrier(0)
    Unit cur, nxt; int ui = 0;
    if (!S.next(0, cur)) return;
    f32x4 acc[2][2][4][2];
#pragma unroll
    for (int a = 0; a < 2; ++a)
#pragma unroll
        for (int b = 0; b < 2; ++b)
#pragma unroll
            for (int m = 0; m < 4; ++m)
#pragma unroll
                for (int n = 0; n < 2; ++n) acc[a][b][m][n] = (f32x4){0.f, 0.f, 0.f, 0.f};
    bf16x8 At[4][2], B0[2][2], B1[2][2];
    const char* cA = (const char*)g.A + (size_t)cur.pm * tstep; const char* cB = (const char*)g.Bt + (size_t)cur.pn * tstep;
    S.a_ready(cur);
    if constexpr (SP2) {
        PG8_STAGE(PG8_SB(0, 0), cB, voffB); PG8_STAGE(PG8_SB(0, 1), cB + hstep, voffB); PG8_STAGE(PG8_SA(0, 0), cA, voffA); PG8_STAGE(PG8_SA(0, 1), cA + hstep, voffA);
        if (wr == 1) PG8_BAR;
        PG8_WAIT_V(2); PG8_BAR;
        PG8_STAGE(PG8_SB(1, 0), cB + kstep, voffB); PG8_STAGE(PG8_SA(1, 0), cA + kstep, voffA); PG8_STAGE(PG8_SB(1, 1), cB + hstep + kstep, voffB);
        PG8_WAIT_V(6); PG8_BAR;
    } else {
        PG8_STAGE(PG8_SB(0, 0), cB, voffB); PG8_STAGE(PG8_SA(0, 0), cA, voffA); PG8_STAGE(PG8_SB(0, 1), cB + hstep, voffB); PG8_STAGE(PG8_SA(0, 1), cA + hstep, voffA);
        if (wr == 1) PG8_BAR;
        PG8_WAIT_V(4); PG8_BAR;
        PG8_STAGE(PG8_SB(1, 0), cB + kstep, voffB); PG8_STAGE(PG8_SA(1, 0), cA + kstep, voffA); PG8_STAGE(PG8_SB(1, 1), cB + hstep + kstep, voffB);
        PG8_WAIT_V(6); PG8_BAR;
    }
    for (;;) {
        const bool has_next = S.next(ui + 1, nxt);
        const char* nA = has_next ? (const char*)g.A + (size_t)nxt.pm * tstep : cA; const char* nB = has_next ? (const char*)g.Bt + (size_t)nxt.pn * tstep : cB;
        for (int t = 0; t < nt; t += 2) {
            const bool last = (t == nt - 2);
            const char* a1 = cA + (size_t)(t + 1) * kstep;
            const char* a2 = last ? nA : cA + (size_t)(t + 2) * kstep; const char* b2 = last ? nB : cB + (size_t)(t + 2) * kstep;
            const char* a3 = a2 + kstep; const char* b3 = b2 + kstep;
            if (last && has_next) S.a_ready(nxt);
            if constexpr (SP2) {
            PG8_LDB(B0, 0, 0); PG8_LDB(B1, 0, 1); PG8_SCHED; PG8_LDA(At, 0, 0); PG8_STAGE(PG8_SA(1, 1), a1 + hstep, voffA);
            PG8_WAIT_V(8); PG8_WAIT_L(0); PG8_BAR; PG8_MMA(0, 0, At, B0); PG8_MMA(0, 1, At, B1); PG8_BAR; PG8_SCHED;
            PG8_LDA(At, 0, 1); PG8_STAGE(PG8_SB(0, 0), b2, voffB); PG8_STAGE(PG8_SB(0, 1), b2 + hstep, voffB); PG8_STAGE(PG8_SA(0, 0), a2, voffA);
            PG8_WAIT_V(8); PG8_WAIT_L(0); PG8_BAR; PG8_MMA(1, 0, At, B0); PG8_MMA(1, 1, At, B1); PG8_BAR; PG8_SCHED;
            PG8_LDB(B0, 1, 0); PG8_LDB(B1, 1, 1); PG8_SCHED; PG8_LDA(At, 1, 0); PG8_STAGE(PG8_SA(0, 1), a2 + hstep, voffA);
            PG8_WAIT_V(8); PG8_WAIT_L(0); PG8_BAR; PG8_MMA(0, 0, At, B0); PG8_MMA(0, 1, At, B1); PG8_BAR; PG8_SCHED;
            PG8_LDA(At, 1, 1); PG8_STAGE(PG8_SB(1, 0), b3, voffB); PG8_STAGE(PG8_SB(1, 1), b3 + hstep, voffB); PG8_STAGE(PG8_SA(1, 0), a3, voffA);
            PG8_WAIT_V(8); PG8_WAIT_L(0); PG8_BAR; PG8_MMA(1, 0, At, B0); PG8_MMA(1, 1, At, B1); PG8_BAR; PG8_SCHED;
            } else {
            PG8_LDB(B0, 0, 0); PG8_SCHED; PG8_LDA(At, 0, 0); PG8_STAGE(PG8_SA(1, 1), a1 + hstep, voffA);
            PG8_WAIT_L(8); PG8_BAR; PG8_WAIT_L(0); PG8_MMA(0, 0, At, B0); PG8_BAR; PG8_SCHED;
            PG8_LDB(B1, 0, 1); PG8_STAGE(PG8_SB(0, 0), b2, voffB);
            PG8_BAR; PG8_WAIT_L(0); PG8_MMA(0, 1, At, B1); PG8_BAR;
            PG8_LDA(At, 0, 1); PG8_STAGE(PG8_SA(0, 0), a2, voffA);
            PG8_BAR; PG8_WAIT_L(0); PG8_MMA(1, 0, At, B0); PG8_BAR; PG8_SCHED;
            PG8_STAGE(PG8_SB(0, 1), b2 + hstep, voffB);
            PG8_WAIT_V(6); PG8_BAR; PG8_MMA(1, 1, At, B1); PG8_BAR;
            PG8_LDB(B0, 1, 0); PG8_SCHED; PG8_LDA(At, 1, 0); PG8_STAGE(PG8_SA(0, 1), a2 + hstep, voffA);
            PG8_WAIT_L(8); PG8_BAR; PG8_WAIT_L(0); PG8_MMA(0, 0, At, B0); PG8_BAR; PG8_SCHED;
            PG8_LDB(B1, 1, 1); PG8_STAGE(PG8_SB(1, 0), b3, voffB);
            PG8_BAR; PG8_WAIT_L(0); PG8_MMA(0, 1, At, B1); PG8_BAR;
            PG8_LDA(At, 1, 1); PG8_STAGE(PG8_SA(1, 0), a3, voffA);
            PG8_BAR; PG8_WAIT_L(0); PG8_MMA(1, 0, At, B0); PG8_BAR; PG8_SCHED;
            PG8_STAGE(PG8_SB(1, 1), b3 + hstep, voffB);
            PG8_WAIT_V(6); PG8_BAR; PG8_MMA(1, 1, At, B1); PG8_BAR;
            }
        }
        if constexpr (ALIGN_EPI) { if (wr == 0) PG8_BAR; }
        if constexpr (!Epi::AFTER_DRAIN) { E(acc, cur, wr, wc, fr, fq); S.done(cur); }
        if (!has_next) break;
#pragma unroll
        for (int a = 0; a < 2; ++a)
#pragma unroll
            for (int b = 0; b < 2; ++b)
#pragma unroll
                for (int m = 0; m < 4; ++m)
#pragma unroll
                    for (int n = 0; n < 2; ++n) acc[a][b][m][n] = (f32x4){0.f, 0.f, 0.f, 0.f};
        cur = nxt; cA = nA; cB = nB; ++ui;
        if constexpr (ALIGN_EPI) { if (wr == 1) PG8_BAR; }
    }
    PG8_WAIT_V(0);
    if constexpr (!ALIGN_EPI) { if (wr == 0) PG8_BAR; }
    PG8_BAR;
    if constexpr (Epi::AFTER_DRAIN) { E.fused(acc, cur, wr, wc, fr, fq, lds, wid, lane); S.done(cur); }
#undef PG8_SA
#undef PG8_SB
#undef PG8_STAGE
#undef PG8_LDA
#undef PG8_LDB
#undef PG8_MMA
#undef PG8_WAIT_V
#undef PG8_WAIT_L
#undef PG8_BAR
#undef PG8_SCHED
}
}
using pg8::bf16_t; using pg8::bf16x8; using pg8::f32x4; using pg8::u32x4; using pg8::cvt_pk_bf16;
#define LAS __attribute__((address_space(3)))
typedef short s16x4 __attribute__((ext_vector_type(4)));
typedef float f32x16 __attribute__((ext_vector_type(16)));
typedef unsigned u32x2 __attribute__((ext_vector_type(2)));
#define MFMA32(a, b, c) __builtin_amdgcn_mfma_f32_32x32x16_bf16((a), (b), (c), 0, 0, 0)

constexpr int DM = 2048, NB = 8, SEQ = 4096, NTOK = NB * SEQ, NMEM = 256, NLAYER = 4;
constexpr int NZ0 = 5632, NZ1 = 7424, NZ2 = 7168, NSRC1 = 7180;
constexpr float LOG2E = 1.4426950408889634f;
constexpr float EPS = 1e-6f;
constexpr size_t MiB = 1u << 20;
constexpr size_t WS_WIN0 = 0, WS_WIN1 = 22 * MiB, WS_WIN2 = 51 * MiB, WS_WIN3 = 79 * MiB, WS_WOUT = 101 * MiB, WS_WKV = 133 * MiB, WS_MEMN = 149 * MiB,
                 WS_KVM = 157 * MiB, WS_LS = 173 * MiB, WS_SSQ = 175 * MiB, WS_GT = 176 * MiB, WS_HB = 177 * MiB, WS_BR = 305 * MiB, WS_Z = 433 * MiB, WS_END = 897 * MiB;
constexpr int LDS_MISC = 131072;
constexpr int LDS_PART = 131072;
constexpr int LDS_BYTES = 131072 + 8192 + 4096;

struct Params {
    const float *x, *mem, *mem_norm_g, *rel_bias, *norm_g, *w_mem_kv, *mem_q_norm_g, *mem_k_norm_g, *w_out, *a_w_in, *a_ln_g, *a_ln_b, *a_w_s, *a_b_s,
                *b_w_in, *b_b_f, *b_q_norm_g, *b_k_norm_g, *c_w_in, *c_q_norm_g, *c_k_norm_g, *c_lam, *c_subln_g;
    float* out; unsigned char* ws; int ph_lo, ph_hi;
};

__device__ __forceinline__ unsigned off_b(unsigned row, unsigned ch) { return 256u * row + 16u * (ch ^ (((row & 3u) << 2) | ((row >> 2) & 3u))); }
__device__ __forceinline__ float bf2f(unsigned short v) { return __uint_as_float(((unsigned)v) << 16); }
__device__ __forceinline__ float bflo(unsigned w) { return __uint_as_float(w << 16); }
__device__ __forceinline__ float bfhi(unsigned w) { return __uint_as_float(w & 0xffff0000u); }
__device__ __forceinline__ unsigned f2bf(float f) { unsigned u = __float_as_uint(f); return (u + 0x7fffu + ((u >> 16) & 1u)) >> 16; }
typedef float f32x2v __attribute__((ext_vector_type(2)));
typedef __bf16 bf16x2v __attribute__((ext_vector_type(2)));
__device__ __forceinline__ unsigned pk2(float lo, float hi) { const f32x2v v = {lo, hi}; return __builtin_bit_cast(unsigned, __builtin_convertvector(v, bf16x2v)); }
__device__ __forceinline__ float fast_exp2(float x) { return __builtin_amdgcn_exp2f(x); }
__device__ __forceinline__ float fast_rcp(float x) { return __builtin_amdgcn_rcpf(x); }
__device__ __forceinline__ float silu_f(float g) { return g * fast_rcp(1.f + fast_exp2(-g * LOG2E)); }
__device__ __forceinline__ float gelu_tanh_f(float x) { const float u = 0.7978845608028654f * (x + 0.044715f * x * x * x); return x * fast_rcp(1.f + fast_exp2(-2.f * LOG2E * u)); }
__device__ __forceinline__ float wave_sum(float v) {
#pragma unroll
    for (int o = 1; o < 64; o <<= 1) v += __shfl_xor(v, o);
    return v;
}

struct EpiZ {
    static constexpr bool PERM = true, AFTER_DRAIN = false;
    unsigned char* ws; LAS float* part; int ldc; int kind; int L;
    __device__ __forceinline__ void operator()(const f32x4 (&acc)[2][2][4][2], const pg8::Unit& u, int wr, int wc, int fr, int fq) const {
        asm volatile("" : "+v"(fr), "+v"(fq));
        const int lrow0 = wr * 64 + fr, row0 = u.pm * 256 + lrow0, colt = u.pn * 256, pn = u.pn;
        bf16_t* const Z = (bf16_t*)(ws + (kind == 3 ? WS_KVM : WS_Z)); float* const LS = (float*)(ws + WS_LS);
        const float* const ssq = (kind == 3) ? nullptr : (const float*)(ws + WS_SSQ) + (size_t)L * NTOK;
        const float* const gt = (const float*)(ws + WS_GT);
        const float* const bfp = gt + 2048; const float* const gq = gt + 384 * L; const float* const gk = gq + 128; const float* const gm = (kind == 3) ? gt + 1536 : gq + 256;
        if (kind == 1 && pn == 28) {
            if (wc == 0) {
#pragma unroll
                for (int ai = 0; ai < 2; ++ai)
#pragma unroll
                    for (int m = 0; m < 4; ++m) { const int row = row0 + ai * 128 + m * 16;
#pragma unroll
                        for (int n = 0; n < 2; ++n)
#pragma unroll
                            for (int j = 0; j < 4; ++j) { const int col = 8 * fq + 4 * n + j;
                                if (col < 12) { const float xv = acc[ai][0][m][n][j] * rsqrtf(ssq[row] * (1.f / DM) + EPS) + bfp[col]; LS[(size_t)row * 16 + col] = fminf(xv, 0.f) - log1pf(expf(-fabsf(xv))); } } }
            }
            return;
        }
        int W = 0; const float* g = nullptr;
        if (kind == 0) { if (pn == 12 || pn == 13) { W = 128; g = gm; } }
        else if (kind == 3) { if ((pn & 3) < 2) { W = 128; g = gm + (pn >> 2) * 128; } }
        else { if (pn < 6) { W = (kind == 1) ? 128 : 64; g = gq; } else if (pn < 12) { W = (kind == 1) ? 128 : 64; g = gk; } else if (pn == 18 || pn == 19) { W = 128; g = gm; } }
        const bool act = (kind == 0) && (pn < 12);
        f32x4 g0 = (f32x4){1.f, 1.f, 1.f, 1.f}, g1 = g0;
        if (W) {
#pragma unroll
            for (int ai = 0; ai < 2; ++ai)
#pragma unroll
                for (int m = 0; m < 4; ++m)
#pragma unroll
                    for (int bj = 0; bj < 2; ++bj) { const f32x4 a0 = acc[ai][bj][m][0], a1 = acc[ai][bj][m][1];
                        float ss = (a0[0] * a0[0] + a0[1] * a0[1]) + (a0[2] * a0[2] + a0[3] * a0[3]) + (a1[0] * a1[0] + a1[1] * a1[1]) + (a1[2] * a1[2] + a1[3] * a1[3]);
                        ss += __shfl_xor(ss, 16); ss += __shfl_xor(ss, 32);
                        if (fq == 0) part[(lrow0 + ai * 128 + m * 16) * 8 + bj * 4 + wc] = ss; }
            asm volatile("s_waitcnt lgkmcnt(0)" ::: "memory"); __builtin_amdgcn_s_barrier(); asm volatile("" ::: "memory");
            const float* gp = g + ((32 * wc + 8 * fq) & (W - 1));
            g0 = *(const f32x4*)gp; g1 = *(const f32x4*)(gp + 4);
        }
        const float invW = W ? 1.f / (float)W : 0.f;
        const int col0 = colt + wc * 32 + 8 * fq;
#pragma unroll
        for (int ai = 0; ai < 2; ++ai) {
            float rsv[4];
#pragma unroll
            for (int m = 0; m < 4; ++m) rsv[m] = ssq ? rsqrtf(ssq[row0 + ai * 128 + m * 16] * (1.f / DM) + EPS) : 1.f;
#pragma unroll
            for (int m = 0; m < 4; ++m) { bf16_t* rowp = Z + (size_t)(row0 + ai * 128 + m * 16) * ldc + col0;
                const float rs = rsv[m];
#pragma unroll
                for (int bj = 0; bj < 2; ++bj) { float mm = rs;
                    if (W) { const f32x4 pp = *(const LAS f32x4*)(part + (lrow0 + ai * 128 + m * 16) * 8 + bj * 4);
                        const float tot = (W == 128) ? ((pp[0] + pp[1]) + (pp[2] + pp[3])) : (wc < 2 ? pp[0] + pp[1] : pp[2] + pp[3]);
                        mm = rs * rsqrtf(tot * rs * rs * invW + EPS); }
                    f32x4 v0 = acc[ai][bj][m][0] * mm * g0, v1 = acc[ai][bj][m][1] * mm * g1;
                    if (act) {
#pragma unroll
                        for (int j = 0; j < 4; ++j) { v0[j] = gelu_tanh_f(v0[j]); v1[j] = gelu_tanh_f(v1[j]); } }
                    u32x4 w; w.x = cvt_pk_bf16(v0[0], v0[1]); w.y = cvt_pk_bf16(v0[2], v0[3]); w.z = cvt_pk_bf16(v1[0], v1[1]); w.w = cvt_pk_bf16(v1[2], v1[3]);
                    *(u32x4*)(rowp + bj * 128) = w; } } }
    }
};
struct EpiOut {
    static constexpr bool PERM = false, AFTER_DRAIN = false;
    const float* Xin; float* Out; bf16_t* HBo; float* ssq;
    __device__ __forceinline__ void operator()(const f32x4 (&acc)[2][2][4][2], const pg8::Unit& u, int wr, int wc, int fr, int fq) const {
        asm volatile("" : "+v"(fr), "+v"(fq));
        const int row0 = u.pm * 256 + wr * 64 + fr, col0 = u.pn * 256 + wc * 32 + 4 * fq;
        f32x4 xr[3][4];
#define EO_LOAD(rr, slot) do { const size_t o_ = (size_t)(row0 + ((rr) >> 2) * 128 + ((rr) & 3) * 16) * DM + col0; _Pragma("unroll") for (int q_ = 0; q_ < 4; ++q_) xr[slot][q_] = *(const f32x4*)(Xin + o_ + (q_ >> 1) * 128 + (q_ & 1) * 16); } while (0)
        EO_LOAD(0, 0); EO_LOAD(1, 1);
#pragma unroll
        for (int rr = 0; rr < 8; ++rr) { const int ai = rr >> 2, m = rr & 3, row = row0 + ai * 128 + m * 16; const size_t o = (size_t)row * DM + col0; float s = 0.f;
            if (rr + 2 < 8) EO_LOAD(rr + 2, (rr + 2) % 3);
#pragma unroll
            for (int q = 0; q < 4; ++q) { const int bj = q >> 1, n = q & 1; const size_t idx = o + bj * 128 + n * 16; const f32x4 v = xr[rr % 3][q] + acc[ai][bj][m][n]; *(f32x4*)(Out + idx) = v;
                if (ssq) { u32x2 w; w.x = cvt_pk_bf16(v[0], v[1]); w.y = cvt_pk_bf16(v[2], v[3]); *(u32x2*)(HBo + idx) = w; s += (v[0] * v[0] + v[1] * v[1]) + (v[2] * v[2] + v[3] * v[3]); } }
            if (ssq) { s += __shfl_xor(s, 16); s += __shfl_xor(s, 32); if (fq == 0) atomicAdd(ssq + row, s); } }
#undef EO_LOAD
    }
};
#ifndef AT_KD
#define AT_KD 4
#endif
#ifndef AT_VD
#define AT_VD 3
#endif
struct AttnArgs {
    const bf16_t *Q, *K, *V, *G; bf16_t* O;
    int ldq, ldkv, ldg, ldo, q0, ntiles;
    const float* c;
    const float* lutsrc;
    const float* subg;
    float sc, lam, outmul, m2;
};
constexpr int A_CS = 65536, A_LUT = 65536 + 16384;

template <int MODE>
__device__ __forceinline__ void attn_item(LAS unsigned char* lds, const AttnArgs& a, const int tid) {
    const int wave = __builtin_amdgcn_readfirstlane(tid >> 6), lane = tid & 63, r = lane & 31, h = lane >> 5;
    constexpr int NKS = (MODE == 2) ? 4 : 8;
    const int map = (MODE == 2) ? (wave >> 2) : 0;
    const int qw0 = a.q0 + 32 * ((MODE == 2) ? (wave & 3) : wave);
    const int tw = (MODE == 0) ? (a.ntiles - 1) : (MODE == 1 ? ((qw0 + 31) >> 6) : (qw0 >> 6));
    __syncthreads();
    if (MODE == 2) {
        if (tid < 255) { const int rel = tid - 191; const int n = rel < 0 ? -rel : rel; int bkt;
            if (n < 8) bkt = n; else { const float nf = (float)n; int lg = 8 + (int)(logf(nf / 8.0f) / 2.772588722239781f * 8.0f); bkt = lg < 15 ? lg : 15; }
            if (rel > 0) bkt += 16;
            ((LAS float*)(lds + A_LUT))[tid] = a.lutsrc[bkt * 12] * LOG2E - a.m2; }
    }
    bf16x8 qf[NKS];
    { const bf16_t* qrow = a.Q + (size_t)(qw0 + r) * a.ldq + map * 64 + 8 * h;
#pragma unroll
      for (int ks = 0; ks < NKS; ++ks) qf[ks] = *(const bf16x8*)(qrow + 16 * ks); }
    if (MODE == 1) {
        LAS float* cl = (LAS float*)(lds + A_CS); LAS float* wtot = (LAS float*)(lds + A_LUT);
        const int n = a.q0 + 256; const bool on = 8 * tid < n;
        float v[8]; float run = 0.f;
        const float* lp = a.c + (size_t)(8 * tid) * 16;
#pragma unroll
        for (int e = 0; e < 8; ++e) { if (on) run += lp[e * 16]; v[e] = run; }
        float incl = run;
#pragma unroll
        for (int o = 1; o < 64; o <<= 1) { const float x = __shfl_up(incl, o); if (lane >= o) incl += x; }
        if (lane == 63) wtot[wave] = incl;
        __syncthreads();
        float pre = incl - run;
        for (int w = 0; w < wave; ++w) pre += wtot[w];
        if (on) {
#pragma unroll
            for (int e = 0; e < 8; ++e) cl[8 * tid + e] = -(pre + v[e]) * LOG2E; }
    }
    unsigned kaddr[NKS];
    { const unsigned X = ((r & 3u) << 2) | ((r >> 2) & 3u);
#pragma unroll
      for (int ks = 0; ks < NKS; ++ks) kaddr[ks] = 256u * r + 16u * ((unsigned)(2 * (map * 4 + ks) + h) ^ X); }
    unsigned vaddr[4][2];
    { const unsigned q = (lane & 15) >> 2, p = lane & 3, blk = (lane >> 4) & 1;
#pragma unroll
      for (int dt = 0; dt < 4; ++dt)
#pragma unroll
          for (int t2 = 0; t2 < 2; ++t2) vaddr[dt][t2] = 16384u + off_b(8 * t2 + 4 * h + q, 4 * dt + 2 * blk + (p >> 1)) + 8u * (p & 1); }
    const unsigned sX = ((unsigned)(lane >> 4) << 2) | (unsigned)(wave & 3);
    const size_t sgoff = (size_t)(4 * wave + (lane >> 4)) * a.ldkv + (size_t)(((unsigned)(lane & 15) ^ sX) * 8u);
    const bf16_t* kg = a.K + sgoff; const bf16_t* vg = a.V + sgoff;
    const size_t tstep = (size_t)64 * a.ldkv, hstep = (size_t)32 * a.ldkv;
#define AT_DMA1(gp, la) asm volatile("s_mov_b32 m0, %1\n\ts_nop 0\n\tglobal_load_lds_dwordx4 %0, off" :: "v"(gp), "s"(la) : "memory", "m0")
#define AT_DMA(t, b) do { const bf16_t* kp = kg + (size_t)(t) * tstep; const bf16_t* vp = vg + (size_t)(t) * tstep; const unsigned la = (unsigned)(size_t)(lds + (b) * 32768 + wave * 1024); \
        AT_DMA1(kp, la); AT_DMA1(kp + hstep, la + 8192u); AT_DMA1(vp, la + 16384u); AT_DMA1(vp + hstep, la + 16384u + 8192u); } while (0)
    float l = 0.f;
    f32x16 o[4];
#pragma unroll
    for (int dt = 0; dt < 4; ++dt)
#pragma unroll
        for (int i = 0; i < 16; ++i) o[dt][i] = 0.f;
    AT_DMA(0, 0);
    asm volatile("s_waitcnt vmcnt(0)" ::: "memory");
    __syncthreads();
#pragma unroll
    for (int ks = 0; ks < NKS; ++ks) asm volatile("" : "+v"(qf[ks]));
    float b15 = 0.f; if (MODE == 2) b15 = ((LAS float*)(lds + A_LUT))[0];
    float addc = -a.m2; if (MODE == 1) addc = -((LAS float*)(lds + A_CS))[qw0 + r] - a.m2; if (MODE == 2) addc = b15;
    const int nt = a.ntiles;
    for (int tt2 = 0; tt2 < nt; tt2 += 2)
#pragma unroll
    for (int bb = 0; bb < 2; ++bb) {
        const int t = tt2 + bb;
        constexpr int dummy_ = 0; (void)dummy_;
        const int b = bb;
        if (t + 1 < nt) AT_DMA(t + 1, b ^ 1);
        if (t <= tw) {
            LAS unsigned char* kb = lds + b * 32768;
            f32x16 s[2];
#pragma unroll
            for (int i = 0; i < 16; ++i) { s[0][i] = 0.f; s[1][i] = 0.f; }
            constexpr int KD = AT_KD, VD = AT_VD;
            bf16x8 kf[KD];
#define AT_KLD(i) (*(LAS bf16x8*)(kb + kaddr[(i) >> 1] + ((i) & 1) * 8192))
#pragma unroll
            for (int i = 0; i < KD; ++i) kf[i] = AT_KLD(i);
#pragma unroll
            for (int i = 0; i < 2 * NKS; ++i) { s[i & 1] = MFMA32(kf[i % KD], qf[i >> 1], s[i & 1]); if (i + KD < 2 * NKS) kf[i % KD] = AT_KLD(i + KD); }
#undef AT_KLD
            bf16x8 vf[VD];
#define AT_VLD(j) do { const s16x4 lo_ = __builtin_amdgcn_ds_read_tr16_b64_v4i16((LAS s16x4*)(kb + vaddr[(j) & 3][0] + (32 * ((j) >> 3) + 16 * (((j) >> 2) & 1)) * 256)); \
                const s16x4 hi_ = __builtin_amdgcn_ds_read_tr16_b64_v4i16((LAS s16x4*)(kb + vaddr[(j) & 3][1] + (32 * ((j) >> 3) + 16 * (((j) >> 2) & 1)) * 256)); \
                vf[(j) % VD] = __builtin_shufflevector(lo_, hi_, 0, 1, 2, 3, 4, 5, 6, 7); } while (0)
#pragma unroll
            for (int j = 0; j < VD; ++j) AT_VLD(j);
            const float sc = a.sc;
            const bool diag = (MODE == 1) && (t * 64 + 63 > qw0);
            const bool near = (MODE == 2) && (t >= tw - 2);
            bf16x8 pf[2];
#pragma unroll
            for (int kt = 0; kt < 2; ++kt) {
                if (MODE == 1) {
                    const LAS float* csb = (const LAS float*)(lds + A_CS) + t * 64 + 32 * kt + 4 * h;
                    const int mb = t * 64 + 32 * kt + 4 * h - (qw0 + r);
#pragma unroll
                    for (int g = 0; g < 4; ++g) { const f32x4 cv = *(const LAS f32x4*)(csb + 8 * g);
#pragma unroll
                        for (int e = 0; e < 4; ++e) { float x = fmaf(s[kt][4 * g + e], sc, addc) + cv[e]; if (diag && (mb + 8 * g + e > 0)) x = -1e30f; s[kt][4 * g + e] = x; } }
                } else if (MODE == 2) {
                    if (near) {
                        const LAS float* lut = (const LAS float*)(lds + A_LUT) + (t * 64 + 32 * kt + 4 * h - (qw0 + r) + 191);
#pragma unroll
                        for (int i = 0; i < 16; ++i) s[kt][i] = fmaf(s[kt][i], sc, lut[8 * (i >> 2) + (i & 3)]);
                    } else {
#pragma unroll
                        for (int i = 0; i < 16; ++i) s[kt][i] = fmaf(s[kt][i], sc, addc);
                    }
                } else {
#pragma unroll
                    for (int i = 0; i < 16; ++i) s[kt][i] = fmaf(s[kt][i], sc, addc);
                }
                float ls = 0.f;
#pragma unroll
                for (int i = 0; i < 16; ++i) { const float pv = fast_exp2(s[kt][i]); s[kt][i] = pv; ls += pv; }
                l += ls;
#pragma unroll
                for (int ss = 0; ss < 2; ++ss) { u32x4 w;
                    w.x = pk2(s[kt][8 * ss + 0], s[kt][8 * ss + 1]); w.y = pk2(s[kt][8 * ss + 2], s[kt][8 * ss + 3]);
                    w.z = pk2(s[kt][8 * ss + 4], s[kt][8 * ss + 5]); w.w = pk2(s[kt][8 * ss + 6], s[kt][8 * ss + 7]);
                    pf[ss] = __builtin_bit_cast(bf16x8, w); }
#pragma unroll
                for (int jj = 0; jj < 8; ++jj) { const int j = 8 * kt + jj;
                    o[jj & 3] = MFMA32(vf[j % VD], pf[jj >> 2], o[jj & 3]);
                    if (j + VD < 16) AT_VLD(j + VD); }
            }
#undef AT_VLD
        }
        asm volatile("s_waitcnt vmcnt(0)" ::: "memory");
        __syncthreads();
    }
#undef AT_DMA
#undef AT_DMA1
    l += __shfl_xor(l, 32);
    const float inv = 1.f / l;
    const size_t qrow = (size_t)(qw0 + r);
    u32x2 gwv[16];
#pragma unroll
    for (int k = 0; k < 16; ++k) gwv[k] = *(const u32x2*)(a.G + qrow * a.ldg + 32 * (k >> 2) + 8 * (k & 3) + 4 * h);
    if (MODE != 2) {
#pragma unroll
        for (int dt = 0; dt < 4; ++dt)
#pragma unroll
            for (int g = 0; g < 4; ++g) { const int d = 32 * dt + 8 * g + 4 * h;
                const u32x2 gw = gwv[dt * 4 + g];
                const float v0 = o[dt][4 * g + 0] * inv * silu_f(bflo(gw.x)), v1 = o[dt][4 * g + 1] * inv * silu_f(bfhi(gw.x));
                const float v2 = o[dt][4 * g + 2] * inv * silu_f(bflo(gw.y)), v3 = o[dt][4 * g + 3] * inv * silu_f(bfhi(gw.y));
                u32x2 w; w.x = pk2(v0, v1); w.y = pk2(v2, v3);
                *(u32x2*)(a.O + qrow * a.ldo + d) = w; }
    } else {
        LAS float* xb = (LAS float*)(lds + (wave & 3) * 16384);
        if (map == 1) {
            const float f = inv * a.lam;
#pragma unroll
            for (int dt = 0; dt < 4; ++dt)
#pragma unroll
                for (int i = 0; i < 16; ++i) xb[(dt * 16 + i) * 64 + lane] = o[dt][i] * f;
        }
        __syncthreads();
        if (map == 0) {
            float ssq = 0.f;
#pragma unroll
            for (int dt = 0; dt < 4; ++dt)
#pragma unroll
                for (int i = 0; i < 16; ++i) { const float v = o[dt][i] * inv - xb[(dt * 16 + i) * 64 + lane]; o[dt][i] = v; ssq += v * v; }
            ssq += __shfl_xor(ssq, 32);
            const float rn = rsqrtf(ssq * (1.f / 128.f) + EPS) * a.outmul;
#pragma unroll
            for (int dt = 0; dt < 4; ++dt)
#pragma unroll
                for (int g = 0; g < 4; ++g) { const int d = 32 * dt + 8 * g + 4 * h;
                    const u32x2 gw = gwv[dt * 4 + g];
                    const f32x4 sg = *(const f32x4*)(a.subg + d);
                    const float v0 = o[dt][4 * g + 0] * rn * sg[0] * silu_f(bflo(gw.x)), v1 = o[dt][4 * g + 1] * rn * sg[1] * silu_f(bfhi(gw.x));
                    const float v2 = o[dt][4 * g + 2] * rn * sg[2] * silu_f(bflo(gw.y)), v3 = o[dt][4 * g + 3] * rn * sg[3] * silu_f(bfhi(gw.y));
                    u32x2 w; w.x = pk2(v0, v1); w.y = pk2(v2, v3);
                    *(u32x2*)(a.O + qrow * a.ldo + d) = w; }
        }
    }
}
__device__ __forceinline__ void tr_item(const float* W, int N, bf16_t* WT, int item, int lane, LAS float* scr, int fox, const float* gk) {
    const int nblk = (N + 31) >> 5, kb = item / nblk, nb = item - kb * nblk, k0 = 64 * kb, n0 = 32 * nb;
    const int nq = lane & 7, kr = lane >> 3, nc = n0 + 4 * nq;
    f32x4 wv[8];
#pragma unroll
    for (int i = 0; i < 8; ++i) wv[i] = (nc < N) ? *(const f32x4*)(W + (size_t)(k0 + kr + 8 * i) * N + nc) : (f32x4){0.f, 0.f, 0.f, 0.f};
#pragma unroll
    for (int i = 0; i < 8; ++i) { const int kk = kr + 8 * i; const float gg = gk ? gk[k0 + kk] : 1.f;
#pragma unroll
        for (int e2 = 0; e2 < 4; ++e2) scr[kk * 33 + 4 * nq + e2] = wv[i][e2] * gg; }
    asm volatile("s_waitcnt lgkmcnt(0)" ::: "memory");
    const int c = lane & 7;
#pragma unroll
    for (int j = 0; j < 4; ++j) { const int nl = (lane >> 3) + 8 * j, n = n0 + nl; const LAS float* s = scr + (8 * c) * 33 + nl;
        if (n < N) { int nd = n; if (fox) { if (n >= 4620) nd = n - 12; else if (n >= 4608) nd = n - 4608 + 7168; }
            u32x4 o; o.x = pk2(s[0 * 33], s[1 * 33]); o.y = pk2(s[2 * 33], s[3 * 33]); o.z = pk2(s[4 * 33], s[5 * 33]); o.w = pk2(s[6 * 33], s[7 * 33]);
            *(u32x4*)(WT + (size_t)nd * DM + k0 + 8 * c) = o; } }
    asm volatile("s_waitcnt lgkmcnt(0)" ::: "memory");
}
__device__ __forceinline__ void rms_row_to_bf16(const float* xrow, const float* g, bf16_t* orow, int lane) {
    const f32x4* xr = (const f32x4*)xrow + lane; const f32x4* gr = (const f32x4*)g + lane;
    f32x4 v[8]; float s = 0.f;
#pragma unroll
    for (int j = 0; j < 8; ++j) { v[j] = xr[64 * j]; s += (v[j][0] * v[j][0] + v[j][1] * v[j][1]) + (v[j][2] * v[j][2] + v[j][3] * v[j][3]); }
    const float rstd = rsqrtf(wave_sum(s) * (1.f / DM) + EPS);
    u32x2* o8 = (u32x2*)orow + lane;
#pragma unroll
    for (int j = 0; j < 8; ++j) { const f32x4 gg = gr[64 * j]; u32x2 w; w.x = pk2(v[j][0] * rstd * gg[0], v[j][1] * rstd * gg[1]); w.y = pk2(v[j][2] * rstd * gg[2], v[j][3] * rstd * gg[3]); o8[64 * j] = w; }
}
__device__ __forceinline__ void row_to_bf16_ssq(const float* xrow, bf16_t* orow, float* ssq, int lane) {
    const f32x4* xr = (const f32x4*)xrow + lane; u32x2* o8 = (u32x2*)orow + lane; float s = 0.f;
#pragma unroll
    for (int j = 0; j < 8; ++j) { const f32x4 v = xr[64 * j]; s += (v[0] * v[0] + v[1] * v[1]) + (v[2] * v[2] + v[3] * v[3]);
        u32x2 w; w.x = pk2(v[0], v[1]); w.y = pk2(v[2], v[3]); o8[64 * j] = w; }
    s = wave_sum(s);
    if (lane == 0) *ssq = s;
}
template <int W>
__device__ __forceinline__ void seg_norm512(bf16_t* p, const float* g, int lane) {
    u32x4 w = *(const u32x4*)(p + 8 * lane);
    float f[8] = {bflo(w.x), bfhi(w.x), bflo(w.y), bfhi(w.y), bflo(w.z), bfhi(w.z), bflo(w.w), bfhi(w.w)};
    float s = 0.f;
#pragma unroll
    for (int j = 0; j < 8; ++j) s += f[j] * f[j];
#pragma unroll
    for (int o = 1; o < W / 8; o <<= 1) s += __shfl_xor(s, o);
    const float rstd = rsqrtf(s * (1.f / W) + EPS);
    const float* gp = g + ((8 * lane) & (W - 1));
    const f32x4 g0 = *(const f32x4*)gp, g1 = *(const f32x4*)(gp + 4);
    w.x = pk2(f[0] * rstd * g0[0], f[1] * rstd * g0[1]); w.y = pk2(f[2] * rstd * g0[2], f[3] * rstd * g0[3]);
    w.z = pk2(f[4] * rstd * g1[0], f[5] * rstd * g1[1]); w.w = pk2(f[6] * rstd * g1[2], f[7] * rstd * g1[3]);
    *(u32x4*)(p + 8 * lane) = w;
}

__device__ __forceinline__ void gmlp_item(LAS unsigned char* lds, const bf16_t* Zt  , bf16_t* BRt  , const float* ws_, const float* bs_, const float* lng, const float* lnb, const int tid) {
    const int wave = __builtin_amdgcn_readfirstlane(tid >> 6), lane = tid & 63, r = lane & 31, h = lane >> 5;
    LAS float* st = (LAS float*)(lds + 131072);
    __syncthreads();
    for (int tq = 0; tq < 4; ++tq) {
        u32x4 w[4][3];
#pragma unroll
        for (int u = 0; u < 4; ++u)
#pragma unroll
            for (int c = 0; c < 3; ++c) w[u][c] = *(const u32x4*)(Zt + (size_t)(16 * wave + 4 * tq + u) * NZ0 + 1536 + 8 * (lane + 64 * c));
#pragma unroll
        for (int u = 0; u < 4; ++u) { float s = 0.f, s2 = 0.f;
#pragma unroll
            for (int c = 0; c < 3; ++c) { const float f[8] = {bflo(w[u][c].x), bfhi(w[u][c].x), bflo(w[u][c].y), bfhi(w[u][c].y), bflo(w[u][c].z), bfhi(w[u][c].z), bflo(w[u][c].w), bfhi(w[u][c].w)};
#pragma unroll
                for (int j = 0; j < 8; ++j) { s += f[j]; s2 += f[j] * f[j]; } }
            s = wave_sum(s); s2 = wave_sum(s2);
            const float mean = s * (1.f / 1536.f), var = fmaxf(s2 * (1.f / 1536.f) - mean * mean, 0.f);
            const int tok = 16 * wave + 4 * tq + u;
            if (lane == 0) { st[2 * tok] = mean; st[2 * tok + 1] = rsqrtf(var + EPS); } } }
    __syncthreads();
    const int tt = wave & 3, cp = wave >> 2;
    const unsigned q = (lane & 15) >> 2, p = lane & 3, blk = (lane >> 4) & 1;
    unsigned aaddr[8], baddr[2][2];
#pragma unroll
    for (int ks = 0; ks < 8; ++ks) aaddr[ks] = tt * 8192 + off_b(r, 2 * ks + h);
#pragma unroll
    for (int cc = 0; cc < 2; ++cc)
#pragma unroll
        for (int t2 = 0; t2 < 2; ++t2) baddr[cc][t2] = 32768u + off_b(8 * h + 4 * t2 + q, 4 * (2 * cp + cc) + 2 * blk + (p >> 1)) + 8u * (p & 1);
    for (int g = 0; g < 12; ++g) {
        const float* Wg = ws_ + (size_t)g * 16384;
        { const int ch = tid & 15, t0 = tid >> 4;
          f32x4 wa[4][2]; u32x4 vw[4], uu[4], gg4[4];
#pragma unroll
          for (int i = 0; i < 4; ++i) { const int t = t0 + 32 * i; wa[i][0] = *(const f32x4*)(Wg + t * 128 + 8 * ch); wa[i][1] = *(const f32x4*)(Wg + t * 128 + 8 * ch + 4);
              vw[i] = *(const u32x4*)(Zt + (size_t)t * NZ0 + 1536 + g * 128 + 8 * ch);
              uu[i] = *(const u32x4*)(Zt + (size_t)t * NZ0 + g * 128 + 8 * ch); gg4[i] = *(const u32x4*)(Zt + (size_t)t * NZ0 + 3584 + g * 128 + 8 * ch); }
          if (g > 0) {
#pragma unroll
              for (int i = 0; i < 4; ++i) { const int t = t0 + 32 * i; const u32x4 ov = *(const LAS u32x4*)(lds + 65536 + off_b(t, ch)); *(u32x4*)(BRt + (size_t)t * DM + (g - 1) * 128 + 8 * ch) = ov; } }
          const float* gp = lng + g * 128 + 8 * ch; const float* bp = lnb + g * 128 + 8 * ch;
          const f32x4 g0 = *(const f32x4*)gp, g1 = *(const f32x4*)(gp + 4), b0 = *(const f32x4*)bp, b1 = *(const f32x4*)(bp + 4);
#pragma unroll
          for (int i = 0; i < 4; ++i) { const int t = t0 + 32 * i;
              f32x4 a0 = wa[i][0], a1 = wa[i][1];
              if (t < 64 && ch >= 8) { a0 = (f32x4){0.f, 0.f, 0.f, 0.f}; a1 = a0; }
              u32x4 w; w.x = pk2(a0[0], a0[1]); w.y = pk2(a0[2], a0[3]); w.z = pk2(a1[0], a1[1]); w.w = pk2(a1[2], a1[3]);
              *(LAS u32x4*)(lds + off_b(t, ch)) = w;
              const float mean = st[2 * t], rstd = st[2 * t + 1];
              u32x4 o;
              o.x = pk2((bflo(vw[i].x) - mean) * rstd * g0[0] + b0[0], (bfhi(vw[i].x) - mean) * rstd * g0[1] + b0[1]);
              o.y = pk2((bflo(vw[i].y) - mean) * rstd * g0[2] + b0[2], (bfhi(vw[i].y) - mean) * rstd * g0[3] + b0[3]);
              o.z = pk2((bflo(vw[i].z) - mean) * rstd * g1[0] + b1[0], (bfhi(vw[i].z) - mean) * rstd * g1[1] + b1[1]);
              o.w = pk2((bflo(vw[i].w) - mean) * rstd * g1[2] + b1[2], (bfhi(vw[i].w) - mean) * rstd * g1[3] + b1[3]);
              *(LAS u32x4*)(lds + 32768 + off_b(t, ch)) = o;
              *(LAS u32x4*)(lds + 65536 + off_b(t, ch)) = uu[i]; *(LAS u32x4*)(lds + 98304 + off_b(t, ch)) = gg4[i]; } }
        __syncthreads();
        f32x16 acc[2];
#pragma unroll
        for (int i = 0; i < 16; ++i) { acc[0][i] = 0.f; acc[1][i] = 0.f; }
#pragma unroll
        for (int ks = 0; ks < 8; ++ks) {
            const bf16x8 af = *(LAS bf16x8*)(lds + aaddr[ks]);
#pragma unroll
            for (int cc = 0; cc < 2; ++cc) {
                const s16x4 lo = __builtin_amdgcn_ds_read_tr16_b64_v4i16((LAS s16x4*)(lds + baddr[cc][0] + ks * 4096));
                const s16x4 hi = __builtin_amdgcn_ds_read_tr16_b64_v4i16((LAS s16x4*)(lds + baddr[cc][1] + ks * 4096));
                const bf16x8 bfv = __builtin_shufflevector(lo, hi, 0, 1, 2, 3, 4, 5, 6, 7);
                acc[cc] = MFMA32(bfv, af, acc[cc]); }
        }
        int r2 = r, h2 = h; asm volatile("" : "+v"(r2), "+v"(h2));
        { const int t = 32 * tt + r2; const float bsv = bs_[g * 128 + t];
#pragma unroll
          for (int k8 = 0; k8 < 8; ++k8) { const int cc = k8 >> 2, q4 = k8 & 3;
              const unsigned ad = off_b(t, 4 * (2 * cp + cc) + q4) + 8u * h2;
              const u32x2 uw = *(const LAS u32x2*)(lds + 65536 + ad), gw = *(const LAS u32x2*)(lds + 98304 + ad);
              const float v0 = bflo(uw.x) * (acc[cc][4 * q4 + 0] + bsv) * silu_f(bflo(gw.x)), v1 = bfhi(uw.x) * (acc[cc][4 * q4 + 1] + bsv) * silu_f(bfhi(gw.x));
              const float v2 = bflo(uw.y) * (acc[cc][4 * q4 + 2] + bsv) * silu_f(bflo(gw.y)), v3 = bfhi(uw.y) * (acc[cc][4 * q4 + 3] + bsv) * silu_f(bfhi(gw.y));
              u32x2 w; w.x = pk2(v0, v1); w.y = pk2(v2, v3);
              *(LAS u32x2*)(lds + 65536 + ad) = w; } }
        __syncthreads();
    }
    { const int ch = tid & 15, t0 = tid >> 4;
#pragma unroll
      for (int i = 0; i < 4; ++i) { const int t = t0 + 32 * i; const u32x4 ov = *(const LAS u32x4*)(lds + 65536 + off_b(t, ch)); *(u32x4*)(BRt + (size_t)t * DM + 11 * 128 + 8 * ch) = ov; } }
}
constexpr int NPHASE = 1 + 3 * NLAYER;
#ifndef MK_PER_PHASE
#define MK_PER_PHASE 0
#endif

__device__ __forceinline__ void grid_bar(unsigned* base, unsigned k  , int tid) {
    __syncthreads();
    if (tid == 0) {
        __builtin_amdgcn_fence(__ATOMIC_RELEASE, "agent");
        const unsigned G = gridDim.x, x = blockIdx.x & 7u, gsize = (G - x + 7u) >> 3, ngroups = G < 8u ? G : 8u;
        const unsigned prev = __hip_atomic_fetch_add(base + 64 * (1 + x), 1u, __ATOMIC_RELAXED, __HIP_MEMORY_SCOPE_AGENT);
        if (prev + 1u == k * gsize) __hip_atomic_fetch_add(base, 1u, __ATOMIC_RELAXED, __HIP_MEMORY_SCOPE_AGENT);
        while (__hip_atomic_load(base, __ATOMIC_RELAXED, __HIP_MEMORY_SCOPE_AGENT) < k * ngroups) __builtin_amdgcn_s_sleep(1);
        __builtin_amdgcn_fence(__ATOMIC_ACQUIRE, "agent");
    }
    __syncthreads();
}

__global__ void __launch_bounds__(512) mk_fwd(Params P) {
    extern __shared__ __attribute__((aligned(16))) unsigned char shm[];
    LAS unsigned char* lds = (LAS unsigned char*)shm;
    cg::grid_group grid = cg::this_grid();
    const int G = gridDim.x, NGW = G * 8;
    int redo = 0; (void)redo;
    for (int ph = P.ph_lo; ph < P.ph_hi; ++ph) {
        int tid = threadIdx.x; asm volatile("" : "+v"(tid));
        const int wave = __builtin_amdgcn_readfirstlane(tid >> 6), lane = tid & 63, gw = blockIdx.x * 8 + wave;
        unsigned char* ws = P.ws; asm volatile("" : "+s"(ws));
        bf16_t* const WOUT = (bf16_t*)(ws + WS_WOUT); bf16_t* const WKV = (bf16_t*)(ws + WS_WKV); bf16_t* const MEMN = (bf16_t*)(ws + WS_MEMN);
        bf16_t* const KVM = (bf16_t*)(ws + WS_KVM); float* const LS = (float*)(ws + WS_LS); float* const SSQ = (float*)(ws + WS_SSQ);
        bf16_t* const HB = (bf16_t*)(ws + WS_HB); bf16_t* const BR = (bf16_t*)(ws + WS_BR); bf16_t* const Z = (bf16_t*)(ws + WS_Z);

        if (ph == 0) {
            LAS float* scr = (LAS float*)(lds + wave * 16384);
            constexpr int I0 = 32 * 176, I1 = 32 * 225, I2 = 32 * 224, IO = 32 * 64, IK = 32 * 32;
            constexpr int NIT = 2 * I0 + I1 + I2 + 4 * IO + 4 * IK;
            for (int it = gw; it < NIT; it += NGW) {
                int r = it;
                if (r < I0) { tr_item(P.a_w_in, NZ0, (bf16_t*)(ws + WS_WIN0), r, lane, scr, 0, P.norm_g); continue; } r -= I0;
                if (r < I1) { tr_item(P.b_w_in, NSRC1, (bf16_t*)(ws + WS_WIN1), r, lane, scr, 1, P.norm_g + DM); continue; } r -= I1;
                if (r < I2) { tr_item(P.c_w_in, NZ2, (bf16_t*)(ws + WS_WIN2), r, lane, scr, 0, P.norm_g + 2 * DM); continue; } r -= I2;
                if (r < I0) { tr_item(P.a_w_in + (size_t)DM * NZ0, NZ0, (bf16_t*)(ws + WS_WIN3), r, lane, scr, 0, P.norm_g + 3 * DM); continue; } r -= I0;
                if (r < 4 * IO) { const int L = r / IO; tr_item(P.w_out + (size_t)L * DM * DM, DM, WOUT + (size_t)L * DM * DM, r - L * IO, lane, scr, 0, nullptr); continue; } r -= 4 * IO;
                { const int L = r / IK; tr_item(P.w_mem_kv + (size_t)L * DM * 1024, 1024, WKV + (size_t)L * 1024 * DM, r - L * IK, lane, scr, 0, nullptr); }
            }
            { u32x4* zp = (u32x4*)((bf16_t*)(ws + WS_WIN1) + (size_t)NSRC1 * DM); const int nz = (NZ1 - NSRC1) * DM / 8;
              for (int i = blockIdx.x * 512 + tid; i < nz; i += G * 512) zp[i] = (u32x4){0u, 0u, 0u, 0u}; }
            for (int m = gw; m < NB * NMEM; m += NGW) rms_row_to_bf16(P.mem + (size_t)m * DM, P.mem_norm_g, MEMN + (size_t)m * DM, lane);
            for (int m = gw; m < NTOK; m += NGW) row_to_bf16_ssq(P.x + (size_t)m * DM, HB + (size_t)m * DM, SSQ + m, lane);
            for (int i = blockIdx.x * 512 + tid; i < 3 * NTOK; i += G * 512) SSQ[NTOK + i] = 0.f;
            if (blockIdx.x == 0) { float* gt = (float*)(ws + WS_GT);
                if (tid < 9) { ((unsigned*)(ws + WS_GT))[4096 + 64 * tid] = 0u; ((unsigned*)(ws + WS_GT))[8192 + 64 * tid] = 0u; }
                for (int i = tid; i < 2064; i += 512) { float v = 0.f;
                    if (i < 1536) { const int Lq = i / 384, w = (i % 384) / 128, d = i & 127, kd = Lq % 3;
                        if (w == 2) v = P.mem_q_norm_g[Lq * 128 + d];
                        else if (kd == 1) v = (w == 0 ? P.b_q_norm_g : P.b_k_norm_g)[d];
                        else if (kd == 2) v = (w == 0 ? P.c_q_norm_g : P.c_k_norm_g)[d & 63];
                    } else if (i < 2048) v = P.mem_k_norm_g[i - 1536];
                    else if (i < 2060) v = P.b_b_f[i - 2048];
                    gt[i] = v; }
                if (tid < 19) {
                    float v = 0.f;
                    if (tid < 16) { const int Lq = tid >> 2, w = tid & 3, kd = Lq % 3;
                        if (w == 2) { for (int i = 0; i < 128; ++i) v = fmaxf(v, fabsf(P.mem_q_norm_g[Lq * 128 + i])); }
                        else if (w == 3) { for (int i = 0; i < 128; ++i) v = fmaxf(v, fabsf(P.mem_k_norm_g[Lq * 128 + i])); }
                        else if (kd == 1) { const float* gsrc = (w == 0) ? P.b_q_norm_g : P.b_k_norm_g; for (int i = 0; i < 128; ++i) v = fmaxf(v, fabsf(gsrc[i])); }
                        else if (kd == 2) { const float* gsrc = (w == 0) ? P.c_q_norm_g : P.c_k_norm_g; for (int i = 0; i < 64; ++i) v = fmaxf(v, fabsf(gsrc[i])); }
                    } else if (tid == 16) { for (int i = 0; i < 384; ++i) v = fmaxf(v, P.rel_bias[i]); }
                    else if (tid == 17) { for (int i = 0; i < 64; ++i) v += P.c_lam[i] * P.c_lam[64 + i]; }
                    else { for (int i = 0; i < 64; ++i) v += P.c_lam[128 + i] * P.c_lam[192 + i]; }
                    gt[2080 + tid] = v; } }
        } else {
            const int L = (ph - 1) / 3, sub = (ph - 1) % 3, kind = L % 3;
            const int NZ = (kind == 0) ? NZ0 : (kind == 1 ? NZ1 : NZ2);
            const int memq_off = (kind == 0) ? 3072 : 4608;
            if (sub == 0) {
                for (int jb = (L == 0 ? 0 : 1); jb < 2; ++jb) {
                    pg8::Gemm g; EpiZ E;
                    LAS float* part = (LAS float*)(lds + LDS_PART);
                    if (jb == 0) { g = pg8::Gemm{MEMN, WKV, NB * NMEM, 4096, DM}; E = EpiZ{ws, part, 4096, 3, 0}; }
                    else { bf16_t* wt = (bf16_t*)(ws + (L == 0 ? WS_WIN0 : L == 1 ? WS_WIN1 : L == 2 ? WS_WIN2 : WS_WIN3));
                           g = pg8::Gemm{HB, wt, NTOK, NZ, DM}; E = EpiZ{ws, part, NZ, kind, L}; }
                    pg8::StaticOrder S; S.init(g.M, g.N, G, (int)blockIdx.x);
                    pg8::gemm_phase<EpiZ, pg8::StaticOrder, true, true>(lds, g, S, E, tid);
                }
            } else if (sub == 1) {
                const int gate_off = memq_off + 512;
                const float* gx = (const float*)(ws + WS_GT) + 2080;
                const float gqm = gx[4 * L], gkm = gx[4 * L + 1], gmq = gx[4 * L + 2], gmk = gx[4 * L + 3];
                const float m2_mem = 11.3137085f * gmq * gmk * 1.01f * LOG2E;
                if (kind == 0) {
                    const int j = L / 3;
#ifdef REP_GM
                    for (int rep_ = 0; rep_ < 2; ++rep_)
#endif
                    for (int it = blockIdx.x; it < NTOK / 128; it += G)
                        gmlp_item(lds, Z + (size_t)it * 128 * NZ0, BR + (size_t)it * 128 * DM, P.a_w_s + (size_t)j * 12 * 16384, P.a_b_s + j * 1536, P.a_ln_g + j * 1536, P.a_ln_b + j * 1536, tid);
                } else if (kind == 1) {
                    for (int it = blockIdx.x; it < 1536; it += G) {
                        const int c = it & 255, rr = it >> 8, bh = rr * 16 + (c & 7) * 2 + (c >> 7); int j = (c >> 3) & 15; if (rr & 1) j = 15 - j;
                        const int b = bh / 12, hh = bh - b * 12;
                        const bf16_t* Zb = Z + (size_t)b * SEQ * NZ1;
                        AttnArgs a; a.Q = Zb + hh * 128; a.K = Zb + 1536 + hh * 128; a.V = Zb + 3072 + hh * 128; a.G = Zb + gate_off + hh * 128; a.O = BR + (size_t)b * SEQ * DM + hh * 128;
                        a.ldq = NZ1; a.ldkv = NZ1; a.ldg = NZ1; a.ldo = DM; a.q0 = 256 * j; a.ntiles = 4 * j + 4; a.c = LS + (size_t)b * SEQ * 16 + hh; a.lutsrc = nullptr; a.subg = nullptr;
                        a.sc = 0.08838834764831845f * LOG2E; a.lam = 0.f; a.outmul = 1.f; a.m2 = 11.3137085f * gqm * gkm * 1.01f * LOG2E;
                        attn_item<1>(lds, a, tid);
                    }
                } else {
                    const float d01 = gx[17], d23 = gx[18];
                    const float lam_init = 0.8f - 0.6f * expf(-0.3f * (float)L);
                    const float lam_val = expf(d01) - expf(d23) + lam_init;
                    const float bmax = gx[16];
                    const float m2_diff = (8.f * gqm * gkm * 1.01f + bmax) * LOG2E;
                    for (int it = blockIdx.x; it < 3072; it += G) {
                        const int c = it & 255, rr = it >> 8, bh = rr * 8 + (c & 7); int j = c >> 3; if (rr & 1) j = 31 - j;
                        const int b = bh / 12, hh = bh - b * 12;
                        const bf16_t* Zb = Z + (size_t)b * SEQ * NZ2;
                        AttnArgs a; a.Q = Zb + hh * 128; a.K = Zb + 1536 + hh * 128; a.V = Zb + 3072 + hh * 128; a.G = Zb + gate_off + hh * 128; a.O = BR + (size_t)b * SEQ * DM + hh * 128;
                        a.ldq = NZ2; a.ldkv = NZ2; a.ldg = NZ2; a.ldo = DM; a.q0 = 128 * j; a.ntiles = 2 * j + 2; a.c = nullptr; a.lutsrc = P.rel_bias + hh; a.subg = P.c_subln_g;
                        a.sc = 0.125f * LOG2E; a.lam = lam_val; a.outmul = 1.f - lam_init; a.m2 = m2_diff;
                        attn_item<2>(lds, a, tid);
                    }
                }
#ifdef REP_MEM
                for (int rep_ = 0; rep_ < 2; ++rep_)
#endif
                for (int it = blockIdx.x; it < 512; it += G) {
                    const int qb = it & 15, hm = (it >> 4) & 3, b = it >> 6;
                    const bf16_t* Zb = Z + (size_t)b * SEQ * NZ;
                    AttnArgs a; a.Q = Zb + memq_off + hm * 128; a.K = KVM + (size_t)b * NMEM * 4096 + L * 1024 + hm * 128; a.V = a.K + 512; a.G = Zb + gate_off + 1536 + hm * 128;
                    a.O = BR + (size_t)b * SEQ * DM + 1536 + hm * 128;
                    a.ldq = NZ; a.ldkv = 4096; a.ldg = NZ; a.ldo = DM; a.q0 = 256 * qb; a.ntiles = 4; a.c = nullptr; a.lutsrc = nullptr; a.subg = nullptr;
                    a.sc = 0.08838834764831845f * LOG2E; a.lam = 0.f; a.outmul = 1.f; a.m2 = m2_mem;
                    attn_item<0>(lds, a, tid);
                }
                __syncthreads();
            } else {
                pg8::Gemm g{BR, WOUT + (size_t)L * DM * DM, NTOK, DM, DM};
                EpiOut E{L == 0 ? P.x : P.out, P.out, HB, (L + 1 < NLAYER) ? SSQ + (size_t)(L + 1) * NTOK : nullptr};
#ifdef REP_OUT0
                if (redo) E.ssq = nullptr;
#endif
                pg8::StaticOrder S; S.init(g.M, g.N, G, (int)blockIdx.x);
                pg8::gemm_phase<EpiOut, pg8::StaticOrder, true, true>(lds, g, S, E, tid);
            }
        }
#ifdef REP_P0
        if (ph == 0 && !redo) { redo = 1; __syncthreads(); --ph; continue; }
        redo = 0;
#endif
#ifdef REP_OUT0
        if (ph == 3 && !redo) { redo = 1; __syncthreads(); --ph; continue; }
        redo = 0;
#endif
#ifdef REP_SUB
        if (ph > 0 && (ph - 1) % 3 == REP_SUB && ((REP_L >> ((ph - 1) / 3)) & 1) && !redo) { redo = 1; __syncthreads(); --ph; continue; }
        redo = 0;
#endif
        if (ph + 1 < P.ph_hi) { if (ph == 0) grid.sync(); else grid_bar((unsigned*)(ws + WS_GT) + 4096, (unsigned)ph, tid); }
#ifdef REP_SYNC
        if (ph == 0) for (int i_ = 0; i_ < 10; ++i_) grid.sync();
#endif
#ifdef REP_BAR
        if (ph == 0) { for (int i_ = 0; i_ < 10; ++i_) grid_bar((unsigned*)(ws + WS_GT) + 8192, (unsigned)(i_ + 1), tid); }
#endif
    }
}

extern "C" void kernel_launch(void* const* d_in, const int* in_sizes, int n_in, void* d_out, int out_size, void* d_ws, size_t ws_size, hipStream_t stream) {
    static int grid = 0;
    if (grid == 0) {
        if (n_in != 23 || ws_size < WS_END) { fprintf(stderr, "kernel_launch: unexpected inputs (n_in %d, ws %zu)\n", n_in, ws_size); grid = -1; return; }
        int dev = 0, cus = 0, per_cu = 0;
        hipGetDevice(&dev); hipDeviceGetAttribute(&cus, hipDeviceAttributeMultiprocessorCount, dev);
        if (hipFuncSetAttribute((const void*)mk_fwd, hipFuncAttributeMaxDynamicSharedMemorySize, LDS_BYTES) != hipSuccess) fprintf(stderr, "kernel_launch: hipFuncSetAttribute failed\n");
        if (hipOccupancyMaxActiveBlocksPerMultiprocessor(&per_cu, (const void*)mk_fwd, 512, LDS_BYTES) != hipSuccess || per_cu < 1) { fprintf(stderr, "kernel_launch: occupancy query says %d\n", per_cu); per_cu = 1; }
        (void)hipGetLastError();
        grid = cus * per_cu;
        fprintf(stderr, "kernel_launch: grid %d (cus %d x %d)\n", grid, cus, per_cu);
    }
    if (grid < 0) return;
    Params p{};
    const float** pp = (const float**)&p;
    for (int i = 0; i < 23; ++i) pp[i] = (const float*)d_in[i];
    p.out = (float*)d_out; p.ws = (unsigned char*)d_ws;
#if MK_PER_PHASE
    for (int ph = 0; ph < NPHASE; ++ph) { p.ph_lo = ph; p.ph_hi = ph + 1; hipLaunchKernelGGL(mk_fwd, dim3(grid), dim3(512), LDS_BYTES, stream, p); }
#else
    p.ph_lo = 0; p.ph_hi = NPHASE;
    void* args[] = {&p};
    hipError_t e = hipLaunchCooperativeKernel((void*)mk_fwd, dim3(grid), dim3(512), args, LDS_BYTES, stream);
    if (e != hipSuccess) fprintf(stderr, "cooperative launch failed: %s (grid %d)\n", hipGetErrorString(e), grid);
#endif
}
```

```cpp
#include <hip/hip_runtime.h>
#include <hip/hip_cooperative_groups.h>
#include <cstdio>
#include <cstdint>
namespace cg = cooperative_groups;
namespace pg8 {
#define PG8_LAS __attribute__((address_space(3)))
typedef unsigned short bf16_t;
typedef short bf16x8 __attribute__((ext_vector_type(8)));
typedef float f32x4 __attribute__((ext_vector_type(4)));
typedef unsigned u32x4 __attribute__((ext_vector_type(4)));
constexpr int BM = 256, BK = 64, HALF = 128, HTB = HALF * BK * 2  , STAGE_BYTES = 8 * HTB, NXCD = 8, WGM = 8;

__host__ __device__ __forceinline__ int lds_byte(int r, int c) { const int st = (r >> 4) * 2 + (c >> 5), rr = r & 15, cc = c & 31, ob = rr * 64 + cc * 2; return st * 1024 + (ob ^ (((ob >> 9) & 1) << 5)); }
__host__ __device__ __forceinline__ void stage_rc(int b, int& R, int& C) { const int st = b / 1024, sb = b % 1024, swz = sb ^ (((sb >> 9) & 1) << 5); R = (st >> 1) * 16 + swz / 64; C = (st & 1) * 32 + (swz % 64) / 2; }
__host__ __device__ __forceinline__ int perm32(int rho) { const int n = rho >> 4, i = rho & 15; return 8 * (i >> 2) + 4 * n + (i & 3); }

struct Unit { int pm, pn; };
struct Gemm { const bf16_t* A; const bf16_t* Bt; int M, N, K; };

struct StaticOrder {
    int nM, nN, nwg, G, c;
    __host__ __device__ void init(int M, int N, int G_, int c_) { nM = M / BM; nN = N / BM; nwg = nM * nN; G = G_; c = c_; }
    __host__ __device__ bool next(int i, Unit& u) const {
        const long L = (long)i * G + c; if (L >= nwg) return false;
        int wgid = (int)L; { const int q = nwg / NXCD, r = nwg % NXCD, xcd = wgid % NXCD, off = wgid / NXCD; wgid = (xcd < r ? xcd * (q + 1) : r * (q + 1) + (xcd - r) * q) + off; }
        const int nig = WGM * nN, gid = wgid / nig, fm = gid * WGM, gsz = (nM - fm) < WGM ? (nM - fm) : WGM;
        u.pm = fm + ((wgid % nig) % gsz); u.pn = (wgid % nig) / gsz; return true;
    }
    __device__ __forceinline__ void a_ready(const Unit&) const {}
    __device__ __forceinline__ void done(const Unit&) const {}
};
__device__ __forceinline__ unsigned cvt_pk_bf16(float lo, float hi) { unsigned r; asm volatile("v_cvt_pk_bf16_f32 %0, %1, %2" : "=v"(r) : "v"(lo), "v"(hi)); return r; }
template <class Epi, class Sched, bool ALIGN_EPI = false, bool SP2 = false>
__device__ __forceinline__ void gemm_phase(PG8_LAS unsigned char* lds, const Gemm g, const Sched& S, const Epi& E, const int tid) {
    const int wid = __builtin_amdgcn_readfirstlane(tid >> 6), lane = tid & 63, wr = wid >> 2, wc = wid & 3, fr = lane & 15, fq = lane >> 4;
    const int K = g.K, nt = K / BK;
    unsigned voffA[2], voffB[2];
#pragma unroll
    for (int i = 0; i < 2; ++i) { int R, C; stage_rc(tid * 16 + i * 8192, R, C); const int Rb = Epi::PERM ? ((R & ~31) + perm32(R & 31)) : R;
        voffA[i] = (unsigned)(R * K + C) * 2u; voffB[i] = (unsigned)(Rb * K + C) * 2u; }
    const size_t kstep = (size_t)(BK * 2);
    const size_t hstep = (size_t)HALF * K * 2;
    const size_t tstep = 2 * hstep;
    const unsigned ldsw = (unsigned)wid * 1024u;
    const int aoff = lds_byte(wr * 64 + fr, fq * 8), boff = lds_byte(wc * 32 + fr, fq * 8);
#define PG8_SA(b, h) (((b) * 2 + (h)) * HTB)
#define PG8_SB(b, h) ((4 + (b) * 2 + (h)) * HTB)
#define PG8_STAGE(bufoff, gbase, voff) do { _Pragma("unroll") for (int _i = 0; _i < 2; ++_i) \
        __builtin_amdgcn_global_load_lds((const unsigned*)((const char*)(gbase) + (voff)[_i]), (PG8_LAS unsigned*)(lds + (bufoff) + ldsw + _i * 8192), 16, 0, 0); } while (0)
#define PG8_LDA(dst, b, h) do { _Pragma("unroll") for (int m = 0; m < 4; ++m) _Pragma("unroll") for (int k = 0; k < 2; ++k) dst[m][k] = *(const PG8_LAS bf16x8*)(lds + PG8_SA(b, h) + aoff + m * 2048 + k * 1024); } while (0)
#define PG8_LDB(dst, b, h) do { _Pragma("unroll") for (int n = 0; n < 2; ++n) _Pragma("unroll") for (int k = 0; k < 2; ++k) dst[n][k] = *(const PG8_LAS bf16x8*)(lds + PG8_SB(b, h) + boff + n * 2048 + k * 1024); } while (0)
#define PG8_MMA(ai, bj, At, Bt) do { __builtin_amdgcn_s_setprio(1); _Pragma("unroll") for (int m = 0; m < 4; ++m) _Pragma("unroll") for (int n = 0; n < 2; ++n) _Pragma("unroll") for (int k = 0; k < 2; ++k) \
        acc[ai][bj][m][n] = __builtin_amdgcn_mfma_f32_16x16x32_bf16(Bt[n][k], At[m][k], acc[ai][bj][m][n], 0, 0, 0); __builtin_amdgcn_s_setprio(0); } while (0)
#define PG8_WAIT_V(n) asm volatile("s_waitcnt vmcnt(" #n ")" ::: "memory")
#define PG8_WAIT_L(n) asm volatile("s_waitcnt lgkmcnt(" #n ")" ::: "memory")
#define PG8_BAR __builtin_amdgcn_s_barrier()
#define PG8_SCHED __builtin_amdgcn_sched_barrier(0)
    Unit cur, nxt; int ui = 0;
    if (!S.next(0, cur)) return;
    f32x4 acc[2][2][4][2];
#pragma unroll
    for (int a = 0; a < 2; ++a)
#pragma unroll
        for (int b = 0; b < 2; ++b)
#pragma unroll
            for (int m = 0; m < 4; ++m)
#pragma unroll
                for (int n = 0; n < 2; ++n) acc[a][b][m][n] = (f32x4){0.f, 0.f, 0.f, 0.f};
    bf16x8 At[4][2], B0[2][2], B1[2][2];
    const char* cA = (const char*)g.A + (size_t)cur.pm * tstep; const char* cB = (const char*)g.Bt + (size_t)cur.pn * tstep;
    S.a_ready(cur);
    if constexpr (SP2) {
        PG8_STAGE(PG8_SB(0, 0), cB, voffB); PG8_STAGE(PG8_SB(0, 1), cB + hstep, voffB); PG8_STAGE(PG8_SA(0, 0), cA, voffA); PG8_STAGE(PG8_SA(0, 1), cA + hstep, voffA);
        if (wr == 1) PG8_BAR;
        PG8_WAIT_V(2); PG8_BAR;
        PG8_STAGE(PG8_SB(1, 0), cB + kstep, voffB); PG8_STAGE(PG8_SA(1, 0), cA + kstep, voffA); PG8_STAGE(PG8_SB(1, 1), cB + hstep + kstep, voffB);
        PG8_WAIT_V(6); PG8_BAR;
    } else {
        PG8_STAGE(PG8_SB(0, 0), cB, voffB); PG8_STAGE(PG8_SA(0, 0), cA, voffA); PG8_STAGE(PG8_SB(0, 1), cB + hstep, voffB); PG8_STAGE(PG8_SA(0, 1), cA + hstep, voffA);
        if (wr == 1) PG8_BAR;
        PG8_WAIT_V(4); PG8_BAR;
        PG8_STAGE(PG8_SB(1, 0), cB + kstep, voffB); PG8_STAGE(PG8_SA(1, 0), cA + kstep, voffA); PG8_STAGE(PG8_SB(1, 1), cB + hstep + kstep, voffB);
        PG8_WAIT_V(6); PG8_BAR;
    }
    for (;;) {
        const bool has_next = S.next(ui + 1, nxt);
        const char* nA = has_next ? (const char*)g.A + (size_t)nxt.pm * tstep : cA; const char* nB = has_next ? (const char*)g.Bt + (size_t)nxt.pn * tstep : cB;
        for (int t = 0; t < nt; t += 2) {
            const bool last = (t == nt - 2);
            const char* a1 = cA + (size_t)(t + 1) * kstep;
            const char* a2 = last ? nA : cA + (size_t)(t + 2) * kstep; const char* b2 = last ? nB : cB + (size_t)(t + 2) * kstep;
            const char* a3 = a2 + kstep; const char* b3 = b2 + kstep;
            if (last && has_next) S.a_ready(nxt);
            if constexpr (SP2) {
            PG8_LDB(B0, 0, 0); PG8_LDB(B1, 0, 1); PG8_SCHED; PG8_LDA(At, 0, 0); PG8_STAGE(PG8_SA(1, 1), a1 + hstep, voffA);
            PG8_WAIT_V(8); PG8_WAIT_L(0); PG8_BAR; PG8_MMA(0, 0, At, B0); PG8_MMA(0, 1, At, B1); PG8_BAR; PG8_SCHED;
            PG8_LDA(At, 0, 1); PG8_STAGE(PG8_SB(0, 0), b2, voffB); PG8_STAGE(PG8_SB(0, 1), b2 + hstep, voffB); PG8_STAGE(PG8_SA(0, 0), a2, voffA);
            PG8_WAIT_V(8); PG8_WAIT_L(0); PG8_BAR; PG8_MMA(1, 0, At, B0); PG8_MMA(1, 1, At, B1); PG8_BAR; PG8_SCHED;
            PG8_LDB(B0, 1, 0); PG8_LDB(B1, 1, 1); PG8_SCHED; PG8_LDA(At, 1, 0); PG8_STAGE(PG8_SA(0, 1), a2 + hstep, voffA);
            PG8_WAIT_V(8); PG8_WAIT_L(0); PG8_BAR; PG8_MMA(0, 0, At, B0); PG8_MMA(0, 1, At, B1); PG8_BAR; PG8_SCHED;
            PG8_LDA(At, 1, 1); PG8_STAGE(PG8_SB(1, 0), b3, voffB); PG8_STAGE(PG8_SB(1, 1), b3 + hstep, voffB); PG8_STAGE(PG8_SA(1, 0), a3, voffA);
            PG8_WAIT_V(8); PG8_WAIT_L(0); PG8_BAR; PG8_MMA(1, 0, At, B0); PG8_MMA(1, 1, At, B1); PG8_BAR; PG8_SCHED;
            } else {
            PG8_LDB(B0, 0, 0); PG8_SCHED; PG8_LDA(At, 0, 0); PG8_STAGE(PG8_SA(1, 1), a1 + hstep, voffA);
            PG8_WAIT_L(8); PG8_BAR; PG8_WAIT_L(0); PG8_MMA(0, 0, At, B0); PG8_BAR; PG8_SCHED;
            PG8_LDB(B1, 0, 1); PG8_STAGE(PG8_SB(0, 0), b2, voffB);
            PG8_BAR; PG8_WAIT_L(0); PG8_MMA(0, 1, At, B1); PG8_BAR;
            PG8_LDA(At, 0, 1); PG8_STAGE(PG8_SA(0, 0), a2, voffA);
            PG8_BAR; PG8_WAIT_L(0); PG8_MMA(1, 0, At, B0); PG8_BAR; PG8_SCHED;
            PG8_STAGE(PG8_SB(0, 1), b2 + hstep, voffB);
            PG8_WAIT_V(6); PG8_BAR; PG8_MMA(1, 1, At, B1); PG8_BAR;
            PG8_LDB(B0, 1, 0); PG8_SCHED; PG8_LDA(At, 1, 0); PG8_STAGE(PG8_SA(0, 1), a2 + hstep, voffA);
            PG8_WAIT_L(8); PG8_BAR; PG8_WAIT_L(0); PG8_MMA(0, 0, At, B0); PG8_BAR; PG8_SCHED;
            PG8_LDB(B1, 1, 1); PG8_STAGE(PG8_SB(1, 0), b3, voffB);
            PG8_BAR; PG8_WAIT_L(0); PG8_MMA(0, 1, At, B1); PG8_BAR;
            PG8_LDA(At, 1, 1); PG8_STAGE(PG8_SA(1, 0), a3, voffA);
            PG8_BAR; PG8_WAIT_L(0); PG8_MMA(1, 0, At, B0); PG8_BAR; PG8_SCHED;
            PG8_STAGE(PG8_SB(1, 1), b3 + hstep, voffB);
            PG8_WAIT_V(6); PG8_BAR; PG8_MMA(1, 1, At, B1); PG8_BAR;
            }
        }
        if constexpr (ALIGN_EPI) { if (wr == 0) PG8_BAR; }
        if constexpr (!Epi::AFTER_DRAIN) { E(acc, cur, wr, wc, fr, fq); S.done(cur); }
        if (!has_next) break;
#pragma unroll
        for (int a = 0; a < 2; ++a)
#pragma unroll
            for (int b = 0; b < 2; ++b)
#pragma unroll
                for (int m = 0; m < 4; ++m)
#pragma unroll
                    for (int n = 0; n < 2; ++n) acc[a][b][m][n] = (f32x4){0.f, 0.f, 0.f, 0.f};
        cur = nxt; cA = nA; cB = nB; ++ui;
        if constexpr (ALIGN_EPI) { if (wr == 1) PG8_BAR; }
    }
    PG8_WAIT_V(0);
    if constexpr (!ALIGN_EPI) { if (wr == 0) PG8_BAR; }
    PG8_BAR;
    if constexpr (Epi::AFTER_DRAIN) { E.fused(acc, cur, wr, wc, fr, fq, lds, wid, lane); S.done(cur); }
#undef PG8_SA
#undef PG8_SB
#undef PG8_STAGE
#undef PG8_LDA
#undef PG8_LDB
#undef PG8_MMA
#undef PG8_WAIT_V
#undef PG8_WAIT_L
#undef PG8_BAR
#undef PG8_SCHED
}
}
using pg8::bf16_t; using pg8::bf16x8; using pg8::f32x4; using pg8::u32x4; using pg8::cvt_pk_bf16;
#define LAS __attribute__((address_space(3)))
typedef short s16x4 __attribute__((ext_vector_type(4)));
typedef float f32x16 __attribute__((ext_vector_type(16)));
typedef unsigned u32x2 __attribute__((ext_vector_type(2)));
#define MFMA32(a, b, c) __builtin_amdgcn_mfma_f32_32x32x16_bf16((a), (b), (c), 0, 0, 0)

constexpr int DM = 2048, NB = 8, SEQ = 4096, NTOK = NB * SEQ, NMEM = 256, NLAYER = 4;
constexpr int NZ0 = 5632, NZ1 = 7424, NZ2 = 7168, NSRC1 = 7180;
constexpr float LOG2E = 1.4426950408889634f;
constexpr float EPS = 1e-6f;
constexpr size_t MiB = 1u << 20;
constexpr size_t WS_WIN0 = 0, WS_WIN1 = 22 * MiB, WS_WIN2 = 51 * MiB, WS_WIN3 = 79 * MiB, WS_WOUT = 101 * MiB, WS_WKV = 133 * MiB, WS_MEMN = 149 * MiB,
                 WS_KVM = 157 * MiB, WS_LS = 173 * MiB, WS_SSQ = 175 * MiB, WS_GT = 176 * MiB, WS_HB = 177 * MiB, WS_BR = 305 * MiB, WS_Z = 433 * MiB, WS_END = 897 * MiB;
constexpr int LDS_MISC = 131072;
constexpr int LDS_PART = 131072;
constexpr int LDS_BYTES = 131072 + 8192 + 4096;

struct Params {
    const float *x, *mem, *mem_norm_g, *rel_bias, *norm_g, *w_mem_kv, *mem_q_norm_g, *mem_k_norm_g, *w_out, *a_w_in, *a_ln_g, *a_ln_b, *a_w_s, *a_b_s,
                *b_w_in, *b_b_f, *b_q_norm_g, *b_k_norm_g, *c_w_in, *c_q_norm_g, *c_k_norm_g, *c_lam, *c_subln_g;
    float* out; unsigned char* ws; int ph_lo, ph_hi;
};

__device__ __forceinline__ unsigned off_b(unsigned row, unsigned ch) { return 256u * row + 16u * (ch ^ (((row & 3u) << 2) | ((row >> 2) & 3u))); }
__device__ __forceinline__ float bf2f(unsigned short v) { return __uint_as_float(((unsigned)v) << 16); }
__device__ __forceinline__ float bflo(unsigned w) { return __uint_as_float(w << 16); }
__device__ __forceinline__ float bfhi(unsigned w) { return __uint_as_float(w & 0xffff0000u); }
__device__ __forceinline__ unsigned f2bf(float f) { unsigned u = __float_as_uint(f); return (u + 0x7fffu + ((u >> 16) & 1u)) >> 16; }
typedef float f32x2v __attribute__((ext_vector_type(2)));
typedef __bf16 bf16x2v __attribute__((ext_vector_type(2)));
__device__ __forceinline__ unsigned pk2(float lo, float hi) { const f32x2v v = {lo, hi}; return __builtin_bit_cast(unsigned, __builtin_convertvector(v, bf16x2v)); }
__device__ __forceinline__ float fast_exp2(float x) { return __builtin_amdgcn_exp2f(x); }
__device__ __forceinline__ float fast_rcp(float x) { return __builtin_amdgcn_rcpf(x); }
__device__ __forceinline__ float silu_f(float g) { return g * fast_rcp(1.f + fast_exp2(-g * LOG2E)); }
__device__ __forceinline__ float gelu_tanh_f(float x) { const float u = 0.7978845608028654f * (x + 0.044715f * x * x * x); return x * fast_rcp(1.f + fast_exp2(-2.f * LOG2E * u)); }
__device__ __forceinline__ float wave_sum(float v) {
#pragma unroll
    for (int o = 1; o < 64; o <<= 1) v += __shfl_xor(v, o);
    return v;
}

struct EpiZ {
    static constexpr bool PERM = true, AFTER_DRAIN = false;
    unsigned char* ws; LAS float* part; int ldc; int kind; int L;
    __device__ __forceinline__ void operator()(const f32x4 (&acc)[2][2][4][2], const pg8::Unit& u, int wr, int wc, int fr, int fq) const {
        asm volatile("" : "+v"(fr), "+v"(fq));
        const int lrow0 = wr * 64 + fr, row0 = u.pm * 256 + lrow0, colt = u.pn * 256, pn = u.pn;
        bf16_t* const Z = (bf16_t*)(ws + (kind == 3 ? WS_KVM : WS_Z)); float* const LS = (float*)(ws + WS_LS);
        const float* const ssq = (kind == 3) ? nullptr : (const float*)(ws + WS_SSQ) + (size_t)L * NTOK;
        const float* const gt = (const float*)(ws + WS_GT);
        const float* const bfp = gt + 2048; const float* const gq = gt + 384 * L; const float* const gk = gq + 128; const float* const gm = (kind == 3) ? gt + 1536 : gq + 256;
        if (kind == 1 && pn == 28) {
            if (wc == 0) {
#pragma unroll
                for (int ai = 0; ai < 2; ++ai)
#pragma unroll
                    for (int m = 0; m < 4; ++m) { const int row = row0 + ai * 128 + m * 16;
#pragma unroll
                        for (int n = 0; n < 2; ++n)
#pragma unroll
                            for (int j = 0; j < 4; ++j) { const int col = 8 * fq + 4 * n + j;
                                if (col < 12) { const float xv = acc[ai][0][m][n][j] * rsqrtf(ssq[row] * (1.f / DM) + EPS) + bfp[col]; LS[(size_t)row * 16 + col] = fminf(xv, 0.f) - log1pf(expf(-fabsf(xv))); } } }
            }
            return;
        }
        int W = 0; const float* g = nullptr;
        if (kind == 0) { if (pn == 12 || pn == 13) { W = 128; g = gm; } }
        else if (kind == 3) { if ((pn & 3) < 2) { W = 128; g = gm + (pn >> 2) * 128; } }
        else { if (pn < 6) { W = (kind == 1) ? 128 : 64; g = gq; } else if (pn < 12) { W = (kind == 1) ? 128 : 64; g = gk; } else if (pn == 18 || pn == 19) { W = 128; g = gm; } }
        const bool act = (kind == 0) && (pn < 12);
        f32x4 g0 = (f32x4){1.f, 1.f, 1.f, 1.f}, g1 = g0;
        if (W) {
#pragma unroll
            for (int ai = 0; ai < 2; ++ai)
#pragma unroll
                for (int m = 0; m < 4; ++m)
#pragma unroll
                    for (int bj = 0; bj < 2; ++bj) { const f32x4 a0 = acc[ai][bj][m][0], a1 = acc[ai][bj][m][1];
                        float ss = (a0[0] * a0[0] + a0[1] * a0[1]) + (a0[2] * a0[2] + a0[3] * a0[3]) + (a1[0] * a1[0] + a1[1] * a1[1]) + (a1[2] * a1[2] + a1[3] * a1[3]);
                        ss += __shfl_xor(ss, 16); ss += __shfl_xor(ss, 32);
                        if (fq == 0) part[(lrow0 + ai * 128 + m * 16) * 8 + bj * 4 + wc] = ss; }
            asm volatile("s_waitcnt lgkmcnt(0)" ::: "memory"); __builtin_amdgcn_s_barrier(); asm volatile("" ::: "memory");
            const float* gp = g + ((32 * wc + 8 * fq) & (W - 1));
            g0 = *(const f32x4*)gp; g1 = *(const f32x4*)(gp + 4);
        }
        const float invW = W ? 1.f / (float)W : 0.f;
        const int col0 = colt + wc * 32 + 8 * fq;
#pragma unroll
        for (int ai = 0; ai < 2; ++ai) {
            float rsv[4];
#pragma unroll
            for (int m = 0; m < 4; ++m) rsv[m] = ssq ? rsqrtf(ssq[row0 + ai * 128 + m * 16] * (1.f / DM) + EPS) : 1.f;
#pragma unroll
            for (int m = 0; m < 4; ++m) { bf16_t* rowp = Z + (size_t)(row0 + ai * 128 + m * 16) * ldc + col0;
                const float rs = rsv[m];
#pragma unroll
                for (int bj = 0; bj < 2; ++bj) { float mm = rs;
                    if (W) { const f32x4 pp = *(const LAS f32x4*)(part + (lrow0 + ai * 128 + m * 16) * 8 + bj * 4);
                        const float tot = (W == 128) ? ((pp[0] + pp[1]) + (pp[2] + pp[3])) : (wc < 2 ? pp[0] + pp[1] : pp[2] + pp[3]);
                        mm = rs * rsqrtf(tot * rs * rs * invW + EPS); }
                    f32x4 v0 = acc[ai][bj][m][0] * mm * g0, v1 = acc[ai][bj][m][1] * mm * g1;
                    if (act) {
#pragma unroll
                        for (int j = 0; j < 4; ++j) { v0[j] = gelu_tanh_f(v0[j]); v1[j] = gelu_tanh_f(v1[j]); } }
                    u32x4 w; w.x = cvt_pk_bf16(v0[0], v0[1]); w.y = cvt_pk_bf16(v0[2], v0[3]); w.z = cvt_pk_bf16(v1[0], v1[1]); w.w = cvt_pk_bf16(v1[2], v1[3]);
                    *(u32x4*)(rowp + bj * 128) = w; } } }
    }
};
struct EpiOut {
    static constexpr bool PERM = false, AFTER_DRAIN = false;
    const float* Xin; float* Out; bf16_t* HBo; float* ssq;
    __device__ __forceinline__ void operator()(const f32x4 (&acc)[2][2][4][2], const pg8::Unit& u, int wr, int wc, int fr, int fq) const {
        asm volatile("" : "+v"(fr), "+v"(fq));
        const int row0 = u.pm * 256 + wr * 64 + fr, col0 = u.pn * 256 + wc * 32 + 4 * fq;
        f32x4 xr[3][4];
#define EO_LOAD(rr, slot) do { const size_t o_ = (size_t)(row0 + ((rr) >> 2) * 128 + ((rr) & 3) * 16) * DM + col0; _Pragma("unroll") for (int q_ = 0; q_ < 4; ++q_) xr[slot][q_] = *(const f32x4*)(Xin + o_ + (q_ >> 1) * 128 + (q_ & 1) * 16); } while (0)
        EO_LOAD(0, 0); EO_LOAD(1, 1);
#pragma unroll
        for (int rr = 0; rr < 8; ++rr) { const int ai = rr >> 2, m = rr & 3, row = row0 + ai * 128 + m * 16; const size_t o = (size_t)row * DM + col0; float s = 0.f;
            if (rr + 2 < 8) EO_LOAD(rr + 2, (rr + 2) % 3);
#pragma unroll
            for (int q = 0; q < 4; ++q) { const int bj = q >> 1, n = q & 1; const size_t idx = o + bj * 128 + n * 16; const f32x4 v = xr[rr % 3][q] + acc[ai][bj][m][n]; *(f32x4*)(Out + idx) = v;
                if (ssq) { u32x2 w; w.x = cvt_pk_bf16(v[0], v[1]); w.y = cvt_pk_bf16(v[2], v[3]); *(u32x2*)(HBo + idx) = w; s += (v[0] * v[0] + v[1] * v[1]) + (v[2] * v[2] + v[3] * v[3]); } }
            if (ssq) { s += __shfl_xor(s, 16); s += __shfl_xor(s, 32); if (fq == 0) atomicAdd(ssq + row, s); } }
#undef EO_LOAD
    }
};
#ifndef AT_KD
#define AT_KD 4
#endif
#ifndef AT_VD
#define AT_VD 3
#endif
struct AttnArgs {
    const bf16_t *Q, *K, *V, *G; bf16_t* O;
    int ldq, ldkv, ldg, ldo, q0, ntiles;
    const float* c;
    const float* lutsrc;
    const float* subg;
    float sc, lam, outmul, m2;
};
constexpr int A_CS = 65536, A_LUT = 65536 + 16384;

template <int MODE>
__device__ __forceinline__ void attn_item(LAS unsigned char* lds, const AttnArgs& a, const int tid) {
    const int wave = __builtin_amdgcn_readfirstlane(tid >> 6), lane = tid & 63, r = lane & 31, h = lane >> 5;
    constexpr int NKS = (MODE == 2) ? 4 : 8;
    const int map = (MODE == 2) ? (wave >> 2) : 0;
    const int qw0 = a.q0 + 32 * ((MODE == 2) ? (wave & 3) : wave);
    const int tw = (MODE == 0) ? (a.ntiles - 1) : (MODE == 1 ? ((qw0 + 31) >> 6) : (qw0 >> 6));
    __syncthreads();
    if (MODE == 2) {
        if (tid < 255) { const int rel = tid - 191; const int n = rel < 0 ? -rel : rel; int bkt;
            if (n < 8) bkt = n; else { const float nf = (float)n; int lg = 8 + (int)(logf(nf / 8.0f) / 2.772588722239781f * 8.0f); bkt = lg < 15 ? lg : 15; }
            if (rel > 0) bkt += 16;
            ((LAS float*)(lds + A_LUT))[tid] = a.lutsrc[bkt * 12] * LOG2E - a.m2; }
    }
    bf16x8 qf[NKS];
    { const bf16_t* qrow = a.Q + (size_t)(qw0 + r) * a.ldq + map * 64 + 8 * h;
#pragma unroll
      for (int ks = 0; ks < NKS; ++ks) qf[ks] = *(const bf16x8*)(qrow + 16 * ks); }
    if (MODE == 1) {
        LAS float* cl = (LAS float*)(lds + A_CS); LAS float* wtot = (LAS float*)(lds + A_LUT);
        const int n = a.q0 + 256; const bool on = 8 * tid < n;
        float v[8]; float run = 0.f;
        const float* lp = a.c + (size_t)(8 * tid) * 16;
#pragma unroll
        for (int e = 0; e < 8; ++e) { if (on) run += lp[e * 16]; v[e] = run; }
        float incl = run;
#pragma unroll
        for (int o = 1; o < 64; o <<= 1) { const float x = __shfl_up(incl, o); if (lane >= o) incl += x; }
        if (lane == 63) wtot[wave] = incl;
        __syncthreads();
        float pre = incl - run;
        for (int w = 0; w < wave; ++w) pre += wtot[w];
        if (on) {
#pragma unroll
            for (int e = 0; e < 8; ++e) cl[8 * tid + e] = -(pre + v[e]) * LOG2E; }
    }
    unsigned kaddr[NKS];
    { const unsigned X = ((r & 3u) << 2) | ((r >> 2) & 3u);
#pragma unroll
      for (int ks = 0; ks < NKS; ++ks) kaddr[ks] = 256u * r + 16u * ((unsigned)(2 * (map * 4 + ks) + h) ^ X); }
    unsigned vaddr[4][2];
    { const unsigned q = (lane & 15) >> 2, p = lane & 3, blk = (lane >> 4) & 1;
#pragma unroll
      for (int dt = 0; dt < 4; ++dt)
#pragma unroll
          for (int t2 = 0; t2 < 2; ++t2) vaddr[dt][t2] = 16384u + off_b(8 * t2 + 4 * h + q, 4 * dt + 2 * blk + (p >> 1)) + 8u * (p & 1); }
    const unsigned sX = ((unsigned)(lane >> 4) << 2) | (unsigned)(wave & 3);
    const size_t sgoff = (size_t)(4 * wave + (lane >> 4)) * a.ldkv + (size_t)(((unsigned)(lane & 15) ^ sX) * 8u);
    const bf16_t* kg = a.K + sgoff; const bf16_t* vg = a.V + sgoff;
    const size_t tstep = (size_t)64 * a.ldkv, hstep = (size_t)32 * a.ldkv;
#define AT_DMA1(gp, la) asm volatile("s_mov_b32 m0, %1\n\ts_nop 0\n\tglobal_load_lds_dwordx4 %0, off" :: "v"(gp), "s"(la) : "memory", "m0")
#define AT_DMA(t, b) do { const bf16_t* kp = kg + (size_t)(t) * tstep; const bf16_t* vp = vg + (size_t)(t) * tstep; const unsigned la = (unsigned)(size_t)(lds + (b) * 32768 + wave * 1024); \
        AT_DMA1(kp, la); AT_DMA1(kp + hstep, la + 8192u); AT_DMA1(vp, la + 16384u); AT_DMA1(vp + hstep, la + 16384u + 8192u); } while (0)
    float l = 0.f;
    f32x16 o[4];
#pragma unroll
    for (int dt = 0; dt < 4; ++dt)
#pragma unroll
        for (int i = 0; i < 16; ++i) o[dt][i] = 0.f;
    AT_DMA(0, 0);
    asm volatile("s_waitcnt vmcnt(0)" ::: "memory");
    __syncthreads();
#pragma unroll
    for (int ks = 0; ks < NKS; ++ks) asm volatile("" : "+v"(qf[ks]));
    float b15 = 0.f; if (MODE == 2) b15 = ((LAS float*)(lds + A_LUT))[0];
    float addc = -a.m2; if (MODE == 1) addc = -((LAS float*)(lds + A_CS))[qw0 + r] - a.m2; if (MODE == 2) addc = b15;
    const int nt = a.ntiles;
    for (int tt2 = 0; tt2 < nt; tt2 += 2)
#pragma unroll
    for (int bb = 0; bb < 2; ++bb) {
        const int t = tt2 + bb;
        constexpr int dummy_ = 0; (void)dummy_;
        const int b = bb;
        if (t + 1 < nt) AT_DMA(t + 1, b ^ 1);
        if (t <= tw) {
            LAS unsigned char* kb = lds + b * 32768;
            f32x16 s[2];
#pragma unroll
            for (int i = 0; i < 16; ++i) { s[0][i] = 0.f; s[1][i] = 0.f; }
            constexpr int KD = AT_KD, VD = AT_VD;
            bf16x8 kf[KD];
#define AT_KLD(i) (*(LAS bf16x8*)(kb + kaddr[(i) >> 1] + ((i) & 1) * 8192))
#pragma unroll
            for (int i = 0; i < KD; ++i) kf[i] = AT_KLD(i);
#pragma unroll
            for (int i = 0; i < 2 * NKS; ++i) { s[i & 1] = MFMA32(kf[i % KD], qf[i >> 1], s[i & 1]); if (i + KD < 2 * NKS) kf[i % KD] = AT_KLD(i + KD); }
#undef AT_KLD
            bf16x8 vf[VD];
#define AT_VLD(j) do { const s16x4 lo_ = __builtin_amdgcn_ds_read_tr16_b64_v4i16((LAS s16x4*)(kb + vaddr[(j) & 3][0] + (32 * ((j) >> 3) + 16 * (((j) >> 2) & 1)) * 256)); \
                const s16x4 hi_ = __builtin_amdgcn_ds_read_tr16_b64_v4i16((LAS s16x4*)(kb + vaddr[(j) & 3][1] + (32 * ((j) >> 3) + 16 * (((j) >> 2) & 1)) * 256)); \
                vf[(j) % VD] = __builtin_shufflevector(lo_, hi_, 0, 1, 2, 3, 4, 5, 6, 7); } while (0)
#pragma unroll
            for (int j = 0; j < VD; ++j) AT_VLD(j);
            const float sc = a.sc;
            const bool diag = (MODE == 1) && (t * 64 + 63 > qw0);
            const bool near = (MODE == 2) && (t >= tw - 2);
            bf16x8 pf[2];
#pragma unroll
            for (int kt = 0; kt < 2; ++kt) {
                if (MODE == 1) {
                    const LAS float* csb = (const LAS float*)(lds + A_CS) + t * 64 + 32 * kt + 4 * h;
                    const int mb = t * 64 + 32 * kt + 4 * h - (qw0 + r);
#pragma unroll
                    for (int g = 0; g < 4; ++g) { const f32x4 cv = *(const LAS f32x4*)(csb + 8 * g);
#pragma unroll
                        for (int e = 0; e < 4; ++e) { float x = fmaf(s[kt][4 * g + e], sc, addc) + cv[e]; if (diag && (mb + 8 * g + e > 0)) x = -1e30f; s[kt][4 * g + e] = x; } }
                } else if (MODE == 2) {
                    if (near) {
                        const LAS float* lut = (const LAS float*)(lds + A_LUT) + (t * 64 + 32 * kt + 4 * h - (qw0 + r) + 191);
#pragma unroll
                        for (int i = 0; i < 16; ++i) s[kt][i] = fmaf(s[kt][i], sc, lut[8 * (i >> 2) + (i & 3)]);
                    } else {
#pragma unroll
                        for (int i = 0; i < 16; ++i) s[kt][i] = fmaf(s[kt][i], sc, addc);
                    }
                } else {
#pragma unroll
                    for (int i = 0; i < 16; ++i) s[kt][i] = fmaf(s[kt][i], sc, addc);
                }
                float ls = 0.f;
#pragma unroll
                for (int i = 0; i < 16; ++i) { const float pv = fast_exp2(s[kt][i]); s[kt][i] = pv; ls += pv; }
                l += ls;
#pragma unroll
                for (int ss = 0; ss < 2; ++ss) { u32x4 w;
                    w.x = pk2(s[kt][8 * ss + 0], s[kt][8 * ss + 1]); w.y = pk2(s[kt][8 * ss + 2], s[kt][8 * ss + 3]);
                    w.z = pk2(s[kt][8 * ss + 4], s[kt][8 * ss + 5]); w.w = pk2(s[kt][8 * ss + 6], s[kt][8 * ss + 7]);
                    pf[ss] = __builtin_bit_cast(bf16x8, w); }
#pragma unroll
                for (int jj = 0; jj < 8; ++jj) { const int j = 8 * kt + jj;
                    o[jj & 3] = MFMA32(vf[j % VD], pf[jj >> 2], o[jj & 3]);
                    if (j + VD < 16) AT_VLD(j + VD); }
            }
#undef AT_VLD
        }
        asm volatile("s_waitcnt vmcnt(0)" ::: "memory");
        __syncthreads();
    }
#undef AT_DMA
#undef AT_DMA1
    l += __shfl_xor(l, 32);
    const float inv = 1.f / l;
    const size_t qrow = (size_t)(qw0 + r);
    u32x2 gwv[16];
#pragma unroll
    for (int k = 0; k < 16; ++k) gwv[k] = *(const u32x2*)(a.G + qrow * a.ldg + 32 * (k >> 2) + 8 * (k & 3) + 4 * h);
    if (MODE != 2) {
#pragma unroll
        for (int dt = 0; dt < 4; ++dt)
#pragma unroll
            for (int g = 0; g < 4; ++g) { const int d = 32 * dt + 8 * g + 4 * h;
                const u32x2 gw = gwv[dt * 4 + g];
                const float v0 = o[dt][4 * g + 0] * inv * silu_f(bflo(gw.x)), v1 = o[dt][4 * g + 1] * inv * silu_f(bfhi(gw.x));
                const float v2 = o[dt][4 * g + 2] * inv * silu_f(bflo(gw.y)), v3 = o[dt][4 * g + 3] * inv * silu_f(bfhi(gw.y));
                u32x2 w; w.x = pk2(v0, v1); w.y = pk2(v2, v3);
                *(u32x2*)(a.O + qrow * a.ldo + d) = w; }
    } else {
        LAS float* xb = (LAS float*)(lds + (wave & 3) * 16384);
        if (map == 1) {
            const float f = inv * a.lam;
#pragma unroll
            for (int dt = 0; dt < 4; ++dt)
#pragma unroll
                for (int i = 0; i < 16; ++i) xb[(dt * 16 + i) * 64 + lane] = o[dt][i] * f;
        }
        __syncthreads();
        if (map == 0) {
            float ssq = 0.f;
#pragma unroll
            for (int dt = 0; dt < 4; ++dt)
#pragma unroll
                for (int i = 0; i < 16; ++i) { const float v = o[dt][i] * inv - xb[(dt * 16 + i) * 64 + lane]; o[dt][i] = v; ssq += v * v; }
            ssq += __shfl_xor(ssq, 32);
            const float rn = rsqrtf(ssq * (1.f / 128.f) + EPS) * a.outmul;
#pragma unroll
            for (int dt = 0; dt < 4; ++dt)
#pragma unroll
                for (int g = 0; g < 4; ++g) { const int d = 32 * dt + 8 * g + 4 * h;
                    const u32x2 gw = gwv[dt * 4 + g];
                    const f32x4 sg = *(const f32x4*)(a.subg + d);
                    const float v0 = o[dt][4 * g + 0] * rn * sg[0] * silu_f(bflo(gw.x)), v1 = o[dt][4 * g + 1] * rn * sg[1] * silu_f(bfhi(gw.x));
                    const float v2 = o[dt][4 * g + 2] * rn * sg[2] * silu_f(bflo(gw.y)), v3 = o[dt][4 * g + 3] * rn * sg[3] * silu_f(bfhi(gw.y));
                    u32x2 w; w.x = pk2(v0, v1); w.y = pk2(v2, v3);
                    *(u32x2*)(a.O + qrow * a.ldo + d) = w; }
        }
    }
}
__device__ __forceinline__ void tr_item(const float* W, int N, bf16_t* WT, int item, int lane, LAS float* scr, int fox, const float* gk) {
    const int nblk = (N + 31) >> 5, kb = item / nblk, nb = item - kb * nblk, k0 = 64 * kb, n0 = 32 * nb;
    const int nq = lane & 7, kr = lane >> 3, nc = n0 + 4 * nq;
    f32x4 wv[8];
#pragma unroll
    for (int i = 0; i < 8; ++i) wv[i] = (nc < N) ? *(const f32x4*)(W + (size_t)(k0 + kr + 8 * i) * N + nc) : (f32x4){0.f, 0.f, 0.f, 0.f};
#pragma unroll
    for (int i = 0; i < 8; ++i) { const int kk = kr + 8 * i; const float gg = gk ? gk[k0 + kk] : 1.f;
#pragma unroll
        for (int e2 = 0; e2 < 4; ++e2) scr[kk * 33 + 4 * nq + e2] = wv[i][e2] * gg; }
    asm volatile("s_waitcnt lgkmcnt(0)" ::: "memory");
    const int c = lane & 7;
#pragma unroll
    for (int j = 0; j < 4; ++j) { const int nl = (lane >> 3) + 8 * j, n = n0 + nl; const LAS float* s = scr + (8 * c) * 33 + nl;
        if (n < N) { int nd = n; if (fox) { if (n >= 4620) nd = n - 12; else if (n >= 4608) nd = n - 4608 + 7168; }
            u32x4 o; o.x = pk2(s[0 * 33], s[1 * 33]); o.y = pk2(s[2 * 33], s[3 * 33]); o.z = pk2(s[4 * 33], s[5 * 33]); o.w = pk2(s[6 * 33], s[7 * 33]);
            *(u32x4*)(WT + (size_t)nd * DM + k0 + 8 * c) = o; } }
    asm volatile("s_waitcnt lgkmcnt(0)" ::: "memory");
}
__device__ __forceinline__ void rms_row_to_bf16(const float* xrow, const float* g, bf16_t* orow, int lane) {
    const f32x4* xr = (const f32x4*)xrow + lane; const f32x4* gr = (const f32x4*)g + lane;
    f32x4 v[8]; float s = 0.f;
#pragma unroll
    for (int j = 0; j < 8; ++j) { v[j] = xr[64 * j]; s += (v[j][0] * v[j][0] + v[j][1] * v[j][1]) + (v[j][2] * v[j][2] + v[j][3] * v[j][3]); }
    const float rstd = rsqrtf(wave_sum(s) * (1.f / DM) + EPS);
    u32x2* o8 = (u32x2*)orow + lane;
#pragma unroll
    for (int j = 0; j < 8; ++j) { const f32x4 gg = gr[64 * j]; u32x2 w; w.x = pk2(v[j][0] * rstd * gg[0], v[j][1] * rstd * gg[1]); w.y = pk2(v[j][2] * rstd * gg[2], v[j][3] * rstd * gg[3]); o8[64 * j] = w; }
}
__device__ __forceinline__ void row_to_bf16_ssq(const float* xrow, bf16_t* orow, float* ssq, int lane) {
    const f32x4* xr = (const f32x4*)xrow + lane; u32x2* o8 = (u32x2*)orow + lane; float s = 0.f;
#pragma unroll
    for (int j = 0; j < 8; ++j) { const f32x4 v = xr[64 * j]; s += (v[0] * v[0] + v[1] * v[1]) + (v[2] * v[2] + v[3] * v[3]);
        u32x2 w; w.x = pk2(v[0], v[1]); w.y = pk2(v[2], v[3]); o8[64 * j] = w; }
    s = wave_sum(s);
    if (lane == 0) *ssq = s;
}
template <int W>
__device__ __forceinline__ void seg_norm512(bf16_t* p, const float* g, int lane) {
    u32x4 w = *(const u32x4*)(p + 8 * lane);
    float f[8] = {bflo(w.x), bfhi(w.x), bflo(w.y), bfhi(w.y), bflo(w.z), bfhi(w.z), bflo(w.w), bfhi(w.w)};
    float s = 0.f;
#pragma unroll
    for (int j = 0; j < 8; ++j) s += f[j] * f[j];
#pragma unroll
    for (int o = 1; o < W / 8; o <<= 1) s += __shfl_xor(s, o);
    const float rstd = rsqrtf(s * (1.f / W) + EPS);
    const float* gp = g + ((8 * lane) & (W - 1));
    const f32x4 g0 = *(const f32x4*)gp, g1 = *(const f32x4*)(gp + 4);
    w.x = pk2(f[0] * rstd * g0[0], f[1] * rstd * g0[1]); w.y = pk2(f[2] * rstd * g0[2], f[3] * rstd * g0[3]);
    w.z = pk2(f[4] * rstd * g1[0], f[5] * rstd * g1[1]); w.w = pk2(f[6] * rstd * g1[2], f[7] * rstd * g1[3]);
    *(u32x4*)(p + 8 * lane) = w;
}

__device__ __forceinline__ void gmlp_item(LAS unsigned char* lds, const bf16_t* Zt  , bf16_t* BRt  , const bf16_t* wsb, const float* bs_, const float* lng, const float* lnb, const int tid) {
    const int wave = __builtin_amdgcn_readfirstlane(tid >> 6), lane = tid & 63, r = lane & 31, h = lane >> 5;
    LAS float* st = (LAS float*)(lds + 131072);
    __syncthreads();
    for (int tq = 0; tq < 4; ++tq) {
        u32x4 w[4][3];
#pragma unroll
        for (int u = 0; u < 4; ++u)
#pragma unroll
            for (int c = 0; c < 3; ++c) w[u][c] = *(const u32x4*)(Zt + (size_t)(16 * wave + 4 * tq + u) * NZ0 + 1536 + 8 * (lane + 64 * c));
#pragma unroll
        for (int u = 0; u < 4; ++u) { float s = 0.f, s2 = 0.f;
#pragma unroll
            for (int c = 0; c < 3; ++c) { const float f[8] = {bflo(w[u][c].x), bfhi(w[u][c].x), bflo(w[u][c].y), bfhi(w[u][c].y), bflo(w[u][c].z), bfhi(w[u][c].z), bflo(w[u][c].w), bfhi(w[u][c].w)};
#pragma unroll
                for (int j = 0; j < 8; ++j) { s += f[j]; s2 += f[j] * f[j]; } }
            s = wave_sum(s); s2 = wave_sum(s2);
            const float mean = s * (1.f / 1536.f), var = fmaxf(s2 * (1.f / 1536.f) - mean * mean, 0.f);
            const int tok = 16 * wave + 4 * tq + u;
            if (lane == 0) { st[2 * tok] = mean; st[2 * tok + 1] = rsqrtf(var + EPS); } } }
    __syncthreads();
    const int tt = wave & 3, cp = wave >> 2;
    const unsigned q = (lane & 15) >> 2, p = lane & 3, blk = (lane >> 4) & 1;
    unsigned aaddr[8], baddr[2][2];
#pragma unroll
    for (int ks = 0; ks < 8; ++ks) aaddr[ks] = tt * 8192 + off_b(r, 2 * ks + h);
#pragma unroll
    for (int cc = 0; cc < 2; ++cc)
#pragma unroll
        for (int t2 = 0; t2 < 2; ++t2) baddr[cc][t2] = 32768u + off_b(8 * h + 4 * t2 + q, 4 * (2 * cp + cc) + 2 * blk + (p >> 1)) + 8u * (p & 1);
    u32x4 wb[4], vw[4], uu[4], gg4[4];
#define GM_LOAD(gq) do { const bf16_t* Wq = wsb + (size_t)(gq) * 16384; const int ch_ = tid & 15, t0_ = tid >> 4; _Pragma("unroll") for (int i = 0; i < 4; ++i) { const int t = t0_ + 32 * i; \
        wb[i] = *(const u32x4*)(Wq + t * 128 + 8 * ch_); \
        vw[i] = *(const u32x4*)(Zt + (size_t)t * NZ0 + 1536 + (gq) * 128 + 8 * ch_); \
        uu[i] = *(const u32x4*)(Zt + (size_t)t * NZ0 + (gq) * 128 + 8 * ch_); gg4[i] = *(const u32x4*)(Zt + (size_t)t * NZ0 + 3584 + (gq) * 128 + 8 * ch_); } } while (0)
    for (int g = 0; g < 12; ++g) {
        GM_LOAD(g);
        { const int ch = tid & 15, t0 = tid >> 4;
          if (g > 0) {
#pragma unroll
              for (int i = 0; i < 4; ++i) { const int t = t0 + 32 * i; const u32x4 ov = *(const LAS u32x4*)(lds + 65536 + off_b(t, ch)); *(u32x4*)(BRt + (size_t)t * DM + (g - 1) * 128 + 8 * ch) = ov; } }
          const float* gp = lng + g * 128 + 8 * ch; const float* bp = lnb + g * 128 + 8 * ch;
          const f32x4 g0 = *(const f32x4*)gp, g1 = *(const f32x4*)(gp + 4), b0 = *(const f32x4*)bp, b1 = *(const f32x4*)(bp + 4);
#pragma unroll
          for (int i = 0; i < 4; ++i) { const int t = t0 + 32 * i;
              *(LAS u32x4*)(lds + off_b(t, ch)) = wb[i];
              const float mean = st[2 * t], rstd = st[2 * t + 1];
              u32x4 o;
              o.x = pk2((bflo(vw[i].x) - mean) * rstd * g0[0] + b0[0], (bfhi(vw[i].x) - mean) * rstd * g0[1] + b0[1]);
              o.y = pk2((bflo(vw[i].y) - mean) * rstd * g0[2] + b0[2], (bfhi(vw[i].y) - mean) * rstd * g0[3] + b0[3]);
              o.z = pk2((bflo(vw[i].z) - mean) * rstd * g1[0] + b1[0], (bfhi(vw[i].z) - mean) * rstd * g1[1] + b1[1]);
              o.w = pk2((bflo(vw[i].w) - mean) * rstd * g1[2] + b1[2], (bfhi(vw[i].w) - mean) * rstd * g1[3] + b1[3]);
              *(LAS u32x4*)(lds + 32768 + off_b(t, ch)) = o;
              *(LAS u32x4*)(lds + 65536 + off_b(t, ch)) = uu[i]; *(LAS u32x4*)(lds + 98304 + off_b(t, ch)) = gg4[i]; } }
        __syncthreads();
        f32x16 acc[2];
#pragma unroll
        for (int i = 0; i < 16; ++i) { acc[0][i] = 0.f; acc[1][i] = 0.f; }
#pragma unroll
        for (int ks = 0; ks < 8; ++ks) {
            const bf16x8 af = *(LAS bf16x8*)(lds + aaddr[ks]);
#pragma unroll
            for (int cc = 0; cc < 2; ++cc) {
                const s16x4 lo = __builtin_amdgcn_ds_read_tr16_b64_v4i16((LAS s16x4*)(lds + baddr[cc][0] + ks * 4096));
                const s16x4 hi = __builtin_amdgcn_ds_read_tr16_b64_v4i16((LAS s16x4*)(lds + baddr[cc][1] + ks * 4096));
                const bf16x8 bfv = __builtin_shufflevector(lo, hi, 0, 1, 2, 3, 4, 5, 6, 7);
                acc[cc] = MFMA32(bfv, af, acc[cc]); }
        }
        int r2 = r, h2 = h; asm volatile("" : "+v"(r2), "+v"(h2));
        { const int t = 32 * tt + r2; const float bsv = bs_[g * 128 + t];
#pragma unroll
          for (int k8 = 0; k8 < 8; ++k8) { const int cc = k8 >> 2, q4 = k8 & 3;
              const unsigned ad = off_b(t, 4 * (2 * cp + cc) + q4) + 8u * h2;
              const u32x2 uw = *(const LAS u32x2*)(lds + 65536 + ad), gw = *(const LAS u32x2*)(lds + 98304 + ad);
              const float v0 = bflo(uw.x) * (acc[cc][4 * q4 + 0] + bsv) * silu_f(bflo(gw.x)), v1 = bfhi(uw.x) * (acc[cc][4 * q4 + 1] + bsv) * silu_f(bfhi(gw.x));
              const float v2 = bflo(uw.y) * (acc[cc][4 * q4 + 2] + bsv) * silu_f(bflo(gw.y)), v3 = bfhi(uw.y) * (acc[cc][4 * q4 + 3] + bsv) * silu_f(bfhi(gw.y));
              u32x2 w; w.x = pk2(v0, v1); w.y = pk2(v2, v3);
              *(LAS u32x2*)(lds + 65536 + ad) = w; } }
        __syncthreads();
    }
    { const int ch = tid & 15, t0 = tid >> 4;
#pragma unroll
      for (int i = 0; i < 4; ++i) { const int t = t0 + 32 * i; const u32x4 ov = *(const LAS u32x4*)(lds + 65536 + off_b(t, ch)); *(u32x4*)(BRt + (size_t)t * DM + 11 * 128 + 8 * ch) = ov; } }
}
#undef GM_LOAD
constexpr int NPHASE = 1 + 3 * NLAYER;
#ifndef MK_PER_PHASE
#define MK_PER_PHASE 0
#endif

__device__ __forceinline__ void grid_bar(unsigned* base, unsigned k  , int tid) {
    __syncthreads();
    if (tid == 0) {
        __builtin_amdgcn_fence(__ATOMIC_RELEASE, "agent");
        const unsigned G = gridDim.x, x = blockIdx.x & 7u, gsize = (G - x + 7u) >> 3, ngroups = G < 8u ? G : 8u;
        const unsigned prev = __hip_atomic_fetch_add(base + 64 * (1 + x), 1u, __ATOMIC_RELAXED, __HIP_MEMORY_SCOPE_AGENT);
        if (prev + 1u == k * gsize) __hip_atomic_fetch_add(base, 1u, __ATOMIC_RELAXED, __HIP_MEMORY_SCOPE_AGENT);
        while (__hip_atomic_load(base, __ATOMIC_RELAXED, __HIP_MEMORY_SCOPE_AGENT) < k * ngroups) __builtin_amdgcn_s_sleep(1);
        __builtin_amdgcn_fence(__ATOMIC_ACQUIRE, "agent");
    }
    __syncthreads();
}

__global__ void __launch_bounds__(512) mk_fwd(Params P) {
    extern __shared__ __attribute__((aligned(16))) unsigned char shm[];
    LAS unsigned char* lds = (LAS unsigned char*)shm;
    cg::grid_group grid = cg::this_grid();
    const int G = gridDim.x, NGW = G * 8;
    int redo = 0; (void)redo;
    for (int ph = P.ph_lo; ph < P.ph_hi; ++ph) {
        int tid = threadIdx.x; asm volatile("" : "+v"(tid));
        const int wave = __builtin_amdgcn_readfirstlane(tid >> 6), lane = tid & 63, gw = blockIdx.x * 8 + wave;
        unsigned char* ws = P.ws; asm volatile("" : "+s"(ws));
        bf16_t* const WOUT = (bf16_t*)(ws + WS_WOUT); bf16_t* const WKV = (bf16_t*)(ws + WS_WKV); bf16_t* const MEMN = (bf16_t*)(ws + WS_MEMN);
        bf16_t* const KVM = (bf16_t*)(ws + WS_KVM); float* const LS = (float*)(ws + WS_LS); float* const SSQ = (float*)(ws + WS_SSQ);
        bf16_t* const HB = (bf16_t*)(ws + WS_HB); bf16_t* const BR = (bf16_t*)(ws + WS_BR); bf16_t* const Z = (bf16_t*)(ws + WS_Z);

        if (ph == 0) {
            LAS float* scr = (LAS float*)(lds + wave * 16384);
            constexpr int I0 = 32 * 176, I1 = 32 * 225, I2 = 32 * 224, IO = 32 * 64, IK = 32 * 32;
            constexpr int NIT = 2 * I0 + I1 + I2 + 4 * IO + 4 * IK;
            for (int it = gw; it < NIT; it += NGW) {
                int r = it;
                if (r < I0) { tr_item(P.a_w_in, NZ0, (bf16_t*)(ws + WS_WIN0), r, lane, scr, 0, P.norm_g); continue; } r -= I0;
                if (r < I1) { tr_item(P.b_w_in, NSRC1, (bf16_t*)(ws + WS_WIN1), r, lane, scr, 1, P.norm_g + DM); continue; } r -= I1;
                if (r < I2) { tr_item(P.c_w_in, NZ2, (bf16_t*)(ws + WS_WIN2), r, lane, scr, 0, P.norm_g + 2 * DM); continue; } r -= I2;
                if (r < I0) { tr_item(P.a_w_in + (size_t)DM * NZ0, NZ0, (bf16_t*)(ws + WS_WIN3), r, lane, scr, 0, P.norm_g + 3 * DM); continue; } r -= I0;
                if (r < 4 * IO) { const int L = r / IO; tr_item(P.w_out + (size_t)L * DM * DM, DM, WOUT + (size_t)L * DM * DM, r - L * IO, lane, scr, 0, nullptr); continue; } r -= 4 * IO;
                { const int L = r / IK; tr_item(P.w_mem_kv + (size_t)L * DM * 1024, 1024, WKV + (size_t)L * 1024 * DM, r - L * IK, lane, scr, 0, nullptr); }
            }
            { u32x4* zp = (u32x4*)((bf16_t*)(ws + WS_WIN1) + (size_t)NSRC1 * DM); const int nz = (NZ1 - NSRC1) * DM / 8;
              for (int i = blockIdx.x * 512 + tid; i < nz; i += G * 512) zp[i] = (u32x4){0u, 0u, 0u, 0u}; }
            { bf16_t* wsb = (bf16_t*)(ws + WS_GT + 65536);
              for (int i = blockIdx.x * 512 + tid; i < 2 * 12 * 2048; i += G * 512) { const int hd = i >> 11, rem = i & 2047, t = rem >> 4, ch = rem & 15;
                  const float* src = P.a_w_s + (size_t)hd * 16384 + t * 128 + 8 * ch;
                  f32x4 a0 = *(const f32x4*)src, a1 = *(const f32x4*)(src + 4);
                  if (t < 64 && ch >= 8) { a0 = (f32x4){0.f, 0.f, 0.f, 0.f}; a1 = a0; }
                  u32x4 w; w.x = pk2(a0[0], a0[1]); w.y = pk2(a0[2], a0[3]); w.z = pk2(a1[0], a1[1]); w.w = pk2(a1[2], a1[3]);
                  *(u32x4*)(wsb + (size_t)hd * 16384 + t * 128 + 8 * ch) = w; } }
            for (int m = gw; m < NB * NMEM; m += NGW) rms_row_to_bf16(P.mem + (size_t)m * DM, P.mem_norm_g, MEMN + (size_t)m * DM, lane);
            for (int m = gw; m < NTOK; m += NGW) row_to_bf16_ssq(P.x + (size_t)m * DM, HB + (size_t)m * DM, SSQ + m, lane);
            for (int i = blockIdx.x * 512 + tid; i < 3 * NTOK; i += G * 512) SSQ[NTOK + i] = 0.f;
            if (blockIdx.x == 0) { float* gt = (float*)(ws + WS_GT);
                if (tid < 9) { ((unsigned*)(ws + WS_GT))[4096 + 64 * tid] = 0u; ((unsigned*)(ws + WS_GT))[8192 + 64 * tid] = 0u; }
                for (int i = tid; i < 2064; i += 512) { float v = 0.f;
                    if (i < 1536) { const int Lq = i / 384, w = (i % 384) / 128, d = i & 127, kd = Lq % 3;
                        if (w == 2) v = P.mem_q_norm_g[Lq * 128 + d];
                        else if (kd == 1) v = (w == 0 ? P.b_q_norm_g : P.b_k_norm_g)[d];
                        else if (kd == 2) v = (w == 0 ? P.c_q_norm_g : P.c_k_norm_g)[d & 63];
                    } else if (i < 2048) v = P.mem_k_norm_g[i - 1536];
                    else if (i < 2060) v = P.b_b_f[i - 2048];
                    gt[i] = v; }
                if (tid < 19) {
                    float v = 0.f;
                    if (tid < 16) { const int Lq = tid >> 2, w = tid & 3, kd = Lq % 3;
                        if (w == 2) { for (int i = 0; i < 128; ++i) v = fmaxf(v, fabsf(P.mem_q_norm_g[Lq * 128 + i])); }
                        else if (w == 3) { for (int i = 0; i < 128; ++i) v = fmaxf(v, fabsf(P.mem_k_norm_g[Lq * 128 + i])); }
                        else if (kd == 1) { const float* gsrc = (w == 0) ? P.b_q_norm_g : P.b_k_norm_g; for (int i = 0; i < 128; ++i) v = fmaxf(v, fabsf(gsrc[i])); }
                        else if (kd == 2) { const float* gsrc = (w == 0) ? P.c_q_norm_g : P.c_k_norm_g; for (int i = 0; i < 64; ++i) v = fmaxf(v, fabsf(gsrc[i])); }
                    } else if (tid == 16) { for (int i = 0; i < 384; ++i) v = fmaxf(v, P.rel_bias[i]); }
                    else if (tid == 17) { for (int i = 0; i < 64; ++i) v += P.c_lam[i] * P.c_lam[64 + i]; }
                    else { for (int i = 0; i < 64; ++i) v += P.c_lam[128 + i] * P.c_lam[192 + i]; }
                    gt[2080 + tid] = v; } }
        } else {
            const int L = (ph - 1) / 3, sub = (ph - 1) % 3, kind = L % 3;
            const int NZ = (kind == 0) ? NZ0 : (kind == 1 ? NZ1 : NZ2);
            const int memq_off = (kind == 0) ? 3072 : 4608;
            if (sub == 0) {
                for (int jb = (L == 0 ? 0 : 1); jb < 2; ++jb) {
                    pg8::Gemm g; EpiZ E;
                    LAS float* part = (LAS float*)(lds + LDS_PART);
                    if (jb == 0) { g = pg8::Gemm{MEMN, WKV, NB * NMEM, 4096, DM}; E = EpiZ{ws, part, 4096, 3, 0}; }
                    else { bf16_t* wt = (bf16_t*)(ws + (L == 0 ? WS_WIN0 : L == 1 ? WS_WIN1 : L == 2 ? WS_WIN2 : WS_WIN3));
                           g = pg8::Gemm{HB, wt, NTOK, NZ, DM}; E = EpiZ{ws, part, NZ, kind, L}; }
                    pg8::StaticOrder S; S.init(g.M, g.N, G, (int)blockIdx.x);
                    pg8::gemm_phase<EpiZ, pg8::StaticOrder, true, true>(lds, g, S, E, tid);
                }
            } else if (sub == 1) {
                const int gate_off = memq_off + 512;
                const float* gx = (const float*)(ws + WS_GT) + 2080;
                const float gqm = gx[4 * L], gkm = gx[4 * L + 1], gmq = gx[4 * L + 2], gmk = gx[4 * L + 3];
                const float m2_mem = 11.3137085f * gmq * gmk * 1.01f * LOG2E;
                if (kind == 0) {
                    const int j = L / 3;
#ifdef REP_GM
                    for (int rep_ = 0; rep_ < 2; ++rep_)
#endif
                    for (int it = blockIdx.x; it < NTOK / 128; it += G)
                        gmlp_item(lds, Z + (size_t)it * 128 * NZ0, BR + (size_t)it * 128 * DM, (const bf16_t*)(ws + WS_GT + 65536) + (size_t)j * 12 * 16384, P.a_b_s + j * 1536, P.a_ln_g + j * 1536, P.a_ln_b + j * 1536, tid);
                } else if (kind == 1) {
                    for (int it = blockIdx.x; it < 1536; it += G) {
                        const int c = it & 255, rr = it >> 8, bh = rr * 16 + (c & 7) * 2 + (c >> 7); int j = (c >> 3) & 15; if (rr & 1) j = 15 - j;
                        const int b = bh / 12, hh = bh - b * 12;
                        const bf16_t* Zb = Z + (size_t)b * SEQ * NZ1;
                        AttnArgs a; a.Q = Zb + hh * 128; a.K = Zb + 1536 + hh * 128; a.V = Zb + 3072 + hh * 128; a.G = Zb + gate_off + hh * 128; a.O = BR + (size_t)b * SEQ * DM + hh * 128;
                        a.ldq = NZ1; a.ldkv = NZ1; a.ldg = NZ1; a.ldo = DM; a.q0 = 256 * j; a.ntiles = 4 * j + 4; a.c = LS + (size_t)b * SEQ * 16 + hh; a.lutsrc = nullptr; a.subg = nullptr;
                        a.sc = 0.08838834764831845f * LOG2E; a.lam = 0.f; a.outmul = 1.f; a.m2 = 11.3137085f * gqm * gkm * 1.01f * LOG2E;
                        attn_item<1>(lds, a, tid);
                    }
                } else {
                    const float d01 = gx[17], d23 = gx[18];
                    const float lam_init = 0.8f - 0.6f * expf(-0.3f * (float)L);
                    const float lam_val = expf(d01) - expf(d23) + lam_init;
                    const float bmax = gx[16];
                    const float m2_diff = (8.f * gqm * gkm * 1.01f + bmax) * LOG2E;
                    for (int it = blockIdx.x; it < 3072; it += G) {
                        const int c = it & 255, rr = it >> 8, bh = rr * 8 + (c & 7); int j = c >> 3; if (rr & 1) j = 31 - j;
                        const int b = bh / 12, hh = bh - b * 12;
                        const bf16_t* Zb = Z + (size_t)b * SEQ * NZ2;
                        AttnArgs a; a.Q = Zb + hh * 128; a.K = Zb + 1536 + hh * 128; a.V = Zb + 3072 + hh * 128; a.G = Zb + gate_off + hh * 128; a.O = BR + (size_t)b * SEQ * DM + hh * 128;
                        a.ldq = NZ2; a.ldkv = NZ2; a.ldg = NZ2; a.ldo = DM; a.q0 = 128 * j; a.ntiles = 2 * j + 2; a.c = nullptr; a.lutsrc = P.rel_bias + hh; a.subg = P.c_subln_g;
                        a.sc = 0.125f * LOG2E; a.lam = lam_val; a.outmul = 1.f - lam_init; a.m2 = m2_diff;
                        attn_item<2>(lds, a, tid);
                    }
                }
#ifdef REP_MEM
                for (int rep_ = 0; rep_ < 2; ++rep_)
#endif
                for (int it = blockIdx.x; it < 512; it += G) {
                    const int qb = it & 15, hm = (it >> 4) & 3, b = it >> 6;
                    const bf16_t* Zb = Z + (size_t)b * SEQ * NZ;
                    AttnArgs a; a.Q = Zb + memq_off + hm * 128; a.K = KVM + (size_t)b * NMEM * 4096 + L * 1024 + hm * 128; a.V = a.K + 512; a.G = Zb + gate_off + 1536 + hm * 128;
                    a.O = BR + (size_t)b * SEQ * DM + 1536 + hm * 128;
                    a.ldq = NZ; a.ldkv = 4096; a.ldg = NZ; a.ldo = DM; a.q0 = 256 * qb; a.ntiles = 4; a.c = nullptr; a.lutsrc = nullptr; a.subg = nullptr;
                    a.sc = 0.08838834764831845f * LOG2E; a.lam = 0.f; a.outmul = 1.f; a.m2 = m2_mem;
                    attn_item<0>(lds, a, tid);
                }
                __syncthreads();
            } else {
                pg8::Gemm g{BR, WOUT + (size_t)L * DM * DM, NTOK, DM, DM};
                EpiOut E{L == 0 ? P.x : P.out, P.out, HB, (L + 1 < NLAYER) ? SSQ + (size_t)(L + 1) * NTOK : nullptr};
#ifdef REP_OUT0
                if (redo) E.ssq = nullptr;
#endif
                pg8::StaticOrder S; S.init(g.M, g.N, G, (int)blockIdx.x);
                pg8::gemm_phase<EpiOut, pg8::StaticOrder, true, true>(lds, g, S, E, tid);
            }
        }
#ifdef REP_P0
        if (ph == 0 && !redo) { redo = 1; __syncthreads(); --ph; continue; }
        redo = 0;
#endif
#ifdef REP_OUT0
        if (ph == 3 && !redo) { redo = 1; __syncthreads(); --ph; continue; }
        redo = 0;
#endif
#ifdef REP_SUB
        if (ph > 0 && (ph - 1) % 3 == REP_SUB && ((REP_L >> ((ph - 1) / 3)) & 1) && !redo) { redo = 1; __syncthreads(); --ph; continue; }
        redo = 0;
#endif
        if (ph + 1 < P.ph_hi) { if (ph == 0) grid.sync(); else grid_bar((unsigned*)(ws + WS_GT) + 4096, (unsigned)ph, tid); }
#ifdef REP_SYNC
        if (ph == 0) for (int i_ = 0; i_ < 10; ++i_) grid.sync();
#endif
#ifdef REP_BAR
        if (ph == 0) { for (int i_ = 0; i_ < 10; ++i_) grid_bar((unsigned*)(ws + WS_GT) + 8192, (unsigned)(i_ + 1), tid); }
#endif
    }
}

extern "C" void kernel_launch(void* const* d_in, const int* in_sizes, int n_in, void* d_out, int out_size, void* d_ws, size_t ws_size, hipStream_t stream) {
    static int grid = 0;
    if (grid == 0) {
        if (n_in != 23 || ws_size < WS_END) { fprintf(stderr, "kernel_launch: unexpected inputs (n_in %d, ws %zu)\n", n_in, ws_size); grid = -1; return; }
        int dev = 0, cus = 0, per_cu = 0;
        hipGetDevice(&dev); hipDeviceGetAttribute(&cus, hipDeviceAttributeMultiprocessorCount, dev);
        if (hipFuncSetAttribute((const void*)mk_fwd, hipFuncAttributeMaxDynamicSharedMemorySize, LDS_BYTES) != hipSuccess) fprintf(stderr, "kernel_launch: hipFuncSetAttribute failed\n");
        if (hipOccupancyMaxActiveBlocksPerMultiprocessor(&per_cu, (const void*)mk_fwd, 512, LDS_BYTES) != hipSuccess || per_cu < 1) { fprintf(stderr, "kernel_launch: occupancy query says %d\n", per_cu); per_cu = 1; }
        (void)hipGetLastError();
        grid = cus * per_cu;
        fprintf(stderr, "kernel_launch: grid %d (cus %d x %d)\n", grid, cus, per_cu);
    }
    if (grid < 0) return;
    Params p{};
    const float** pp = (const float**)&p;
    for (int i = 0; i < 23; ++i) pp[i] = (const float*)d_in[i];
    p.out = (float*)d_out; p.ws = (unsigned char*)d_ws;
#if MK_PER_PHASE
    for (int ph = 0; ph < NPHASE; ++ph) { p.ph_lo = ph; p.ph_hi = ph + 1; hipLaunchKernelGGL(mk_fwd, dim3(grid), dim3(512), LDS_BYTES, stream, p); }
#else
    p.ph_lo = 0; p.ph_hi = NPHASE;
    void* args[] = {&p};
    hipError_t e = hipLaunchCooperativeKernel((void*)mk_fwd, dim3(grid), dim3(512), args, LDS_BYTES, stream);
    if (e != hipSuccess) fprintf(stderr, "cooperative launch failed: %s (grid %d)\n", hipGetErrorString(e), grid);
#endif
}
```

```cpp
#include <hip/hip_runtime.h>
#include <hip/hip_cooperative_groups.h>
#include <cstdio>
#include <cstdint>
namespace cg = cooperative_groups;
namespace pg8 {
#define PG8_LAS __attribute__((address_space(3)))
typedef unsigned short bf16_t;
typedef short bf16x8 __attribute__((ext_vector_type(8)));
typedef float f32x4 __attribute__((ext_vector_type(4)));
typedef unsigned u32x4 __attribute__((ext_vector_type(4)));
constexpr int BM = 256, BK = 64, HALF = 128, HTB = HALF * BK * 2  , STAGE_BYTES = 8 * HTB, NXCD = 8, WGM = 8;

__host__ __device__ __forceinline__ int lds_byte(int r, int c) { const int st = (r >> 4) * 2 + (c >> 5), rr = r & 15, cc = c & 31, ob = rr * 64 + cc * 2; return st * 1024 + (ob ^ (((ob >> 9) & 1) << 5)); }
__host__ __device__ __forceinline__ void stage_rc(int b, int& R, int& C) { const int st = b / 1024, sb = b % 1024, swz = sb ^ (((sb >> 9) & 1) << 5); R = (st >> 1) * 16 + swz / 64; C = (st & 1) * 32 + (swz % 64) / 2; }
__host__ __device__ __forceinline__ int perm32(int rho) { const int n = rho >> 4, i = rho & 15; return 8 * (i >> 2) + 4 * n + (i & 3); }

struct Unit { int pm, pn; };
struct Gemm { const bf16_t* A; const bf16_t* Bt; int M, N, K; };

struct StaticOrder {
    int nM, nN, nwg, G, c;
    __host__ __device__ void init(int M, int N, int G_, int c_) { nM = M / BM; nN = N / BM; nwg = nM * nN; G = G_; c = c_; }
    __host__ __device__ bool next(int i, Unit& u) const {
        const long L = (long)i * G + c; if (L >= nwg) return false;
        int wgid = (int)L; { const int q = nwg / NXCD, r = nwg % NXCD, xcd = wgid % NXCD, off = wgid / NXCD; wgid = (xcd < r ? xcd * (q + 1) : r * (q + 1) + (xcd - r) * q) + off; }
        const int nig = WGM * nN, gid = wgid / nig, fm = gid * WGM, gsz = (nM - fm) < WGM ? (nM - fm) : WGM;
        u.pm = fm + ((wgid % nig) % gsz); u.pn = (wgid % nig) / gsz; return true;
    }
    __device__ __forceinline__ void a_ready(const Unit&) const {}
    __device__ __forceinline__ void done(const Unit&) const {}
};
__device__ __forceinline__ unsigned cvt_pk_bf16(float lo, float hi) { unsigned r; asm volatile("v_cvt_pk_bf16_f32 %0, %1, %2" : "=v"(r) : "v"(lo), "v"(hi)); return r; }
template <class Epi, class Sched, bool ALIGN_EPI = false, bool SP2 = false>
__device__ __forceinline__ void gemm_phase(PG8_LAS unsigned char* lds, const Gemm g, const Sched& S, const Epi& E, const int tid) {
    const int wid = __builtin_amdgcn_readfirstlane(tid >> 6), lane = tid & 63, wr = wid >> 2, wc = wid & 3, fr = lane & 15, fq = lane >> 4;
    const int K = g.K, nt = K / BK;
    unsigned voffA[2], voffB[2];
#pragma unroll
    for (int i = 0; i < 2; ++i) { int R, C; stage_rc(tid * 16 + i * 8192, R, C); const int Rb = Epi::PERM ? ((R & ~31) + perm32(R & 31)) : R;
        voffA[i] = (unsigned)(R * K + C) * 2u; voffB[i] = (unsigned)(Rb * K + C) * 2u; }
    const size_t kstep = (size_t)(BK * 2);
    const size_t hstep = (size_t)HALF * K * 2;
    const size_t tstep = 2 * hstep;
    const unsigned ldsw = (unsigned)wid * 1024u;
    const int aoff = lds_byte(wr * 64 + fr, fq * 8), boff = lds_byte(wc * 32 + fr, fq * 8);
#define PG8_SA(b, h) (((b) * 2 + (h)) * HTB)
#define PG8_SB(b, h) ((4 + (b) * 2 + (h)) * HTB)
#define PG8_STAGE(bufoff, gbase, voff) do { _Pragma("unroll") for (int _i = 0; _i < 2; ++_i) \
        __builtin_amdgcn_global_load_lds((const unsigned*)((const char*)(gbase) + (voff)[_i]), (PG8_LAS unsigned*)(lds + (bufoff) + ldsw + _i * 8192), 16, 0, 0); } while (0)
#define PG8_LDA(dst, b, h) do { _Pragma("unroll") for (int m = 0; m < 4; ++m) _Pragma("unroll") for (int k = 0; k < 2; ++k) dst[m][k] = *(const PG8_LAS bf16x8*)(lds + PG8_SA(b, h) + aoff + m * 2048 + k * 1024); } while (0)
#define PG8_LDB(dst, b, h) do { _Pragma("unroll") for (int n = 0; n < 2; ++n) _Pragma("unroll") for (int k = 0; k < 2; ++k) dst[n][k] = *(const PG8_LAS bf16x8*)(lds + PG8_SB(b, h) + boff + n * 2048 + k * 1024); } while (0)
#define PG8_MMA(ai, bj, At, Bt) do { __builtin_amdgcn_s_setprio(1); _Pragma("unroll") for (int m = 0; m < 4; ++m) _Pragma("unroll") for (int n = 0; n < 2; ++n) _Pragma("unroll") for (int k = 0; k < 2; ++k) \
        acc[ai][bj][m][n] = __builtin_amdgcn_mfma_f32_16x16x32_bf16(Bt[n][k], At[m][k], acc[ai][bj][m][n], 0, 0, 0); __builtin_amdgcn_s_setprio(0); } while (0)
#define PG8_WAIT_V(n) asm volatile("s_waitcnt vmcnt(" #n ")" ::: "memory")
#define PG8_WAIT_L(n) asm volatile("s_waitcnt lgkmcnt(" #n ")" ::: "memory")
#define PG8_BAR __builtin_amdgcn_s_barrier()
#define PG8_SCHED __builtin_amdgcn_sched_barrier(0)
    Unit cur, nxt; int ui = 0;
    if (!S.next(0, cur)) return;
    f32x4 acc[2][2][4][2];
#pragma unroll
    for (int a = 0; a < 2; ++a)
#pragma unroll
        for (int b = 0; b < 2; ++b)
#pragma unroll
            for (int m = 0; m < 4; ++m)
#pragma unroll
                for (int n = 0; n < 2; ++n) acc[a][b][m][n] = (f32x4){0.f, 0.f, 0.f, 0.f};
    bf16x8 At[4][2], B0[2][2], B1[2][2];
    const char* cA = (const char*)g.A + (size_t)cur.pm * tstep; const char* cB = (const char*)g.Bt + (size_t)cur.pn * tstep;
    S.a_ready(cur);
    if constexpr (SP2) {
        PG8_STAGE(PG8_SB(0, 0), cB, voffB); PG8_STAGE(PG8_SB(0, 1), cB + hstep, voffB); PG8_STAGE(PG8_SA(0, 0), cA, voffA); PG8_STAGE(PG8_SA(0, 1), cA + hstep, voffA);
        if (wr == 1) PG8_BAR;
        PG8_WAIT_V(2); PG8_BAR;
        PG8_STAGE(PG8_SB(1, 0), cB + kstep, voffB); PG8_STAGE(PG8_SA(1, 0), cA + kstep, voffA); PG8_STAGE(PG8_SB(1, 1), cB + hstep + kstep, voffB);
        PG8_WAIT_V(6); PG8_BAR;
    } else {
        PG8_STAGE(PG8_SB(0, 0), cB, voffB); PG8_STAGE(PG8_SA(0, 0), cA, voffA); PG8_STAGE(PG8_SB(0, 1), cB + hstep, voffB); PG8_STAGE(PG8_SA(0, 1), cA + hstep, voffA);
        if (wr == 1) PG8_BAR;
        PG8_WAIT_V(4); PG8_BAR;
        PG8_STAGE(PG8_SB(1, 0), cB + kstep, voffB); PG8_STAGE(PG8_SA(1, 0), cA + kstep, voffA); PG8_STAGE(PG8_SB(1, 1), cB + hstep + kstep, voffB);
        PG8_WAIT_V(6); PG8_BAR;
    }
    for (;;) {
        const bool has_next = S.next(ui + 1, nxt);
        const char* nA = has_next ? (const char*)g.A + (size_t)nxt.pm * tstep : cA; const char* nB = has_next ? (const char*)g.Bt + (size_t)nxt.pn * tstep : cB;
        for (int t = 0; t < nt; t += 2) {
            const bool last = (t == nt - 2);
            const char* a1 = cA + (size_t)(t + 1) * kstep;
            const char* a2 = last ? nA : cA + (size_t)(t + 2) * kstep; const char* b2 = last ? nB : cB + (size_t)(t + 2) * kstep;
            const char* a3 = a2 + kstep; const char* b3 = b2 + kstep;
            if (last && has_next) S.a_ready(nxt);
            if constexpr (SP2) {
            PG8_LDB(B0, 0, 0); PG8_LDB(B1, 0, 1); PG8_SCHED; PG8_LDA(At, 0, 0); PG8_STAGE(PG8_SA(1, 1), a1 + hstep, voffA);
            PG8_WAIT_V(8); PG8_WAIT_L(0); PG8_BAR; PG8_MMA(0, 0, At, B0); PG8_MMA(0, 1, At, B1); PG8_BAR; PG8_SCHED;
            PG8_LDA(At, 0, 1); PG8_STAGE(PG8_SB(0, 0), b2, voffB); PG8_STAGE(PG8_SB(0, 1), b2 + hstep, voffB); PG8_STAGE(PG8_SA(0, 0), a2, voffA);
            PG8_WAIT_V(8); PG8_WAIT_L(0); PG8_BAR; PG8_MMA(1, 0, At, B0); PG8_MMA(1, 1, At, B1); PG8_BAR; PG8_SCHED;
            PG8_LDB(B0, 1, 0); PG8_LDB(B1, 1, 1); PG8_SCHED; PG8_LDA(At, 1, 0); PG8_STAGE(PG8_SA(0, 1), a2 + hstep, voffA);
            PG8_WAIT_V(8); PG8_WAIT_L(0); PG8_BAR; PG8_MMA(0, 0, At, B0); PG8_MMA(0, 1, At, B1); PG8_BAR; PG8_SCHED;
            PG8_LDA(At, 1, 1); PG8_STAGE(PG8_SB(1, 0), b3, voffB); PG8_STAGE(PG8_SB(1, 1), b3 + hstep, voffB); PG8_STAGE(PG8_SA(1, 0), a3, voffA);
            PG8_WAIT_V(8); PG8_WAIT_L(0); PG8_BAR; PG8_MMA(1, 0, At, B0); PG8_MMA(1, 1, At, B1); PG8_BAR; PG8_SCHED;
            } else {
            PG8_LDB(B0, 0, 0); PG8_SCHED; PG8_LDA(At, 0, 0); PG8_STAGE(PG8_SA(1, 1), a1 + hstep, voffA);
            PG8_WAIT_L(8); PG8_BAR; PG8_WAIT_L(0); PG8_MMA(0, 0, At, B0); PG8_BAR; PG8_SCHED;
            PG8_LDB(B1, 0, 1); PG8_STAGE(PG8_SB(0, 0), b2, voffB);
            PG8_BAR; PG8_WAIT_L(0); PG8_MMA(0, 1, At, B1); PG8_BAR;
            PG8_LDA(At, 0, 1); PG8_STAGE(PG8_SA(0, 0), a2, voffA);
            PG8_BAR; PG8_WAIT_L(0); PG8_MMA(1, 0, At, B0); PG8_BAR; PG8_SCHED;
            PG8_STAGE(PG8_SB(0, 1), b2 + hstep, voffB);
            PG8_WAIT_V(6); PG8_BAR; PG8_MMA(1, 1, At, B1); PG8_BAR;
            PG8_LDB(B0, 1, 0); PG8_SCHED; PG8_LDA(At, 1, 0); PG8_STAGE(PG8_SA(0, 1), a2 + hstep, voffA);
            PG8_WAIT_L(8); PG8_BAR; PG8_WAIT_L(0); PG8_MMA(0, 0, At, B0); PG8_BAR; PG8_SCHED;
            PG8_LDB(B1, 1, 1); PG8_STAGE(PG8_SB(1, 0), b3, voffB);
            PG8_BAR; PG8_WAIT_L(0); PG8_MMA(0, 1, At, B1); PG8_BAR;
            PG8_LDA(At, 1, 1); PG8_STAGE(PG8_SA(1, 0), a3, voffA);
            PG8_BAR; PG8_WAIT_L(0); PG8_MMA(1, 0, At, B0); PG8_BAR; PG8_SCHED;
            PG8_STAGE(PG8_SB(1, 1), b3 + hstep, voffB);
            PG8_WAIT_V(6); PG8_BAR; PG8_MMA(1, 1, At, B1); PG8_BAR;
            }
        }
        if constexpr (ALIGN_EPI) { if (wr == 0) PG8_BAR; }
        if constexpr (!Epi::AFTER_DRAIN) { E(acc, cur, wr, wc, fr, fq); S.done(cur); }
        if (!has_next) break;
#pragma unroll
        for (int a = 0; a < 2; ++a)
#pragma unroll
            for (int b = 0; b < 2; ++b)
#pragma unroll
                for (int m = 0; m < 4; ++m)
#pragma unroll
                    for (int n = 0; n < 2; ++n) acc[a][b][m][n] = (f32x4){0.f, 0.f, 0.f, 0.f};
        cur = nxt; cA = nA; cB = nB; ++ui;
        if constexpr (ALIGN_EPI) { if (wr == 1) PG8_BAR; }
    }
    PG8_WAIT_V(0);
    if constexpr (!ALIGN_EPI) { if (wr == 0) PG8_BAR; }
    PG8_BAR;
    if constexpr (Epi::AFTER_DRAIN) { E.fused(acc, cur, wr, wc, fr, fq, lds, wid, lane); S.done(cur); }
#undef PG8_SA
#undef PG8_SB
#undef PG8_STAGE
#undef PG8_LDA
#undef PG8_LDB
#undef PG8_MMA
#undef PG8_WAIT_V
#undef PG8_WAIT_L
#undef PG8_BAR
#undef PG8_SCHED
}
}
using pg8::bf16_t; using pg8::bf16x8; using pg8::f32x4; using pg8::u32x4; using pg8::cvt_pk_bf16;
#define LAS __attribute__((address_space(3)))
typedef short s16x4 __attribute__((ext_vector_type(4)));
typedef float f32x16 __attribute__((ext_vector_type(16)));
typedef unsigned u32x2 __attribute__((ext_vector_type(2)));
#define MFMA32(a, b, c) __builtin_amdgcn_mfma_f32_32x32x16_bf16((a), (b), (c), 0, 0, 0)

constexpr int DM = 2048, NB = 8, SEQ = 4096, NTOK = NB * SEQ, NMEM = 256, NLAYER = 4;
constexpr int NZ0 = 5632, NZ1 = 7424, NZ2 = 7168, NSRC1 = 7180;
constexpr float LOG2E = 1.4426950408889634f;
constexpr float EPS = 1e-6f;
constexpr size_t MiB = 1u << 20;
constexpr size_t WS_WIN0 = 0, WS_WIN1 = 22 * MiB, WS_WIN2 = 51 * MiB, WS_WIN3 = 79 * MiB, WS_WOUT = 101 * MiB, WS_WKV = 133 * MiB, WS_MEMN = 149 * MiB,
                 WS_KVM = 157 * MiB, WS_LS = 173 * MiB, WS_SSQ = 175 * MiB, WS_GT = 176 * MiB, WS_HB = 177 * MiB, WS_BR = 305 * MiB, WS_Z = 433 * MiB, WS_END = 897 * MiB;
constexpr int LDS_MISC = 131072;
constexpr int LDS_PART = 131072;
constexpr int LDS_BYTES = 131072 + 8192 + 4096;

struct Params {
    const float *x, *mem, *mem_norm_g, *rel_bias, *norm_g, *w_mem_kv, *mem_q_norm_g, *mem_k_norm_g, *w_out, *a_w_in, *a_ln_g, *a_ln_b, *a_w_s, *a_b_s,
                *b_w_in, *b_b_f, *b_q_norm_g, *b_k_norm_g, *c_w_in, *c_q_norm_g, *c_k_norm_g, *c_lam, *c_subln_g;
    float* out; unsigned char* ws; int ph_lo, ph_hi;
};

__device__ __forceinline__ unsigned off_b(unsigned row, unsigned ch) { return 256u * row + 16u * (ch ^ (((row & 3u) << 2) | ((row >> 2) & 3u))); }
__device__ __forceinline__ float bf2f(unsigned short v) { return __uint_as_float(((unsigned)v) << 16); }
__device__ __forceinline__ float bflo(unsigned w) { return __uint_as_float(w << 16); }
__device__ __forceinline__ float bfhi(unsigned w) { return __uint_as_float(w & 0xffff0000u); }
__device__ __forceinline__ unsigned f2bf(float f) { unsigned u = __float_as_uint(f); return (u + 0x7fffu + ((u >> 16) & 1u)) >> 16; }
typedef float f32x2v __attribute__((ext_vector_type(2)));
typedef __bf16 bf16x2v __attribute__((ext_vector_type(2)));
__device__ __forceinline__ unsigned pk2(float lo, float hi) { const f32x2v v = {lo, hi}; return __builtin_bit_cast(unsigned, __builtin_convertvector(v, bf16x2v)); }
__device__ __forceinline__ float fast_exp2(float x) { return __builtin_amdgcn_exp2f(x); }
__device__ __forceinline__ float fast_rcp(float x) { return __builtin_amdgcn_rcpf(x); }
__device__ __forceinline__ float silu_f(float g) { return g * fast_rcp(1.f + fast_exp2(-g * LOG2E)); }
__device__ __forceinline__ float gelu_tanh_f(float x) { const float u = 0.7978845608028654f * (x + 0.044715f * x * x * x); return x * fast_rcp(1.f + fast_exp2(-2.f * LOG2E * u)); }
__device__ __forceinline__ float wave_sum(float v) {
#pragma unroll
    for (int o = 1; o < 64; o <<= 1) v += __shfl_xor(v, o);
    return v;
}

struct EpiZ {
    static constexpr bool PERM = true, AFTER_DRAIN = false;
    unsigned char* ws; LAS float* part; int ldc; int kind; int L;
    __device__ __forceinline__ void operator()(const f32x4 (&acc)[2][2][4][2], const pg8::Unit& u, int wr, int wc, int fr, int fq) const {
        asm volatile("" : "+v"(fr), "+v"(fq));
        const int lrow0 = wr * 64 + fr, row0 = u.pm * 256 + lrow0, colt = u.pn * 256, pn = u.pn;
        bf16_t* const Z = (bf16_t*)(ws + (kind == 3 ? WS_KVM : WS_Z)); float* const LS = (float*)(ws + WS_LS);
        const float* const ssq = (kind == 3) ? nullptr : (const float*)(ws + WS_SSQ) + (size_t)L * NTOK;
        const float* const gt = (const float*)(ws + WS_GT);
        const float* const bfp = gt + 2048; const float* const gq = gt + 384 * L; const float* const gk = gq + 128; const float* const gm = (kind == 3) ? gt + 1536 : gq + 256;
        if (kind == 1 && pn == 28) {
            if (wc == 0) {
#pragma unroll
                for (int ai = 0; ai < 2; ++ai)
#pragma unroll
                    for (int m = 0; m < 4; ++m) { const int row = row0 + ai * 128 + m * 16;
#pragma unroll
                        for (int n = 0; n < 2; ++n)
#pragma unroll
                            for (int j = 0; j < 4; ++j) { const int col = 8 * fq + 4 * n + j;
                                if (col < 12) { const float xv = acc[ai][0][m][n][j] * rsqrtf(ssq[row] * (1.f / DM) + EPS) + bfp[col]; LS[(size_t)row * 16 + col] = fminf(xv, 0.f) - log1pf(expf(-fabsf(xv))); } } }
            }
            return;
        }
        int W = 0; const float* g = nullptr;
        if (kind == 0) { if (pn == 12 || pn == 13) { W = 128; g = gm; } }
        else if (kind == 3) { if ((pn & 3) < 2) { W = 128; g = gm + (pn >> 2) * 128; } }
        else { if (pn < 6) { W = (kind == 1) ? 128 : 64; g = gq; } else if (pn < 12) { W = (kind == 1) ? 128 : 64; g = gk; } else if (pn == 18 || pn == 19) { W = 128; g = gm; } }
        const bool act = (kind == 0) && (pn < 12);
        f32x4 g0 = (f32x4){1.f, 1.f, 1.f, 1.f}, g1 = g0;
        if (W) {
#pragma unroll
            for (int ai = 0; ai < 2; ++ai)
#pragma unroll
                for (int m = 0; m < 4; ++m)
#pragma unroll
                    for (int bj = 0; bj < 2; ++bj) { const f32x4 a0 = acc[ai][bj][m][0], a1 = acc[ai][bj][m][1];
                        float ss = (a0[0] * a0[0] + a0[1] * a0[1]) + (a0[2] * a0[2] + a0[3] * a0[3]) + (a1[0] * a1[0] + a1[1] * a1[1]) + (a1[2] * a1[2] + a1[3] * a1[3]);
                        ss += __shfl_xor(ss, 16); ss += __shfl_xor(ss, 32);
                        if (fq == 0) part[(lrow0 + ai * 128 + m * 16) * 8 + bj * 4 + wc] = ss; }
            asm volatile("s_waitcnt lgkmcnt(0)" ::: "memory"); __builtin_amdgcn_s_barrier(); asm volatile("" ::: "memory");
            const float* gp = g + ((32 * wc + 8 * fq) & (W - 1));
            g0 = *(const f32x4*)gp; g1 = *(const f32x4*)(gp + 4);
        }
        const float invW = W ? 1.f / (float)W : 0.f;
        const int col0 = colt + wc * 32 + 8 * fq;
#pragma unroll
        for (int ai = 0; ai < 2; ++ai) {
            float rsv[4];
#pragma unroll
            for (int m = 0; m < 4; ++m) rsv[m] = ssq ? rsqrtf(ssq[row0 + ai * 128 + m * 16] * (1.f / DM) + EPS) : 1.f;
#pragma unroll
            for (int m = 0; m < 4; ++m) { bf16_t* rowp = Z + (size_t)(row0 + ai * 128 + m * 16) * ldc + col0;
                const float rs = rsv[m];
#pragma unroll
                for (int bj = 0; bj < 2; ++bj) { float mm = rs;
                    if (W) { const f32x4 pp = *(const LAS f32x4*)(part + (lrow0 + ai * 128 + m * 16) * 8 + bj * 4);
                        const float tot = (W == 128) ? ((pp[0] + pp[1]) + (pp[2] + pp[3])) : (wc < 2 ? pp[0] + pp[1] : pp[2] + pp[3]);
                        mm = rs * rsqrtf(tot * rs * rs * invW + EPS); }
                    f32x4 v0 = acc[ai][bj][m][0] * mm * g0, v1 = acc[ai][bj][m][1] * mm * g1;
                    if (act) {
#pragma unroll
                        for (int j = 0; j < 4; ++j) { v0[j] = gelu_tanh_f(v0[j]); v1[j] = gelu_tanh_f(v1[j]); } }
                    u32x4 w; w.x = cvt_pk_bf16(v0[0], v0[1]); w.y = cvt_pk_bf16(v0[2], v0[3]); w.z = cvt_pk_bf16(v1[0], v1[1]); w.w = cvt_pk_bf16(v1[2], v1[3]);
                    *(u32x4*)(rowp + bj * 128) = w; } } }
    }
};
struct EpiOut {
    static constexpr bool PERM = false, AFTER_DRAIN = false;
    const float* Xin; float* Out; bf16_t* HBo; float* ssq;
    __device__ __forceinline__ void operator()(const f32x4 (&acc)[2][2][4][2], const pg8::Unit& u, int wr, int wc, int fr, int fq) const {
        asm volatile("" : "+v"(fr), "+v"(fq));
        const int row0 = u.pm * 256 + wr * 64 + fr, col0 = u.pn * 256 + wc * 32 + 4 * fq;
        f32x4 xr[3][4];
#define EO_LOAD(rr, slot) do { const size_t o_ = (size_t)(row0 + ((rr) >> 2) * 128 + ((rr) & 3) * 16) * DM + col0; _Pragma("unroll") for (int q_ = 0; q_ < 4; ++q_) xr[slot][q_] = *(const f32x4*)(Xin + o_ + (q_ >> 1) * 128 + (q_ & 1) * 16); } while (0)
        EO_LOAD(0, 0); EO_LOAD(1, 1);
#pragma unroll
        for (int rr = 0; rr < 8; ++rr) { const int ai = rr >> 2, m = rr & 3, row = row0 + ai * 128 + m * 16; const size_t o = (size_t)row * DM + col0; float s = 0.f;
            if (rr + 2 < 8) EO_LOAD(rr + 2, (rr + 2) % 3);
#pragma unroll
            for (int q = 0; q < 4; ++q) { const int bj = q >> 1, n = q & 1; const size_t idx = o + bj * 128 + n * 16; const f32x4 v = xr[rr % 3][q] + acc[ai][bj][m][n]; *(f32x4*)(Out + idx) = v;
                if (ssq) { u32x2 w; w.x = cvt_pk_bf16(v[0], v[1]); w.y = cvt_pk_bf16(v[2], v[3]); *(u32x2*)(HBo + idx) = w; s += (v[0] * v[0] + v[1] * v[1]) + (v[2] * v[2] + v[3] * v[3]); } }
            if (ssq) { s += __shfl_xor(s, 16); s += __shfl_xor(s, 32); if (fq == 0) atomicAdd(ssq + row, s); } }
#undef EO_LOAD
    }
};
#ifndef AT_KD
#define AT_KD 4
#endif
#ifndef AT_VD
#define AT_VD 3
#endif
struct AttnArgs {
    const bf16_t *Q, *K, *V, *G; bf16_t* O;
    int ldq, ldkv, ldg, ldo, q0, ntiles;
    const float* c;
    const float* lutsrc;
    const float* subg;
    float sc, lam, outmul, m2;
};
constexpr int A_CS = 65536, A_LUT = 65536 + 16384;

template <int MODE>
__device__ __forceinline__ void attn_item(LAS unsigned char* lds, const AttnArgs& a, const int tid) {
    const int wave = __builtin_amdgcn_readfirstlane(tid >> 6), lane = tid & 63, r = lane & 31, h = lane >> 5;
    constexpr int NKS = (MODE == 2) ? 4 : 8;
    const int map = (MODE == 2) ? (wave >> 2) : 0;
    const int qw0 = a.q0 + 32 * ((MODE == 2) ? (wave & 3) : wave);
    const int tw = (MODE == 0) ? (a.ntiles - 1) : (MODE == 1 ? ((qw0 + 31) >> 6) : (qw0 >> 6));
    __syncthreads();
    if (MODE == 2) {
        if (tid < 255) { const int rel = tid - 191; const int n = rel < 0 ? -rel : rel; int bkt;
            if (n < 8) bkt = n; else { const float nf = (float)n; int lg = 8 + (int)(logf(nf / 8.0f) / 2.772588722239781f * 8.0f); bkt = lg < 15 ? lg : 15; }
            if (rel > 0) bkt += 16;
            ((LAS float*)(lds + A_LUT))[tid] = a.lutsrc[bkt * 12] * LOG2E - a.m2; }
    }
    bf16x8 qf[NKS];
    { const bf16_t* qrow = a.Q + (size_t)(qw0 + r) * a.ldq + map * 64 + 8 * h;
#pragma unroll
      for (int ks = 0; ks < NKS; ++ks) qf[ks] = *(const bf16x8*)(qrow + 16 * ks); }
    if (MODE == 1) {
        LAS float* cl = (LAS float*)(lds + A_CS); LAS float* wtot = (LAS float*)(lds + A_LUT);
        const int n = a.q0 + 256; const bool on = 8 * tid < n;
        float v[8]; float run = 0.f;
        const float* lp = a.c + (size_t)(8 * tid) * 16;
#pragma unroll
        for (int e = 0; e < 8; ++e) { if (on) run += lp[e * 16]; v[e] = run; }
        float incl = run;
#pragma unroll
        for (int o = 1; o < 64; o <<= 1) { const float x = __shfl_up(incl, o); if (lane >= o) incl += x; }
        if (lane == 63) wtot[wave] = incl;
        __syncthreads();
        float pre = incl - run;
        for (int w = 0; w < wave; ++w) pre += wtot[w];
        if (on) {
#pragma unroll
            for (int e = 0; e < 8; ++e) cl[8 * tid + e] = -(pre + v[e]) * LOG2E; }
    }
    unsigned kaddr[NKS];
    { const unsigned X = ((r & 3u) << 2) | ((r >> 2) & 3u);
#pragma unroll
      for (int ks = 0; ks < NKS; ++ks) kaddr[ks] = 256u * r + 16u * ((unsigned)(2 * (map * 4 + ks) + h) ^ X); }
    unsigned vaddr[4][2];
    { const unsigned q = (lane & 15) >> 2, p = lane & 3, blk = (lane >> 4) & 1;
#pragma unroll
      for (int dt = 0; dt < 4; ++dt)
#pragma unroll
          for (int t2 = 0; t2 < 2; ++t2) vaddr[dt][t2] = 16384u + off_b(8 * t2 + 4 * h + q, 4 * dt + 2 * blk + (p >> 1)) + 8u * (p & 1); }
    const unsigned sX = ((unsigned)(lane >> 4) << 2) | (unsigned)(wave & 3);
    const size_t sgoff = (size_t)(4 * wave + (lane >> 4)) * a.ldkv + (size_t)(((unsigned)(lane & 15) ^ sX) * 8u);
    const bf16_t* kg = a.K + sgoff; const bf16_t* vg = a.V + sgoff;
    const size_t tstep = (size_t)64 * a.ldkv, hstep = (size_t)32 * a.ldkv;
#define AT_DMA1(gp, la) asm volatile("s_mov_b32 m0, %1\n\ts_nop 0\n\tglobal_load_lds_dwordx4 %0, off" :: "v"(gp), "s"(la) : "memory", "m0")
#define AT_DMA(t, b) do { const bf16_t* kp = kg + (size_t)(t) * tstep; const bf16_t* vp = vg + (size_t)(t) * tstep; const unsigned la = (unsigned)(size_t)(lds + (b) * 32768 + wave * 1024); \
        AT_DMA1(kp, la); AT_DMA1(kp + hstep, la + 8192u); AT_DMA1(vp, la + 16384u); AT_DMA1(vp + hstep, la + 16384u + 8192u); } while (0)
    float l = 0.f;
    f32x16 o[4];
#pragma unroll
    for (int dt = 0; dt < 4; ++dt)
#pragma unroll
        for (int i = 0; i < 16; ++i) o[dt][i] = 0.f;
    AT_DMA(0, 0);
    asm volatile("s_waitcnt vmcnt(0)" ::: "memory");
    __syncthreads();
#pragma unroll
    for (int ks = 0; ks < NKS; ++ks) asm volatile("" : "+v"(qf[ks]));
    float b15 = 0.f; if (MODE == 2) b15 = ((LAS float*)(lds + A_LUT))[0];
    float addc = -a.m2; if (MODE == 1) addc = -((LAS float*)(lds + A_CS))[qw0 + r] - a.m2; if (MODE == 2) addc = b15;
    const int nt = a.ntiles;
    for (int tt2 = 0; tt2 < nt; tt2 += 2)
#pragma unroll
    for (int bb = 0; bb < 2; ++bb) {
        const int t = tt2 + bb;
        constexpr int dummy_ = 0; (void)dummy_;
        const int b = bb;
        if (t + 1 < nt) AT_DMA(t + 1, b ^ 1);
        if (t <= tw) {
            LAS unsigned char* kb = lds + b * 32768;
            f32x16 s[2];
#pragma unroll
            for (int i = 0; i < 16; ++i) { s[0][i] = 0.f; s[1][i] = 0.f; }
            constexpr int KD = AT_KD, VD = AT_VD;
            bf16x8 kf[KD];
#define AT_KLD(i) (*(LAS bf16x8*)(kb + kaddr[(i) >> 1] + ((i) & 1) * 8192))
#pragma unroll
            for (int i = 0; i < KD; ++i) kf[i] = AT_KLD(i);
#pragma unroll
            for (int i = 0; i < 2 * NKS; ++i) { s[i & 1] = MFMA32(kf[i % KD], qf[i >> 1], s[i & 1]); if (i + KD < 2 * NKS) kf[i % KD] = AT_KLD(i + KD); }
#undef AT_KLD
            bf16x8 vf[VD];
#define AT_VLD(j) do { const s16x4 lo_ = __builtin_amdgcn_ds_read_tr16_b64_v4i16((LAS s16x4*)(kb + vaddr[(j) & 3][0] + (32 * ((j) >> 3) + 16 * (((j) >> 2) & 1)) * 256)); \
                const s16x4 hi_ = __builtin_amdgcn_ds_read_tr16_b64_v4i16((LAS s16x4*)(kb + vaddr[(j) & 3][1] + (32 * ((j) >> 3) + 16 * (((j) >> 2) & 1)) * 256)); \
                vf[(j) % VD] = __builtin_shufflevector(lo_, hi_, 0, 1, 2, 3, 4, 5, 6, 7); } while (0)
#pragma unroll
            for (int j = 0; j < VD; ++j) AT_VLD(j);
            const float sc = a.sc;
            const bool diag = (MODE == 1) && (t * 64 + 63 > qw0);
            const bool near = (MODE == 2) && (t >= tw - 2);
            bf16x8 pf[2];
#pragma unroll
            for (int kt = 0; kt < 2; ++kt) {
                if (MODE == 1) {
                    const LAS float* csb = (const LAS float*)(lds + A_CS) + t * 64 + 32 * kt + 4 * h;
                    const int mb = t * 64 + 32 * kt + 4 * h - (qw0 + r);
#pragma unroll
                    for (int g = 0; g < 4; ++g) { const f32x4 cv = *(const LAS f32x4*)(csb + 8 * g);
#pragma unroll
                        for (int e = 0; e < 4; ++e) { float x = fmaf(s[kt][4 * g + e], sc, addc) + cv[e]; if (diag && (mb + 8 * g + e > 0)) x = -1e30f; s[kt][4 * g + e] = x; } }
                } else if (MODE == 2) {
                    if (near) {
                        const LAS float* lut = (const LAS float*)(lds + A_LUT) + (t * 64 + 32 * kt + 4 * h - (qw0 + r) + 191);
#pragma unroll
                        for (int i = 0; i < 16; ++i) s[kt][i] = fmaf(s[kt][i], sc, lut[8 * (i >> 2) + (i & 3)]);
                    } else {
#pragma unroll
                        for (int i = 0; i < 16; ++i) s[kt][i] = fmaf(s[kt][i], sc, addc);
                    }
                } else {
#pragma unroll
                    for (int i = 0; i < 16; ++i) s[kt][i] = fmaf(s[kt][i], sc, addc);
                }
                float ls = 0.f;
#pragma unroll
                for (int i = 0; i < 16; ++i) { const float pv = fast_exp2(s[kt][i]); s[kt][i] = pv; ls += pv; }
                l += ls;
#pragma unroll
                for (int ss = 0; ss < 2; ++ss) { u32x4 w;
                    w.x = pk2(s[kt][8 * ss + 0], s[kt][8 * ss + 1]); w.y = pk2(s[kt][8 * ss + 2], s[kt][8 * ss + 3]);
                    w.z = pk2(s[kt][8 * ss + 4], s[kt][8 * ss + 5]); w.w = pk2(s[kt][8 * ss + 6], s[kt][8 * ss + 7]);
                    pf[ss] = __builtin_bit_cast(bf16x8, w); }
#pragma unroll
                for (int jj = 0; jj < 8; ++jj) { const int j = 8 * kt + jj;
                    o[jj & 3] = MFMA32(vf[j % VD], pf[jj >> 2], o[jj & 3]);
                    if (j + VD < 16) AT_VLD(j + VD); }
            }
#undef AT_VLD
        }
        asm volatile("s_waitcnt vmcnt(0)" ::: "memory");
        __syncthreads();
    }
#undef AT_DMA
#undef AT_DMA1
    l += __shfl_xor(l, 32);
    const float inv = 1.f / l;
    const size_t qrow = (size_t)(qw0 + r);
    u32x2 gwv[16];
    if (MODE == 2) {
#pragma unroll
        for (int k = 0; k < 16; ++k) gwv[k] = *(const u32x2*)(a.G + qrow * a.ldg + 32 * (k >> 2) + 8 * (k & 3) + 4 * h);
    }
    if (MODE != 2) {
        int ch = tid & 15, r0 = tid >> 4, lrow = 32 * wave + r, hh = h;
        asm volatile("" : "+v"(ch), "+v"(r0), "+v"(lrow), "+v"(hh));
#pragma unroll 1
        for (int i0 = 0; i0 < 8; i0 += 4) { u32x4 gv[4];
#pragma unroll
          for (int i = 0; i < 4; ++i) gv[i] = *(const u32x4*)(a.G + (size_t)(a.q0 + r0 + 32 * (i0 + i)) * a.ldg + 8 * ch);
#pragma unroll
          for (int i = 0; i < 4; ++i) *(LAS u32x4*)(lds + off_b(r0 + 32 * (i0 + i), ch)) = gv[i]; }
        __syncthreads();
#pragma unroll
        for (int dt = 0; dt < 4; ++dt)
#pragma unroll
            for (int g = 0; g < 4; ++g) { const unsigned ad = off_b(lrow, 4 * dt + g) + 8u * hh;
                const u32x2 gw = *(const LAS u32x2*)(lds + ad);
                const float v0 = o[dt][4 * g + 0] * inv * silu_f(bflo(gw.x)), v1 = o[dt][4 * g + 1] * inv * silu_f(bfhi(gw.x));
                const float v2 = o[dt][4 * g + 2] * inv * silu_f(bflo(gw.y)), v3 = o[dt][4 * g + 3] * inv * silu_f(bfhi(gw.y));
                u32x2 w; w.x = pk2(v0, v1); w.y = pk2(v2, v3);
                *(LAS u32x2*)(lds + ad) = w; }
        __syncthreads();
#pragma unroll 4
        for (int i = 0; i < 8; ++i) { const u32x4 ov = *(const LAS u32x4*)(lds + off_b(r0 + 32 * i, ch)); *(u32x4*)(a.O + (size_t)(a.q0 + r0 + 32 * i) * a.ldo + 8 * ch) = ov; }
    } else {
        LAS float* xb = (LAS float*)(lds + (wave & 3) * 16384);
        if (map == 1) {
            const float f = inv * a.lam;
#pragma unroll
            for (int dt = 0; dt < 4; ++dt)
#pragma unroll
                for (int i = 0; i < 16; ++i) xb[(dt * 16 + i) * 64 + lane] = o[dt][i] * f;
        }
        __syncthreads();
        if (map == 0) {
            float ssq = 0.f;
#pragma unroll
            for (int dt = 0; dt < 4; ++dt)
#pragma unroll
                for (int i = 0; i < 16; ++i) { const float v = o[dt][i] * inv - xb[(dt * 16 + i) * 64 + lane]; o[dt][i] = v; ssq += v * v; }
            ssq += __shfl_xor(ssq, 32);
            const float rn = rsqrtf(ssq * (1.f / 128.f) + EPS) * a.outmul;
#pragma unroll
            for (int dt = 0; dt < 4; ++dt)
#pragma unroll
                for (int g = 0; g < 4; ++g) { const int d = 32 * dt + 8 * g + 4 * h;
                    const u32x2 gw = gwv[dt * 4 + g];
                    const f32x4 sg = *(const f32x4*)(a.subg + d);
                    const float v0 = o[dt][4 * g + 0] * rn * sg[0] * silu_f(bflo(gw.x)), v1 = o[dt][4 * g + 1] * rn * sg[1] * silu_f(bfhi(gw.x));
                    const float v2 = o[dt][4 * g + 2] * rn * sg[2] * silu_f(bflo(gw.y)), v3 = o[dt][4 * g + 3] * rn * sg[3] * silu_f(bfhi(gw.y));
                    u32x2 w; w.x = pk2(v0, v1); w.y = pk2(v2, v3);
                    *(u32x2*)(a.O + qrow * a.ldo + d) = w; }
        }
    }
}
__device__ __forceinline__ void tr_item(const float* W, int N, bf16_t* WT, int item, int lane, LAS float* scr, int fox, const float* gk) {
    const int nblk = (N + 31) >> 5, kb = item / nblk, nb = item - kb * nblk, k0 = 64 * kb, n0 = 32 * nb;
    const int nq = lane & 7, kr = lane >> 3, nc = n0 + 4 * nq;
    f32x4 wv[8];
#pragma unroll
    for (int i = 0; i < 8; ++i) wv[i] = (nc < N) ? *(const f32x4*)(W + (size_t)(k0 + kr + 8 * i) * N + nc) : (f32x4){0.f, 0.f, 0.f, 0.f};
#pragma unroll
    for (int i = 0; i < 8; ++i) { const int kk = kr + 8 * i; const float gg = gk ? gk[k0 + kk] : 1.f;
#pragma unroll
        for (int e2 = 0; e2 < 4; ++e2) scr[kk * 33 + 4 * nq + e2] = wv[i][e2] * gg; }
    asm volatile("s_waitcnt lgkmcnt(0)" ::: "memory");
    const int c = lane & 7;
#pragma unroll
    for (int j = 0; j < 4; ++j) { const int nl = (lane >> 3) + 8 * j, n = n0 + nl; const LAS float* s = scr + (8 * c) * 33 + nl;
        if (n < N) { int nd = n; if (fox) { if (n >= 4620) nd = n - 12; else if (n >= 4608) nd = n - 4608 + 7168; }
            u32x4 o; o.x = pk2(s[0 * 33], s[1 * 33]); o.y = pk2(s[2 * 33], s[3 * 33]); o.z = pk2(s[4 * 33], s[5 * 33]); o.w = pk2(s[6 * 33], s[7 * 33]);
            *(u32x4*)(WT + (size_t)nd * DM + k0 + 8 * c) = o; } }
    asm volatile("s_waitcnt lgkmcnt(0)" ::: "memory");
}
__device__ __forceinline__ void rms_row_to_bf16(const float* xrow, const float* g, bf16_t* orow, int lane) {
    const f32x4* xr = (const f32x4*)xrow + lane; const f32x4* gr = (const f32x4*)g + lane;
    f32x4 v[8]; float s = 0.f;
#pragma unroll
    for (int j = 0; j < 8; ++j) { v[j] = xr[64 * j]; s += (v[j][0] * v[j][0] + v[j][1] * v[j][1]) + (v[j][2] * v[j][2] + v[j][3] * v[j][3]); }
    const float rstd = rsqrtf(wave_sum(s) * (1.f / DM) + EPS);
    u32x2* o8 = (u32x2*)orow + lane;
#pragma unroll
    for (int j = 0; j < 8; ++j) { const f32x4 gg = gr[64 * j]; u32x2 w; w.x = pk2(v[j][0] * rstd * gg[0], v[j][1] * rstd * gg[1]); w.y = pk2(v[j][2] * rstd * gg[2], v[j][3] * rstd * gg[3]); o8[64 * j] = w; }
}
__device__ __forceinline__ void row_to_bf16_ssq(const float* xrow, bf16_t* orow, float* ssq, int lane) {
    const f32x4* xr = (const f32x4*)xrow + lane; u32x2* o8 = (u32x2*)orow + lane; float s = 0.f;
#pragma unroll
    for (int j = 0; j < 8; ++j) { const f32x4 v = xr[64 * j]; s += (v[0] * v[0] + v[1] * v[1]) + (v[2] * v[2] + v[3] * v[3]);
        u32x2 w; w.x = pk2(v[0], v[1]); w.y = pk2(v[2], v[3]); o8[64 * j] = w; }
    s = wave_sum(s);
    if (lane == 0) *ssq = s;
}
template <int W>
__device__ __forceinline__ void seg_norm512(bf16_t* p, const float* g, int lane) {
    u32x4 w = *(const u32x4*)(p + 8 * lane);
    float f[8] = {bflo(w.x), bfhi(w.x), bflo(w.y), bfhi(w.y), bflo(w.z), bfhi(w.z), bflo(w.w), bfhi(w.w)};
    float s = 0.f;
#pragma unroll
    for (int j = 0; j < 8; ++j) s += f[j] * f[j];
#pragma unroll
    for (int o = 1; o < W / 8; o <<= 1) s += __shfl_xor(s, o);
    const float rstd = rsqrtf(s * (1.f / W) + EPS);
    const float* gp = g + ((8 * lane) & (W - 1));
    const f32x4 g0 = *(const f32x4*)gp, g1 = *(const f32x4*)(gp + 4);
    w.x = pk2(f[0] * rstd * g0[0], f[1] * rstd * g0[1]); w.y = pk2(f[2] * rstd * g0[2], f[3] * rstd * g0[3]);
    w.z = pk2(f[4] * rstd * g1[0], f[5] * rstd * g1[1]); w.w = pk2(f[6] * rstd * g1[2], f[7] * rstd * g1[3]);
    *(u32x4*)(p + 8 * lane) = w;
}

__device__ __forceinline__ void gmlp_item(LAS unsigned char* lds, const bf16_t* Zt  , bf16_t* BRt  , const bf16_t* wsb, const float* bs_, const float* lng, const float* lnb, const int tid) {
    const int wave = __builtin_amdgcn_readfirstlane(tid >> 6), lane = tid & 63, r = lane & 31, h = lane >> 5;
    LAS float* st = (LAS float*)(lds + 131072);
    __syncthreads();
    for (int tq = 0; tq < 4; ++tq) {
        u32x4 w[4][3];
#pragma unroll
        for (int u = 0; u < 4; ++u)
#pragma unroll
            for (int c = 0; c < 3; ++c) w[u][c] = *(const u32x4*)(Zt + (size_t)(16 * wave + 4 * tq + u) * NZ0 + 1536 + 8 * (lane + 64 * c));
#pragma unroll
        for (int u = 0; u < 4; ++u) { float s = 0.f, s2 = 0.f;
#pragma unroll
            for (int c = 0; c < 3; ++c) { const float f[8] = {bflo(w[u][c].x), bfhi(w[u][c].x), bflo(w[u][c].y), bfhi(w[u][c].y), bflo(w[u][c].z), bfhi(w[u][c].z), bflo(w[u][c].w), bfhi(w[u][c].w)};
#pragma unroll
                for (int j = 0; j < 8; ++j) { s += f[j]; s2 += f[j] * f[j]; } }
            s = wave_sum(s); s2 = wave_sum(s2);
            const float mean = s * (1.f / 1536.f), var = fmaxf(s2 * (1.f / 1536.f) - mean * mean, 0.f);
            const int tok = 16 * wave + 4 * tq + u;
            if (lane == 0) { st[2 * tok] = mean; st[2 * tok + 1] = rsqrtf(var + EPS); } } }
    __syncthreads();
    const int tt = wave & 3, cp = wave >> 2;
    const unsigned q = (lane & 15) >> 2, p = lane & 3, blk = (lane >> 4) & 1;
    unsigned aaddr[8], baddr[2][2];
#pragma unroll
    for (int ks = 0; ks < 8; ++ks) aaddr[ks] = tt * 8192 + off_b(r, 2 * ks + h);
#pragma unroll
    for (int cc = 0; cc < 2; ++cc)
#pragma unroll
        for (int t2 = 0; t2 < 2; ++t2) baddr[cc][t2] = 32768u + off_b(8 * h + 4 * t2 + q, 4 * (2 * cp + cc) + 2 * blk + (p >> 1)) + 8u * (p & 1);
    u32x4 wb[4], vw[4], uu[4], gg4[4];
#define GM_LOAD(gq) do { const bf16_t* Wq = wsb + (size_t)(gq) * 16384; const int ch_ = tid & 15, t0_ = tid >> 4; _Pragma("unroll") for (int i = 0; i < 4; ++i) { const int t = t0_ + 32 * i; \
        wb[i] = *(const u32x4*)(Wq + t * 128 + 8 * ch_); \
        vw[i] = *(const u32x4*)(Zt + (size_t)t * NZ0 + 1536 + (gq) * 128 + 8 * ch_); \
        uu[i] = *(const u32x4*)(Zt + (size_t)t * NZ0 + (gq) * 128 + 8 * ch_); gg4[i] = *(const u32x4*)(Zt + (size_t)t * NZ0 + 3584 + (gq) * 128 + 8 * ch_); } } while (0)
    for (int g = 0; g < 12; ++g) {
        GM_LOAD(g);
        { const int ch = tid & 15, t0 = tid >> 4;
          if (g > 0) {
#pragma unroll
              for (int i = 0; i < 4; ++i) { const int t = t0 + 32 * i; const u32x4 ov = *(const LAS u32x4*)(lds + 65536 + off_b(t, ch)); *(u32x4*)(BRt + (size_t)t * DM + (g - 1) * 128 + 8 * ch) = ov; } }
          const float* gp = lng + g * 128 + 8 * ch; const float* bp = lnb + g * 128 + 8 * ch;
          const f32x4 g0 = *(const f32x4*)gp, g1 = *(const f32x4*)(gp + 4), b0 = *(const f32x4*)bp, b1 = *(const f32x4*)(bp + 4);
#pragma unroll
          for (int i = 0; i < 4; ++i) { const int t = t0 + 32 * i;
              *(LAS u32x4*)(lds + off_b(t, ch)) = wb[i];
              const float mean = st[2 * t], rstd = st[2 * t + 1];
              u32x4 o;
              o.x = pk2((bflo(vw[i].x) - mean) * rstd * g0[0] + b0[0], (bfhi(vw[i].x) - mean) * rstd * g0[1] + b0[1]);
              o.y = pk2((bflo(vw[i].y) - mean) * rstd * g0[2] + b0[2], (bfhi(vw[i].y) - mean) * rstd * g0[3] + b0[3]);
              o.z = pk2((bflo(vw[i].z) - mean) * rstd * g1[0] + b1[0], (bfhi(vw[i].z) - mean) * rstd * g1[1] + b1[1]);
              o.w = pk2((bflo(vw[i].w) - mean) * rstd * g1[2] + b1[2], (bfhi(vw[i].w) - mean) * rstd * g1[3] + b1[3]);
              *(LAS u32x4*)(lds + 32768 + off_b(t, ch)) = o;
              *(LAS u32x4*)(lds + 65536 + off_b(t, ch)) = uu[i]; *(LAS u32x4*)(lds + 98304 + off_b(t, ch)) = gg4[i]; } }
        __syncthreads();
        f32x16 acc[2];
#pragma unroll
        for (int i = 0; i < 16; ++i) { acc[0][i] = 0.f; acc[1][i] = 0.f; }
#pragma unroll
        for (int ks = 0; ks < 8; ++ks) {
            const bf16x8 af = *(LAS bf16x8*)(lds + aaddr[ks]);
#pragma unroll
            for (int cc = 0; cc < 2; ++cc) {
                const s16x4 lo = __builtin_amdgcn_ds_read_tr16_b64_v4i16((LAS s16x4*)(lds + baddr[cc][0] + ks * 4096));
                const s16x4 hi = __builtin_amdgcn_ds_read_tr16_b64_v4i16((LAS s16x4*)(lds + baddr[cc][1] + ks * 4096));
                const bf16x8 bfv = __builtin_shufflevector(lo, hi, 0, 1, 2, 3, 4, 5, 6, 7);
                acc[cc] = MFMA32(bfv, af, acc[cc]); }
        }
        int r2 = r, h2 = h; asm volatile("" : "+v"(r2), "+v"(h2));
        { const int t = 32 * tt + r2; const float bsv = bs_[g * 128 + t];
#pragma unroll
          for (int k8 = 0; k8 < 8; ++k8) { const int cc = k8 >> 2, q4 = k8 & 3;
              const unsigned ad = off_b(t, 4 * (2 * cp + cc) + q4) + 8u * h2;
              const u32x2 uw = *(const LAS u32x2*)(lds + 65536 + ad), gw = *(const LAS u32x2*)(lds + 98304 + ad);
              const float v0 = bflo(uw.x) * (acc[cc][4 * q4 + 0] + bsv) * silu_f(bflo(gw.x)), v1 = bfhi(uw.x) * (acc[cc][4 * q4 + 1] + bsv) * silu_f(bfhi(gw.x));
              const float v2 = bflo(uw.y) * (acc[cc][4 * q4 + 2] + bsv) * silu_f(bflo(gw.y)), v3 = bfhi(uw.y) * (acc[cc][4 * q4 + 3] + bsv) * silu_f(bfhi(gw.y));
              u32x2 w; w.x = pk2(v0, v1); w.y = pk2(v2, v3);
              *(LAS u32x2*)(lds + 65536 + ad) = w; } }
        __syncthreads();
    }
    { const int ch = tid & 15, t0 = tid >> 4;
#pragma unroll
      for (int i = 0; i < 4; ++i) { const int t = t0 + 32 * i; const u32x4 ov = *(const LAS u32x4*)(lds + 65536 + off_b(t, ch)); *(u32x4*)(BRt + (size_t)t * DM + 11 * 128 + 8 * ch) = ov; } }
}
#undef GM_LOAD
constexpr int NPHASE = 1 + 3 * NLAYER;
#ifndef MK_PER_PHASE
#define MK_PER_PHASE 0
#endif

__device__ __forceinline__ void grid_bar(unsigned* base, unsigned k  , int tid) {
    __syncthreads();
    if (tid == 0) {
        __builtin_amdgcn_fence(__ATOMIC_RELEASE, "agent");
        const unsigned G = gridDim.x, x = blockIdx.x & 7u, gsize = (G - x + 7u) >> 3, ngroups = G < 8u ? G : 8u;
        const unsigned prev = __hip_atomic_fetch_add(base + 64 * (1 + x), 1u, __ATOMIC_RELAXED, __HIP_MEMORY_SCOPE_AGENT);
        if (prev + 1u == k * gsize) __hip_atomic_fetch_add(base, 1u, __ATOMIC_RELAXED, __HIP_MEMORY_SCOPE_AGENT);
        while (__hip_atomic_load(base, __ATOMIC_RELAXED, __HIP_MEMORY_SCOPE_AGENT) < k * ngroups) __builtin_amdgcn_s_sleep(1);
        __builtin_amdgcn_fence(__ATOMIC_ACQUIRE, "agent");
    }
    __syncthreads();
}

__global__ void __launch_bounds__(512) mk_fwd(Params P) {
    extern __shared__ __attribute__((aligned(16))) unsigned char shm[];
    LAS unsigned char* lds = (LAS unsigned char*)shm;
    cg::grid_group grid = cg::this_grid();
    const int G = gridDim.x, NGW = G * 8;
    int redo = 0; (void)redo;
    for (int ph = P.ph_lo; ph < P.ph_hi; ++ph) {
        int tid = threadIdx.x; asm volatile("" : "+v"(tid));
        const int wave = __builtin_amdgcn_readfirstlane(tid >> 6), lane = tid & 63, gw = blockIdx.x * 8 + wave;
        unsigned char* ws = P.ws; asm volatile("" : "+s"(ws));
        bf16_t* const WOUT = (bf16_t*)(ws + WS_WOUT); bf16_t* const WKV = (bf16_t*)(ws + WS_WKV); bf16_t* const MEMN = (bf16_t*)(ws + WS_MEMN);
        bf16_t* const KVM = (bf16_t*)(ws + WS_KVM); float* const LS = (float*)(ws + WS_LS); float* const SSQ = (float*)(ws + WS_SSQ);
        bf16_t* const HB = (bf16_t*)(ws + WS_HB); bf16_t* const BR = (bf16_t*)(ws + WS_BR); bf16_t* const Z = (bf16_t*)(ws + WS_Z);

        if (ph == 0) {
            LAS float* scr = (LAS float*)(lds + wave * 16384);
            constexpr int I0 = 32 * 176, I1 = 32 * 225, I2 = 32 * 224, IO = 32 * 64, IK = 32 * 32;
            constexpr int NIT = 2 * I0 + I1 + I2 + 4 * IO + 4 * IK;
            for (int it = gw; it < NIT; it += NGW) {
                int r = it;
                if (r < I0) { tr_item(P.a_w_in, NZ0, (bf16_t*)(ws + WS_WIN0), r, lane, scr, 0, P.norm_g); continue; } r -= I0;
                if (r < I1) { tr_item(P.b_w_in, NSRC1, (bf16_t*)(ws + WS_WIN1), r, lane, scr, 1, P.norm_g + DM); continue; } r -= I1;
                if (r < I2) { tr_item(P.c_w_in, NZ2, (bf16_t*)(ws + WS_WIN2), r, lane, scr, 0, P.norm_g + 2 * DM); continue; } r -= I2;
                if (r < I0) { tr_item(P.a_w_in + (size_t)DM * NZ0, NZ0, (bf16_t*)(ws + WS_WIN3), r, lane, scr, 0, P.norm_g + 3 * DM); continue; } r -= I0;
                if (r < 4 * IO) { const int L = r / IO; tr_item(P.w_out + (size_t)L * DM * DM, DM, WOUT + (size_t)L * DM * DM, r - L * IO, lane, scr, 0, nullptr); continue; } r -= 4 * IO;
                { const int L = r / IK; tr_item(P.w_mem_kv + (size_t)L * DM * 1024, 1024, WKV + (size_t)L * 1024 * DM, r - L * IK, lane, scr, 0, nullptr); }
            }
            { u32x4* zp = (u32x4*)((bf16_t*)(ws + WS_WIN1) + (size_t)NSRC1 * DM); const int nz = (NZ1 - NSRC1) * DM / 8;
              for (int i = blockIdx.x * 512 + tid; i < nz; i += G * 512) zp[i] = (u32x4){0u, 0u, 0u, 0u}; }
            { bf16_t* wsb = (bf16_t*)(ws + WS_GT + 65536);
              for (int i = blockIdx.x * 512 + tid; i < 2 * 12 * 2048; i += G * 512) { const int hd = i >> 11, rem = i & 2047, t = rem >> 4, ch = rem & 15;
                  const float* src = P.a_w_s + (size_t)hd * 16384 + t * 128 + 8 * ch;
                  f32x4 a0 = *(const f32x4*)src, a1 = *(const f32x4*)(src + 4);
                  if (t < 64 && ch >= 8) { a0 = (f32x4){0.f, 0.f, 0.f, 0.f}; a1 = a0; }
                  u32x4 w; w.x = pk2(a0[0], a0[1]); w.y = pk2(a0[2], a0[3]); w.z = pk2(a1[0], a1[1]); w.w = pk2(a1[2], a1[3]);
                  *(u32x4*)(wsb + (size_t)hd * 16384 + t * 128 + 8 * ch) = w; } }
            for (int m = gw; m < NB * NMEM; m += NGW) rms_row_to_bf16(P.mem + (size_t)m * DM, P.mem_norm_g, MEMN + (size_t)m * DM, lane);
            for (int m = gw; m < NTOK; m += NGW) row_to_bf16_ssq(P.x + (size_t)m * DM, HB + (size_t)m * DM, SSQ + m, lane);
            for (int i = blockIdx.x * 512 + tid; i < 3 * NTOK; i += G * 512) SSQ[NTOK + i] = 0.f;
            if (blockIdx.x == 0) { float* gt = (float*)(ws + WS_GT);
                if (tid < 9) { ((unsigned*)(ws + WS_GT))[4096 + 64 * tid] = 0u; ((unsigned*)(ws + WS_GT))[8192 + 64 * tid] = 0u; }
                for (int i = tid; i < 2064; i += 512) { float v = 0.f;
                    if (i < 1536) { const int Lq = i / 384, w = (i % 384) / 128, d = i & 127, kd = Lq % 3;
                        if (w == 2) v = P.mem_q_norm_g[Lq * 128 + d];
                        else if (kd == 1) v = (w == 0 ? P.b_q_norm_g : P.b_k_norm_g)[d];
                        else if (kd == 2) v = (w == 0 ? P.c_q_norm_g : P.c_k_norm_g)[d & 63];
                    } else if (i < 2048) v = P.mem_k_norm_g[i - 1536];
                    else if (i < 2060) v = P.b_b_f[i - 2048];
                    gt[i] = v; }
                if (tid < 19) {
                    float v = 0.f;
                    if (tid < 16) { const int Lq = tid >> 2, w = tid & 3, kd = Lq % 3;
                        if (w == 2) { for (int i = 0; i < 128; ++i) v = fmaxf(v, fabsf(P.mem_q_norm_g[Lq * 128 + i])); }
                        else if (w == 3) { for (int i = 0; i < 128; ++i) v = fmaxf(v, fabsf(P.mem_k_norm_g[Lq * 128 + i])); }
                        else if (kd == 1) { const float* gsrc = (w == 0) ? P.b_q_norm_g : P.b_k_norm_g; for (int i = 0; i < 128; ++i) v = fmaxf(v, fabsf(gsrc[i])); }
                        else if (kd == 2) { const float* gsrc = (w == 0) ? P.c_q_norm_g : P.c_k_norm_g; for (int i = 0; i < 64; ++i) v = fmaxf(v, fabsf(gsrc[i])); }
                    } else if (tid == 16) { for (int i = 0; i < 384; ++i) v = fmaxf(v, P.rel_bias[i]); }
                    else if (tid == 17) { for (int i = 0; i < 64; ++i) v += P.c_lam[i] * P.c_lam[64 + i]; }
                    else { for (int i = 0; i < 64; ++i) v += P.c_lam[128 + i] * P.c_lam[192 + i]; }
                    gt[2080 + tid] = v; } }
        } else {
            const int L = (ph - 1) / 3, sub = (ph - 1) % 3, kind = L % 3;
            const int NZ = (kind == 0) ? NZ0 : (kind == 1 ? NZ1 : NZ2);
            const int memq_off = (kind == 0) ? 3072 : 4608;
            if (sub == 0) {
                for (int jb = (L == 0 ? 0 : 1); jb < 2; ++jb) {
                    pg8::Gemm g; EpiZ E;
                    LAS float* part = (LAS float*)(lds + LDS_PART);
                    if (jb == 0) { g = pg8::Gemm{MEMN, WKV, NB * NMEM, 4096, DM}; E = EpiZ{ws, part, 4096, 3, 0}; }
                    else { bf16_t* wt = (bf16_t*)(ws + (L == 0 ? WS_WIN0 : L == 1 ? WS_WIN1 : L == 2 ? WS_WIN2 : WS_WIN3));
                           g = pg8::Gemm{HB, wt, NTOK, NZ, DM}; E = EpiZ{ws, part, NZ, kind, L}; }
                    pg8::StaticOrder S; S.init(g.M, g.N, G, (int)blockIdx.x);
                    pg8::gemm_phase<EpiZ, pg8::StaticOrder, true, true>(lds, g, S, E, tid);
                }
            } else if (sub == 1) {
                const int gate_off = memq_off + 512;
                const float* gx = (const float*)(ws + WS_GT) + 2080;
                const float gqm = gx[4 * L], gkm = gx[4 * L + 1], gmq = gx[4 * L + 2], gmk = gx[4 * L + 3];
                const float m2_mem = 11.3137085f * gmq * gmk * 1.01f * LOG2E;
                if (kind == 0) {
                    const int j = L / 3;
#ifdef REP_GM
                    for (int rep_ = 0; rep_ < 2; ++rep_)
#endif
                    for (int it = blockIdx.x; it < NTOK / 128; it += G)
                        gmlp_item(lds, Z + (size_t)it * 128 * NZ0, BR + (size_t)it * 128 * DM, (const bf16_t*)(ws + WS_GT + 65536) + (size_t)j * 12 * 16384, P.a_b_s + j * 1536, P.a_ln_g + j * 1536, P.a_ln_b + j * 1536, tid);
                } else if (kind == 1) {
                    for (int it = blockIdx.x; it < 1536; it += G) {
                        const int c = it & 255, rr = it >> 8, bh = rr * 16 + (c & 7) * 2 + (c >> 7); int j = (c >> 3) & 15; if (rr & 1) j = 15 - j;
                        const int b = bh / 12, hh = bh - b * 12;
                        const bf16_t* Zb = Z + (size_t)b * SEQ * NZ1;
                        AttnArgs a; a.Q = Zb + hh * 128; a.K = Zb + 1536 + hh * 128; a.V = Zb + 3072 + hh * 128; a.G = Zb + gate_off + hh * 128; a.O = BR + (size_t)b * SEQ * DM + hh * 128;
                        a.ldq = NZ1; a.ldkv = NZ1; a.ldg = NZ1; a.ldo = DM; a.q0 = 256 * j; a.ntiles = 4 * j + 4; a.c = LS + (size_t)b * SEQ * 16 + hh; a.lutsrc = nullptr; a.subg = nullptr;
                        a.sc = 0.08838834764831845f * LOG2E; a.lam = 0.f; a.outmul = 1.f; a.m2 = 11.3137085f * gqm * gkm * 1.01f * LOG2E;
                        attn_item<1>(lds, a, tid);
                    }
                } else {
                    const float d01 = gx[17], d23 = gx[18];
                    const float lam_init = 0.8f - 0.6f * expf(-0.3f * (float)L);
                    const float lam_val = expf(d01) - expf(d23) + lam_init;
                    const float bmax = gx[16];
                    const float m2_diff = (8.f * gqm * gkm * 1.01f + bmax) * LOG2E;
                    for (int it = blockIdx.x; it < 3072; it += G) {
                        const int c = it & 255, rr = it >> 8, bh = rr * 8 + (c & 7); int j = c >> 3; if (rr & 1) j = 31 - j;
                        const int b = bh / 12, hh = bh - b * 12;
                        const bf16_t* Zb = Z + (size_t)b * SEQ * NZ2;
                        AttnArgs a; a.Q = Zb + hh * 128; a.K = Zb + 1536 + hh * 128; a.V = Zb + 3072 + hh * 128; a.G = Zb + gate_off + hh * 128; a.O = BR + (size_t)b * SEQ * DM + hh * 128;
                        a.ldq = NZ2; a.ldkv = NZ2; a.ldg = NZ2; a.ldo = DM; a.q0 = 128 * j; a.ntiles = 2 * j + 2; a.c = nullptr; a.lutsrc = P.rel_bias + hh; a.subg = P.c_subln_g;
                        a.sc = 0.125f * LOG2E; a.lam = lam_val; a.outmul = 1.f - lam_init; a.m2 = m2_diff;
                        attn_item<2>(lds, a, tid);
                    }
                }
#ifdef REP_MEM
                for (int rep_ = 0; rep_ < 2; ++rep_)
#endif
                for (int it = blockIdx.x; it < 512; it += G) {
                    const int qb = it & 15, hm = (it >> 4) & 3, b = it >> 6;
                    const bf16_t* Zb = Z + (size_t)b * SEQ * NZ;
                    AttnArgs a; a.Q = Zb + memq_off + hm * 128; a.K = KVM + (size_t)b * NMEM * 4096 + L * 1024 + hm * 128; a.V = a.K + 512; a.G = Zb + gate_off + 1536 + hm * 128;
                    a.O = BR + (size_t)b * SEQ * DM + 1536 + hm * 128;
                    a.ldq = NZ; a.ldkv = 4096; a.ldg = NZ; a.ldo = DM; a.q0 = 256 * qb; a.ntiles = 4; a.c = nullptr; a.lutsrc = nullptr; a.subg = nullptr;
                    a.sc = 0.08838834764831845f * LOG2E; a.lam = 0.f; a.outmul = 1.f; a.m2 = m2_mem;
                    attn_item<0>(lds, a, tid);
                }
                __syncthreads();
            } else {
                pg8::Gemm g{BR, WOUT + (size_t)L * DM * DM, NTOK, DM, DM};
                EpiOut E{L == 0 ? P.x : P.out, P.out, HB, (L + 1 < NLAYER) ? SSQ + (size_t)(L + 1) * NTOK : nullptr};
#ifdef REP_OUT0
                if (redo) E.ssq = nullptr;
#endif
                pg8::StaticOrder S; S.init(g.M, g.N, G, (int)blockIdx.x);
                pg8::gemm_phase<EpiOut, pg8::StaticOrder, true, true>(lds, g, S, E, tid);
            }
        }
#ifdef REP_P0
        if (ph == 0 && !redo) { redo = 1; __syncthreads(); --ph; continue; }
        redo = 0;
#endif
#ifdef REP_OUT0
        if (ph == 3 && !redo) { redo = 1; __syncthreads(); --ph; continue; }
        redo = 0;
#endif
#ifdef REP_SUB
        if (ph > 0 && (ph - 1) % 3 == REP_SUB && ((REP_L >> ((ph - 1) / 3)) & 1) && !redo) { redo = 1; __syncthreads(); --ph; continue; }
        redo = 0;
#endif
        if (ph + 1 < P.ph_hi) { if (ph == 0) grid.sync(); else grid_bar((unsigned*)(ws + WS_GT) + 4096, (unsigned)ph, tid); }
#ifdef REP_SYNC
        if (ph == 0) for (int i_ = 0; i_ < 10; ++i_) grid.sync();
#endif
#ifdef REP_BAR
        if (ph == 0) { for (int i_ = 0; i_ < 10; ++i_) grid_bar((unsigned*)(ws + WS_GT) + 8192, (unsigned)(i_ + 1), tid); }
#endif
    }
}

extern "C" void kernel_launch(void* const* d_in, const int* in_sizes, int n_in, void* d_out, int out_size, void* d_ws, size_t ws_size, hipStream_t stream) {
    static int grid = 0;
    if (grid == 0) {
        if (n_in != 23 || ws_size < WS_END) { fprintf(stderr, "kernel_launch: unexpected inputs (n_in %d, ws %zu)\n", n_in, ws_size); grid = -1; return; }
        int dev = 0, cus = 0, per_cu = 0;
        hipGetDevice(&dev); hipDeviceGetAttribute(&cus, hipDeviceAttributeMultiprocessorCount, dev);
        if (hipFuncSetAttribute((const void*)mk_fwd, hipFuncAttributeMaxDynamicSharedMemorySize, LDS_BYTES) != hipSuccess) fprintf(stderr, "kernel_launch: hipFuncSetAttribute failed\n");
        if (hipOccupancyMaxActiveBlocksPerMultiprocessor(&per_cu, (const void*)mk_fwd, 512, LDS_BYTES) != hipSuccess || per_cu < 1) { fprintf(stderr, "kernel_launch: occupancy query says %d\n", per_cu); per_cu = 1; }
        (void)hipGetLastError();
        grid = cus * per_cu;
        fprintf(stderr, "kernel_launch: grid %d (cus %d x %d)\n", grid, cus, per_cu);
    }
    if (grid < 0) return;
    Params p{};
    const float** pp = (const float**)&p;
    for (int i = 0; i < 23; ++i) pp[i] = (const float*)d_in[i];
    p.out = (float*)d_out; p.ws = (unsigned char*)d_ws;
#if MK_PER_PHASE
    for (int ph = 0; ph < NPHASE; ++ph) { p.ph_lo = ph; p.ph_hi = ph + 1; hipLaunchKernelGGL(mk_fwd, dim3(grid), dim3(512), LDS_BYTES, stream, p); }
#else
    p.ph_lo = 0; p.ph_hi = NPHASE;
    void* args[] = {&p};
    hipError_t e = hipLaunchCooperativeKernel((void*)mk_fwd, dim3(grid), dim3(512), args, LDS_BYTES, stream);
    if (e != hipSuccess) fprintf(stderr, "cooperative launch failed: %s (grid %d)\n", hipGetErrorString(e), grid);
#endif
}
```

```cpp
#include <hip/hip_runtime.h>
#include <hip/hip_cooperative_groups.h>
#include <cstdio>
#include <cstdint>
namespace cg = cooperative_groups;
namespace pg8 {
#define PG8_LAS __attribute__((address_space(3)))
typedef unsigned short bf16_t;
typedef short bf16x8 __attribute__((ext_vector_type(8)));
typedef float f32x4 __attribute__((ext_vector_type(4)));
typedef unsigned u32x4 __attribute__((ext_vector_type(4)));
constexpr int BM = 256, BK = 64, HALF = 128, HTB = HALF * BK * 2  , STAGE_BYTES = 8 * HTB, NXCD = 8, WGM = 8;

__host__ __device__ __forceinline__ int lds_byte(int r, int c) { const int st = (r >> 4) * 2 + (c >> 5), rr = r & 15, cc = c & 31, ob = rr * 64 + cc * 2; return st * 1024 + (ob ^ (((ob >> 9) & 1) << 5)); }
__host__ __device__ __forceinline__ void stage_rc(int b, int& R, int& C) { const int st = b / 1024, sb = b % 1024, swz = sb ^ (((sb >> 9) & 1) << 5); R = (st >> 1) * 16 + swz / 64; C = (st & 1) * 32 + (swz % 64) / 2; }
__host__ __device__ __forceinline__ int perm32(int rho) { const int n = rho >> 4, i = rho & 15; return 8 * (i >> 2) + 4 * n + (i & 3); }

struct Unit { int pm, pn; };
struct Gemm { const bf16_t* A; const bf16_t* Bt; int M, N, K; };

struct StaticOrder {
    int nM, nN, nwg, G, c;
    __host__ __device__ void init(int M, int N, int G_, int c_) { nM = M / BM; nN = N / BM; nwg = nM * nN; G = G_; c = c_; }
    __host__ __device__ bool next(int i, Unit& u) const {
        const long L = (long)i * G + c; if (L >= nwg) return false;
        int wgid = (int)L; { const int q = nwg / NXCD, r = nwg % NXCD, xcd = wgid % NXCD, off = wgid / NXCD; wgid = (xcd < r ? xcd * (q + 1) : r * (q + 1) + (xcd - r) * q) + off; }
        const int nig = WGM * nN, gid = wgid / nig, fm = gid * WGM, gsz = (nM - fm) < WGM ? (nM - fm) : WGM;
        u.pm = fm + ((wgid % nig) % gsz); u.pn = (wgid % nig) / gsz; return true;
    }
    __device__ __forceinline__ void a_ready(const Unit&) const {}
    __device__ __forceinline__ void done(const Unit&) const {}
};
__device__ __forceinline__ unsigned cvt_pk_bf16(float lo, float hi) { unsigned r; asm volatile("v_cvt_pk_bf16_f32 %0, %1, %2" : "=v"(r) : "v"(lo), "v"(hi)); return r; }
template <class Epi, class Sched, bool ALIGN_EPI = false, bool SP2 = false>
__device__ __forceinline__ void gemm_phase(PG8_LAS unsigned char* lds, const Gemm g, const Sched& S, const Epi& E, const int tid) {
    const int wid = __builtin_amdgcn_readfirstlane(tid >> 6), lane = tid & 63, wr = wid >> 2, wc = wid & 3, fr = lane & 15, fq = lane >> 4;
    const int K = g.K, nt = K / BK;
    unsigned voffA[2], voffB[2];
#pragma unroll
    for (int i = 0; i < 2; ++i) { int R, C; stage_rc(tid * 16 + i * 8192, R, C); const int Rb = Epi::PERM ? ((R & ~31) + perm32(R & 31)) : R;
        voffA[i] = (unsigned)(R * K + C) * 2u; voffB[i] = (unsigned)(Rb * K + C) * 2u; }
    const size_t kstep = (size_t)(BK * 2);
    const size_t hstep = (size_t)HALF * K * 2;
    const size_t tstep = 2 * hstep;
    const unsigned ldsw = (unsigned)wid * 1024u;
    const int aoff = lds_byte(wr * 64 + fr, fq * 8), boff = lds_byte(wc * 32 + fr, fq * 8);
#define PG8_SA(b, h) (((b) * 2 + (h)) * HTB)
#define PG8_SB(b, h) ((4 + (b) * 2 + (h)) * HTB)
#define PG8_STAGE(bufoff, gbase, voff) do { _Pragma("unroll") for (int _i = 0; _i < 2; ++_i) \
        __builtin_amdgcn_global_load_lds((const unsigned*)((const char*)(gbase) + (voff)[_i]), (PG8_LAS unsigned*)(lds + (bufoff) + ldsw + _i * 8192), 16, 0, 0); } while (0)
#define PG8_LDA(dst, b, h) do { _Pragma("unroll") for (int m = 0; m < 4; ++m) _Pragma("unroll") for (int k = 0; k < 2; ++k) dst[m][k] = *(const PG8_LAS bf16x8*)(lds + PG8_SA(b, h) + aoff + m * 2048 + k * 1024); } while (0)
#define PG8_LDB(dst, b, h) do { _Pragma("unroll") for (int n = 0; n < 2; ++n) _Pragma("unroll") for (int k = 0; k < 2; ++k) dst[n][k] = *(const PG8_LAS bf16x8*)(lds + PG8_SB(b, h) + boff + n * 2048 + k * 1024); } while (0)
#define PG8_MMA(ai, bj, At, Bt) do { __builtin_amdgcn_s_setprio(1); _Pragma("unroll") for (int m = 0; m < 4; ++m) _Pragma("unroll") for (int n = 0; n < 2; ++n) _Pragma("unroll") for (int k = 0; k < 2; ++k) \
        acc[ai][bj][m][n] = __builtin_amdgcn_mfma_f32_16x16x32_bf16(Bt[n][k], At[m][k], acc[ai][bj][m][n], 0, 0, 0); __builtin_amdgcn_s_setprio(0); } while (0)
#define PG8_WAIT_V(n) asm volatile("s_waitcnt vmcnt(" #n ")" ::: "memory")
#define PG8_WAIT_L(n) asm volatile("s_waitcnt lgkmcnt(" #n ")" ::: "memory")
#define PG8_BAR __builtin_amdgcn_s_barrier()
#define PG8_SCHED __builtin_amdgcn_sched_barrier(0)
    Unit cur, nxt; int ui = 0;
    if (!S.next(0, cur)) return;
    f32x4 acc[2][2][4][2];
#pragma unroll
    for (int a = 0; a < 2; ++a)
#pragma unroll
        for (int b = 0; b < 2; ++b)
#pragma unroll
            for (int m = 0; m < 4; ++m)
#pragma unroll
                for (int n = 0; n < 2; ++n) acc[a][b][m][n] = (f32x4){0.f, 0.f, 0.f, 0.f};
    bf16x8 At[4][2], B0[2][2], B1[2][2];
    const char* cA = (const char*)g.A + (size_t)cur.pm * tstep; const char* cB = (const char*)g.Bt + (size_t)cur.pn * tstep;
    S.a_ready(cur);
    if constexpr (SP2) {
        PG8_STAGE(PG8_SB(0, 0), cB, voffB); PG8_STAGE(PG8_SB(0, 1), cB + hstep, voffB); PG8_STAGE(PG8_SA(0, 0), cA, voffA); PG8_STAGE(PG8_SA(0, 1), cA + hstep, voffA);
        if (wr == 1) PG8_BAR;
        PG8_WAIT_V(2); PG8_BAR;
        PG8_STAGE(PG8_SB(1, 0), cB + kstep, voffB); PG8_STAGE(PG8_SA(1, 0), cA + kstep, voffA); PG8_STAGE(PG8_SB(1, 1), cB + hstep + kstep, voffB);
        PG8_WAIT_V(6); PG8_BAR;
    } else {
        PG8_STAGE(PG8_SB(0, 0), cB, voffB); PG8_STAGE(PG8_SA(0, 0), cA, voffA); PG8_STAGE(PG8_SB(0, 1), cB + hstep, voffB); PG8_STAGE(PG8_SA(0, 1), cA + hstep, voffA);
        if (wr == 1) PG8_BAR;
        PG8_WAIT_V(4); PG8_BAR;
        PG8_STAGE(PG8_SB(1, 0), cB + kstep, voffB); PG8_STAGE(PG8_SA(1, 0), cA + kstep, voffA); PG8_STAGE(PG8_SB(1, 1), cB + hstep + kstep, voffB);
        PG8_WAIT_V(6); PG8_BAR;
    }
    for (;;) {
        const bool has_next = S.next(ui + 1, nxt);
        const char* nA = has_next ? (const char*)g.A + (size_t)nxt.pm * tstep : cA; const char* nB = has_next ? (const char*)g.Bt + (size_t)nxt.pn * tstep : cB;
        for (int t = 0; t < nt; t += 2) {
            const bool last = (t == nt - 2);
            const char* a1 = cA + (size_t)(t + 1) * kstep;
            const char* a2 = last ? nA : cA + (size_t)(t + 2) * kstep; const char* b2 = last ? nB : cB + (size_t)(t + 2) * kstep;
            const char* a3 = a2 + kstep; const char* b3 = b2 + kstep;
            if (last && has_next) S.a_ready(nxt);
            if constexpr (SP2) {
            PG8_LDB(B0, 0, 0); PG8_LDB(B1, 0, 1); PG8_SCHED; PG8_LDA(At, 0, 0); PG8_STAGE(PG8_SA(1, 1), a1 + hstep, voffA);
            PG8_WAIT_V(8); PG8_WAIT_L(0); PG8_BAR; PG8_MMA(0, 0, At, B0); PG8_MMA(0, 1, At, B1); PG8_BAR; PG8_SCHED;
            PG8_LDA(At, 0, 1); PG8_STAGE(PG8_SB(0, 0), b2, voffB); PG8_STAGE(PG8_SB(0, 1), b2 + hstep, voffB); PG8_STAGE(PG8_SA(0, 0), a2, voffA);
            PG8_WAIT_V(8); PG8_WAIT_L(0); PG8_BAR; PG8_MMA(1, 0, At, B0); PG8_MMA(1, 1, At, B1); PG8_BAR; PG8_SCHED;
            PG8_LDB(B0, 1, 0); PG8_LDB(B1, 1, 1); PG8_SCHED; PG8_LDA(At, 1, 0); PG8_STAGE(PG8_SA(0, 1), a2 + hstep, voffA);
            PG8_WAIT_V(8); PG8_WAIT_L(0); PG8_BAR; PG8_MMA(0, 0, At, B0); PG8_MMA(0, 1, At, B1); PG8_BAR; PG8_SCHED;
            PG8_LDA(At, 1, 1); PG8_STAGE(PG8_SB(1, 0), b3, voffB); PG8_STAGE(PG8_SB(1, 1), b3 + hstep, voffB); PG8_STAGE(PG8_SA(1, 0), a3, voffA);
            PG8_WAIT_V(8); PG8_WAIT_L(0); PG8_BAR; PG8_MMA(1, 0, At, B0); PG8_MMA(1, 1, At, B1); PG8_BAR; PG8_SCHED;
            } else {
            PG8_LDB(B0, 0, 0); PG8_SCHED; PG8_LDA(At, 0, 0); PG8_STAGE(PG8_SA(1, 1), a1 + hstep, voffA);
            PG8_WAIT_L(8); PG8_BAR; PG8_WAIT_L(0); PG8_MMA(0, 0, At, B0); PG8_BAR; PG8_SCHED;
            PG8_LDB(B1, 0, 1); PG8_STAGE(PG8_SB(0, 0), b2, voffB);
            PG8_BAR; PG8_WAIT_L(0); PG8_MMA(0, 1, At, B1); PG8_BAR;
            PG8_LDA(At, 0, 1); PG8_STAGE(PG8_SA(0, 0), a2, voffA);
            PG8_BAR; PG8_WAIT_L(0); PG8_MMA(1, 0, At, B0); PG8_BAR; PG8_SCHED;
            PG8_STAGE(PG8_SB(0, 1), b2 + hstep, voffB);
            PG8_WAIT_V(6); PG8_BAR; PG8_MMA(1, 1, At, B1); PG8_BAR;
            PG8_LDB(B0, 1, 0); PG8_SCHED; PG8_LDA(At, 1, 0); PG8_STAGE(PG8_SA(0, 1), a2 + hstep, voffA);
            PG8_WAIT_L(8); PG8_BAR; PG8_WAIT_L(0); PG8_MMA(0, 0, At, B0); PG8_BAR; PG8_SCHED;
            PG8_LDB(B1, 1, 1); PG8_STAGE(PG8_SB(1, 0), b3, voffB);
            PG8_BAR; PG8_WAIT_L(0); PG8_MMA(0, 1, At, B1); PG8_BAR;
            PG8_LDA(At, 1, 1); PG8_STAGE(PG8_SA(1, 0), a3, voffA);
            PG8_BAR; PG8_WAIT_L(0); PG8_MMA(1, 0, At, B0); PG8_BAR; PG8_SCHED;
            PG8_STAGE(PG8_SB(1, 1), b3 + hstep, voffB);
            PG8_WAIT_V(6); PG8_BAR; PG8_MMA(1, 1, At, B1); PG8_BAR;
            }
        }
        if constexpr (ALIGN_EPI) { if (wr == 0) PG8_BAR; }
        if constexpr (!Epi::AFTER_DRAIN) { E(acc, cur, wr, wc, fr, fq); S.done(cur); }
        if (!has_next) break;
#pragma unroll
        for (int a = 0; a < 2; ++a)
#pragma unroll
            for (int b = 0; b < 2; ++b)
#pragma unroll
                for (int m = 0; m < 4; ++m)
#pragma unroll
                    for (int n = 0; n < 2; ++n) acc[a][b][m][n] = (f32x4){0.f, 0.f, 0.f, 0.f};
        cur = nxt; cA = nA; cB = nB; ++ui;
        if constexpr (ALIGN_EPI) { if (wr == 1) PG8_BAR; }
    }
    PG8_WAIT_V(0);
    if constexpr (!ALIGN_EPI) { if (wr == 0) PG8_BAR; }
    PG8_BAR;
    if constexpr (Epi::AFTER_DRAIN) { E.fused(acc, cur, wr, wc, fr, fq, lds, wid, lane); S.done(cur); }
#undef PG8_SA
#undef PG8_SB
#undef PG8_STAGE
#undef PG8_LDA
#undef PG8_LDB
#undef PG8_MMA
#undef PG8_WAIT_V
#undef PG8_WAIT_L
#undef PG8_BAR
#undef PG8_SCHED
}
}
using pg8::bf16_t; using pg8::bf16x8; using pg8::f32x4; using pg8::u32x4; using pg8::cvt_pk_bf16;
#define LAS __attribute__((address_space(3)))
typedef short s16x4 __attribute__((ext_vector_type(4)));
typedef float f32x16 __attribute__((ext_vector_type(16)));
typedef unsigned u32x2 __attribute__((ext_vector_type(2)));
#define MFMA32(a, b, c) __builtin_amdgcn_mfma_f32_32x32x16_bf16((a), (b), (c), 0, 0, 0)

constexpr int DM = 2048, NB = 8, SEQ = 4096, NTOK = NB * SEQ, NMEM = 256, NLAYER = 4;
constexpr int NZ0 = 5632, NZ1 = 7424, NZ2 = 7168, NSRC1 = 7180;
constexpr float LOG2E = 1.4426950408889634f;
constexpr float EPS = 1e-6f;
constexpr size_t MiB = 1u << 20;
constexpr size_t WS_WIN0 = 0, WS_WIN1 = 22 * MiB, WS_WIN2 = 51 * MiB, WS_WIN3 = 79 * MiB, WS_WOUT = 101 * MiB, WS_WKV = 133 * MiB, WS_MEMN = 149 * MiB,
                 WS_KVM = 157 * MiB, WS_LS = 173 * MiB, WS_SSQ = 175 * MiB, WS_GT = 176 * MiB, WS_HB = 177 * MiB, WS_BR = 305 * MiB, WS_Z = 433 * MiB, WS_END = 897 * MiB;
constexpr int LDS_MISC = 131072;
constexpr int LDS_PART = 131072;
constexpr int LDS_BYTES = 131072 + 8192 + 4096;

struct Params {
    const float *x, *mem, *mem_norm_g, *rel_bias, *norm_g, *w_mem_kv, *mem_q_norm_g, *mem_k_norm_g, *w_out, *a_w_in, *a_ln_g, *a_ln_b, *a_w_s, *a_b_s,
                *b_w_in, *b_b_f, *b_q_norm_g, *b_k_norm_g, *c_w_in, *c_q_norm_g, *c_k_norm_g, *c_lam, *c_subln_g;
    float* out; unsigned char* ws; int ph_lo, ph_hi;
};

__device__ __forceinline__ unsigned off_b(unsigned row, unsigned ch) { return 256u * row + 16u * (ch ^ (((row & 3u) << 2) | ((row >> 2) & 3u))); }
__device__ __forceinline__ float bf2f(unsigned short v) { return __uint_as_float(((unsigned)v) << 16); }
__device__ __forceinline__ float bflo(unsigned w) { return __uint_as_float(w << 16); }
__device__ __forceinline__ float bfhi(unsigned w) { return __uint_as_float(w & 0xffff0000u); }
__device__ __forceinline__ unsigned f2bf(float f) { unsigned u = __float_as_uint(f); return (u + 0x7fffu + ((u >> 16) & 1u)) >> 16; }
typedef float f32x2v __attribute__((ext_vector_type(2)));
typedef __bf16 bf16x2v __attribute__((ext_vector_type(2)));
__device__ __forceinline__ unsigned pk2(float lo, float hi) { const f32x2v v = {lo, hi}; return __builtin_bit_cast(unsigned, __builtin_convertvector(v, bf16x2v)); }
__device__ __forceinline__ float fast_exp2(float x) { return __builtin_amdgcn_exp2f(x); }
__device__ __forceinline__ float fast_rcp(float x) { return __builtin_amdgcn_rcpf(x); }
__device__ __forceinline__ float silu_f(float g) { return g * fast_rcp(1.f + fast_exp2(-g * LOG2E)); }
__device__ __forceinline__ float gelu_tanh_f(float x) { const float u = 0.7978845608028654f * (x + 0.044715f * x * x * x); return x * fast_rcp(1.f + fast_exp2(-2.f * LOG2E * u)); }
__device__ __forceinline__ float wave_sum(float v) {
#pragma unroll
    for (int o = 1; o < 64; o <<= 1) v += __shfl_xor(v, o);
    return v;
}

struct EpiZ {
    static constexpr bool PERM = true, AFTER_DRAIN = false;
    unsigned char* ws; LAS float* part; int ldc; int kind; int L;
    __device__ __forceinline__ void operator()(const f32x4 (&acc)[2][2][4][2], const pg8::Unit& u, int wr, int wc, int fr, int fq) const {
        asm volatile("" : "+v"(fr), "+v"(fq));
        const int lrow0 = wr * 64 + fr, row0 = u.pm * 256 + lrow0, colt = u.pn * 256, pn = u.pn;
        bf16_t* const Z = (bf16_t*)(ws + (kind == 3 ? WS_KVM : WS_Z)); float* const LS = (float*)(ws + WS_LS);
        const float* const ssq = (kind == 3) ? nullptr : (const float*)(ws + WS_SSQ) + (size_t)L * NTOK;
        const float* const gt = (const float*)(ws + WS_GT);
        const float* const bfp = gt + 2048; const float* const gq = gt + 384 * L; const float* const gk = gq + 128; const float* const gm = (kind == 3) ? gt + 1536 : gq + 256;
        if (kind == 1 && pn == 28) {
            if (wc == 0) {
#pragma unroll
                for (int ai = 0; ai < 2; ++ai)
#pragma unroll
                    for (int m = 0; m < 4; ++m) { const int row = row0 + ai * 128 + m * 16;
#pragma unroll
                        for (int n = 0; n < 2; ++n)
#pragma unroll
                            for (int j = 0; j < 4; ++j) { const int col = 8 * fq + 4 * n + j;
                                if (col < 12) { const float xv = acc[ai][0][m][n][j] * rsqrtf(ssq[row] * (1.f / DM) + EPS) + bfp[col]; LS[(size_t)row * 16 + col] = fminf(xv, 0.f) - log1pf(expf(-fabsf(xv))); } } }
            }
            return;
        }
        int W = 0; const float* g = nullptr;
        if (kind == 0) { if (pn == 12 || pn == 13) { W = 128; g = gm; } }
        else if (kind == 3) { if ((pn & 3) < 2) { W = 128; g = gm + (pn >> 2) * 128; } }
        else { if (pn < 6) { W = (kind == 1) ? 128 : 64; g = gq; } else if (pn < 12) { W = (kind == 1) ? 128 : 64; g = gk; } else if (pn == 18 || pn == 19) { W = 128; g = gm; } }
        const bool act = (kind == 0) && (pn < 12);
        f32x4 g0 = (f32x4){1.f, 1.f, 1.f, 1.f}, g1 = g0;
        if (W) {
#pragma unroll
            for (int ai = 0; ai < 2; ++ai)
#pragma unroll
                for (int m = 0; m < 4; ++m)
#pragma unroll
                    for (int bj = 0; bj < 2; ++bj) { const f32x4 a0 = acc[ai][bj][m][0], a1 = acc[ai][bj][m][1];
                        float ss = (a0[0] * a0[0] + a0[1] * a0[1]) + (a0[2] * a0[2] + a0[3] * a0[3]) + (a1[0] * a1[0] + a1[1] * a1[1]) + (a1[2] * a1[2] + a1[3] * a1[3]);
                        ss += __shfl_xor(ss, 16); ss += __shfl_xor(ss, 32);
                        if (fq == 0) part[(lrow0 + ai * 128 + m * 16) * 8 + bj * 4 + wc] = ss; }
            asm volatile("s_waitcnt lgkmcnt(0)" ::: "memory"); __builtin_amdgcn_s_barrier(); asm volatile("" ::: "memory");
            const float* gp = g + ((32 * wc + 8 * fq) & (W - 1));
            g0 = *(const f32x4*)gp; g1 = *(const f32x4*)(gp + 4);
        }
        const float invW = W ? 1.f / (float)W : 0.f;
        const int col0 = colt + wc * 32 + 8 * fq;
#pragma unroll
        for (int ai = 0; ai < 2; ++ai) {
            float rsv[4];
#pragma unroll
            for (int m = 0; m < 4; ++m) rsv[m] = ssq ? rsqrtf(ssq[row0 + ai * 128 + m * 16] * (1.f / DM) + EPS) : 1.f;
#pragma unroll
            for (int m = 0; m < 4; ++m) { bf16_t* rowp = Z + (size_t)(row0 + ai * 128 + m * 16) * ldc + col0;
                const float rs = rsv[m];
#pragma unroll
                for (int bj = 0; bj < 2; ++bj) { float mm = rs;
                    if (W) { const f32x4 pp = *(const LAS f32x4*)(part + (lrow0 + ai * 128 + m * 16) * 8 + bj * 4);
                        const float tot = (W == 128) ? ((pp[0] + pp[1]) + (pp[2] + pp[3])) : (wc < 2 ? pp[0] + pp[1] : pp[2] + pp[3]);
                        mm = rs * rsqrtf(tot * rs * rs * invW + EPS); }
                    f32x4 v0 = acc[ai][bj][m][0] * mm * g0, v1 = acc[ai][bj][m][1] * mm * g1;
                    if (act) {
#pragma unroll
                        for (int j = 0; j < 4; ++j) { v0[j] = gelu_tanh_f(v0[j]); v1[j] = gelu_tanh_f(v1[j]); } }
                    u32x4 w; w.x = cvt_pk_bf16(v0[0], v0[1]); w.y = cvt_pk_bf16(v0[2], v0[3]); w.z = cvt_pk_bf16(v1[0], v1[1]); w.w = cvt_pk_bf16(v1[2], v1[3]);
                    *(u32x4*)(rowp + bj * 128) = w; } } }
    }
};
struct EpiOut {
    static constexpr bool PERM = false, AFTER_DRAIN = false;
    const float* Xin; float* Out; bf16_t* HBo; float* ssq;
    __device__ __forceinline__ void operator()(const f32x4 (&acc)[2][2][4][2], const pg8::Unit& u, int wr, int wc, int fr, int fq) const {
        asm volatile("" : "+v"(fr), "+v"(fq));
        const int row0 = u.pm * 256 + wr * 64 + fr, col0 = u.pn * 256 + wc * 32 + 4 * fq;
        f32x4 xr[3][4];
#define EO_LOAD(rr, slot) do { const size_t o_ = (size_t)(row0 + ((rr) >> 2) * 128 + ((rr) & 3) * 16) * DM + col0; _Pragma("unroll") for (int q_ = 0; q_ < 4; ++q_) xr[slot][q_] = *(const f32x4*)(Xin + o_ + (q_ >> 1) * 128 + (q_ & 1) * 16); } while (0)
        EO_LOAD(0, 0); EO_LOAD(1, 1);
#pragma unroll
        for (int rr = 0; rr < 8; ++rr) { const int ai = rr >> 2, m = rr & 3, row = row0 + ai * 128 + m * 16; const size_t o = (size_t)row * DM + col0; float s = 0.f;
            if (rr + 2 < 8) EO_LOAD(rr + 2, (rr + 2) % 3);
#pragma unroll
            for (int q = 0; q < 4; ++q) { const int bj = q >> 1, n = q & 1; const size_t idx = o + bj * 128 + n * 16; const f32x4 v = xr[rr % 3][q] + acc[ai][bj][m][n]; *(f32x4*)(Out + idx) = v;
                if (ssq) { u32x2 w; w.x = cvt_pk_bf16(v[0], v[1]); w.y = cvt_pk_bf16(v[2], v[3]); *(u32x2*)(HBo + idx) = w; s += (v[0] * v[0] + v[1] * v[1]) + (v[2] * v[2] + v[3] * v[3]); } }
            if (ssq) { s += __shfl_xor(s, 16); s += __shfl_xor(s, 32); if (fq == 0) atomicAdd(ssq + row, s); } }
#undef EO_LOAD
    }
};
#ifndef AT_KD
#define AT_KD 4
#endif
#ifndef AT_VD
#define AT_VD 3
#endif
struct AttnArgs {
    const bf16_t *Q, *K, *V, *G; bf16_t* O;
    int ldq, ldkv, ldg, ldo, q0, ntiles;
    const float* c;
    const float* lutsrc;
    const float* subg;
    float sc, lam, outmul, m2;
};
constexpr int A_CS = 65536, A_LUT = 65536 + 16384;

template <int MODE>
__device__ __forceinline__ void attn_item(LAS unsigned char* lds, const AttnArgs& a, const int tid) {
    const int wave = __builtin_amdgcn_readfirstlane(tid >> 6), lane = tid & 63, r = lane & 31, h = lane >> 5;
    constexpr int NKS = (MODE == 2) ? 4 : 8;
    const int map = (MODE == 2) ? (wave >> 2) : 0;
    const int qw0 = a.q0 + 32 * ((MODE == 2) ? (wave & 3) : wave);
    const int tw = (MODE == 0) ? (a.ntiles - 1) : (MODE == 1 ? ((qw0 + 31) >> 6) : (qw0 >> 6));
    __syncthreads();
    if (MODE == 2) {
        if (tid < 255) { const int rel = tid - 191; const int n = rel < 0 ? -rel : rel; int bkt;
            if (n < 8) bkt = n; else { const float nf = (float)n; int lg = 8 + (int)(logf(nf / 8.0f) / 2.772588722239781f * 8.0f); bkt = lg < 15 ? lg : 15; }
            if (rel > 0) bkt += 16;
            ((LAS float*)(lds + A_LUT))[tid] = a.lutsrc[bkt * 12] * LOG2E - a.m2; }
    }
    bf16x8 qf[NKS];
    { const bf16_t* qrow = a.Q + (size_t)(qw0 + r) * a.ldq + map * 64 + 8 * h;
#pragma unroll
      for (int ks = 0; ks < NKS; ++ks) qf[ks] = *(const bf16x8*)(qrow + 16 * ks); }
    if (MODE == 1) {
        LAS float* cl = (LAS float*)(lds + A_CS); LAS float* wtot = (LAS float*)(lds + A_LUT);
        const int n = a.q0 + 256; const bool on = 8 * tid < n;
        float v[8]; float run = 0.f;
        const float* lp = a.c + (size_t)(8 * tid) * 16;
#pragma unroll
        for (int e = 0; e < 8; ++e) { if (on) run += lp[e * 16]; v[e] = run; }
        float incl = run;
#pragma unroll
        for (int o = 1; o < 64; o <<= 1) { const float x = __shfl_up(incl, o); if (lane >= o) incl += x; }
        if (lane == 63) wtot[wave] = incl;
        __syncthreads();
        float pre = incl - run;
        for (int w = 0; w < wave; ++w) pre += wtot[w];
        if (on) {
#pragma unroll
            for (int e = 0; e < 8; ++e) cl[8 * tid + e] = -(pre + v[e]) * LOG2E; }
    }
    unsigned kaddr[NKS];
    { const unsigned X = ((r & 3u) << 2) | ((r >> 2) & 3u);
#pragma unroll
      for (int ks = 0; ks < NKS; ++ks) kaddr[ks] = 256u * r + 16u * ((unsigned)(2 * (map * 4 + ks) + h) ^ X); }
    unsigned vaddr[4][2];
    { const unsigned q = (lane & 15) >> 2, p = lane & 3, blk = (lane >> 4) & 1;
#pragma unroll
      for (int dt = 0; dt < 4; ++dt)
#pragma unroll
          for (int t2 = 0; t2 < 2; ++t2) vaddr[dt][t2] = 16384u + off_b(8 * t2 + 4 * h + q, 4 * dt + 2 * blk + (p >> 1)) + 8u * (p & 1); }
    const unsigned sX = ((unsigned)(lane >> 4) << 2) | (unsigned)(wave & 3);
    const size_t sgoff = (size_t)(4 * wave + (lane >> 4)) * a.ldkv + (size_t)(((unsigned)(lane & 15) ^ sX) * 8u);
    const bf16_t* kg = a.K + sgoff; const bf16_t* vg = a.V + sgoff;
    const size_t tstep = (size_t)64 * a.ldkv, hstep = (size_t)32 * a.ldkv;
#define AT_DMA1(gp, la) asm volatile("s_mov_b32 m0, %1\n\ts_nop 0\n\tglobal_load_lds_dwordx4 %0, off" :: "v"(gp), "s"(la) : "memory", "m0")
#define AT_DMA(t, b) do { const bf16_t* kp = kg + (size_t)(t) * tstep; const bf16_t* vp = vg + (size_t)(t) * tstep; const unsigned la = (unsigned)(size_t)(lds + (b) * 32768 + wave * 1024); \
        AT_DMA1(kp, la); AT_DMA1(kp + hstep, la + 8192u); AT_DMA1(vp, la + 16384u); AT_DMA1(vp + hstep, la + 16384u + 8192u); } while (0)
    float l = 0.f;
    f32x16 o[4];
#pragma unroll
    for (int dt = 0; dt < 4; ++dt)
#pragma unroll
        for (int i = 0; i < 16; ++i) o[dt][i] = 0.f;
    AT_DMA(0, 0);
    asm volatile("s_waitcnt vmcnt(0)" ::: "memory");
    __syncthreads();
#pragma unroll
    for (int ks = 0; ks < NKS; ++ks) asm volatile("" : "+v"(qf[ks]));
    float b15 = 0.f; if (MODE == 2) b15 = ((LAS float*)(lds + A_LUT))[0];
    float addc = -a.m2; if (MODE == 1) addc = -((LAS float*)(lds + A_CS))[qw0 + r] - a.m2; if (MODE == 2) addc = b15;
    const int nt = a.ntiles;
    for (int tt2 = 0; tt2 < nt; tt2 += 2)
#pragma unroll
    for (int bb = 0; bb < 2; ++bb) {
        const int t = tt2 + bb;
        constexpr int dummy_ = 0; (void)dummy_;
        const int b = bb;
        if (t + 1 < nt) AT_DMA(t + 1, b ^ 1);
        if (t <= tw) {
            LAS unsigned char* kb = lds + b * 32768;
            f32x16 s[2];
#pragma unroll
            for (int i = 0; i < 16; ++i) { s[0][i] = 0.f; s[1][i] = 0.f; }
            constexpr int KD = AT_KD, VD = AT_VD;
            bf16x8 kf[KD];
#define AT_KLD(i) (*(LAS bf16x8*)(kb + kaddr[(i) >> 1] + ((i) & 1) * 8192))
#pragma unroll
            for (int i = 0; i < KD; ++i) kf[i] = AT_KLD(i);
#pragma unroll
            for (int i = 0; i < 2 * NKS; ++i) { s[i & 1] = MFMA32(kf[i % KD], qf[i >> 1], s[i & 1]); if (i + KD < 2 * NKS) kf[i % KD] = AT_KLD(i + KD); }
#undef AT_KLD
            bf16x8 vf[VD];
#define AT_VLD(j) do { const s16x4 lo_ = __builtin_amdgcn_ds_read_tr16_b64_v4i16((LAS s16x4*)(kb + vaddr[(j) & 3][0] + (32 * ((j) >> 3) + 16 * (((j) >> 2) & 1)) * 256)); \
                const s16x4 hi_ = __builtin_amdgcn_ds_read_tr16_b64_v4i16((LAS s16x4*)(kb + vaddr[(j) & 3][1] + (32 * ((j) >> 3) + 16 * (((j) >> 2) & 1)) * 256)); \
                vf[(j) % VD] = __builtin_shufflevector(lo_, hi_, 0, 1, 2, 3, 4, 5, 6, 7); } while (0)
#pragma unroll
            for (int j = 0; j < VD; ++j) AT_VLD(j);
            const float sc = a.sc;
            const bool diag = (MODE == 1) && (t * 64 + 63 > qw0);
            const bool near = (MODE == 2) && (t >= tw - 2);
            bf16x8 pf[2];
#pragma unroll
            for (int kt = 0; kt < 2; ++kt) {
                if (MODE == 1) {
                    const LAS float* csb = (const LAS float*)(lds + A_CS) + t * 64 + 32 * kt + 4 * h;
                    const int mb = t * 64 + 32 * kt + 4 * h - (qw0 + r);
#pragma unroll
                    for (int g = 0; g < 4; ++g) { const f32x4 cv = *(const LAS f32x4*)(csb + 8 * g);
#pragma unroll
                        for (int e = 0; e < 4; ++e) { float x = fmaf(s[kt][4 * g + e], sc, addc) + cv[e]; if (diag && (mb + 8 * g + e > 0)) x = -1e30f; s[kt][4 * g + e] = x; } }
                } else if (MODE == 2) {
                    if (near) {
                        const LAS float* lut = (const LAS float*)(lds + A_LUT) + (t * 64 + 32 * kt + 4 * h - (qw0 + r) + 191);
#pragma unroll
                        for (int i = 0; i < 16; ++i) s[kt][i] = fmaf(s[kt][i], sc, lut[8 * (i >> 2) + (i & 3)]);
                    } else {
#pragma unroll
                        for (int i = 0; i < 16; ++i) s[kt][i] = fmaf(s[kt][i], sc, addc);
                    }
                } else {
#pragma unroll
                    for (int i = 0; i < 16; ++i) s[kt][i] = fmaf(s[kt][i], sc, addc);
                }
                float ls = 0.f;
#pragma unroll
                for (int i = 0; i < 16; ++i) { const float pv = fast_exp2(s[kt][i]); s[kt][i] = pv; ls += pv; }
                l += ls;
#pragma unroll
                for (int ss = 0; ss < 2; ++ss) { u32x4 w;
                    w.x = pk2(s[kt][8 * ss + 0], s[kt][8 * ss + 1]); w.y = pk2(s[kt][8 * ss + 2], s[kt][8 * ss + 3]);
                    w.z = pk2(s[kt][8 * ss + 4], s[kt][8 * ss + 5]); w.w = pk2(s[kt][8 * ss + 6], s[kt][8 * ss + 7]);
                    pf[ss] = __builtin_bit_cast(bf16x8, w); }
#pragma unroll
                for (int jj = 0; jj < 8; ++jj) { const int j = 8 * kt + jj;
                    o[jj & 3] = MFMA32(vf[j % VD], pf[jj >> 2], o[jj & 3]);
                    if (j + VD < 16) AT_VLD(j + VD); }
            }
#undef AT_VLD
        }
        asm volatile("s_waitcnt vmcnt(0)" ::: "memory");
        __syncthreads();
    }
#undef AT_DMA
#undef AT_DMA1
    l += __shfl_xor(l, 32);
    const float inv = 1.f / l;
    const size_t qrow = (size_t)(qw0 + r);
    if (MODE != 2) {
        int ch = tid & 15, r0 = tid >> 4, lrow = 32 * wave + r, hh = h;
        asm volatile("" : "+v"(ch), "+v"(r0), "+v"(lrow), "+v"(hh));
#pragma unroll 1
        for (int i0 = 0; i0 < 8; i0 += 4) { u32x4 gv[4];
#pragma unroll
          for (int i = 0; i < 4; ++i) gv[i] = *(const u32x4*)(a.G + (size_t)(a.q0 + r0 + 32 * (i0 + i)) * a.ldg + 8 * ch);
#pragma unroll
          for (int i = 0; i < 4; ++i) *(LAS u32x4*)(lds + off_b(r0 + 32 * (i0 + i), ch)) = gv[i]; }
        __syncthreads();
#pragma unroll
        for (int dt = 0; dt < 4; ++dt)
#pragma unroll
            for (int g = 0; g < 4; ++g) { const unsigned ad = off_b(lrow, 4 * dt + g) + 8u * hh;
                const u32x2 gw = *(const LAS u32x2*)(lds + ad);
                const float v0 = o[dt][4 * g + 0] * inv * silu_f(bflo(gw.x)), v1 = o[dt][4 * g + 1] * inv * silu_f(bfhi(gw.x));
                const float v2 = o[dt][4 * g + 2] * inv * silu_f(bflo(gw.y)), v3 = o[dt][4 * g + 3] * inv * silu_f(bfhi(gw.y));
                u32x2 w; w.x = pk2(v0, v1); w.y = pk2(v2, v3);
                *(LAS u32x2*)(lds + ad) = w; }
        __syncthreads();
#pragma unroll 4
        for (int i = 0; i < 8; ++i) { const u32x4 ov = *(const LAS u32x4*)(lds + off_b(r0 + 32 * i, ch)); *(u32x4*)(a.O + (size_t)(a.q0 + r0 + 32 * i) * a.ldo + 8 * ch) = ov; }
    } else {
        LAS float* xb = (LAS float*)(lds + (wave & 3) * 16384);
        int ch = tid & 15, r0 = tid >> 4, lrow = 32 * (wave & 3) + r, hh = h;
        asm volatile("" : "+v"(ch), "+v"(r0), "+v"(lrow), "+v"(hh));
        { u32x4 gv[4];
#pragma unroll
          for (int i = 0; i < 4; ++i) gv[i] = *(const u32x4*)(a.G + (size_t)(a.q0 + r0 + 32 * i) * a.ldg + 8 * ch);
#pragma unroll
          for (int i = 0; i < 4; ++i) *(LAS u32x4*)(lds + 98304 + off_b(r0 + 32 * i, ch)) = gv[i]; }
        if (map == 1) {
            const float f = inv * a.lam;
#pragma unroll
            for (int dt = 0; dt < 4; ++dt)
#pragma unroll
                for (int i = 0; i < 16; ++i) xb[(dt * 16 + i) * 64 + lane] = o[dt][i] * f;
        }
        __syncthreads();
        if (map == 0) {
            float ssq = 0.f;
#pragma unroll
            for (int dt = 0; dt < 4; ++dt)
#pragma unroll
                for (int i = 0; i < 16; ++i) { const float v = o[dt][i] * inv - xb[(dt * 16 + i) * 64 + lane]; o[dt][i] = v; ssq += v * v; }
            ssq += __shfl_xor(ssq, 32);
            const float rn = rsqrtf(ssq * (1.f / 128.f) + EPS) * a.outmul;
#pragma unroll
            for (int dt = 0; dt < 4; ++dt)
#pragma unroll
                for (int g = 0; g < 4; ++g) { const int dd = 32 * dt + 8 * g + 4 * hh; const unsigned ad = 98304u + off_b(lrow, 4 * dt + g) + 8u * hh;
                    const u32x2 gw = *(const LAS u32x2*)(lds + ad);
                    const f32x4 sg = *(const f32x4*)(a.subg + dd);
                    const float v0 = o[dt][4 * g + 0] * rn * sg[0] * silu_f(bflo(gw.x)), v1 = o[dt][4 * g + 1] * rn * sg[1] * silu_f(bfhi(gw.x));
                    const float v2 = o[dt][4 * g + 2] * rn * sg[2] * silu_f(bflo(gw.y)), v3 = o[dt][4 * g + 3] * rn * sg[3] * silu_f(bfhi(gw.y));
                    u32x2 w; w.x = pk2(v0, v1); w.y = pk2(v2, v3);
                    *(LAS u32x2*)(lds + ad) = w; }
        }
        __syncthreads();
#pragma unroll
        for (int i = 0; i < 4; ++i) { const u32x4 ov = *(const LAS u32x4*)(lds + 98304 + off_b(r0 + 32 * i, ch)); *(u32x4*)(a.O + (size_t)(a.q0 + r0 + 32 * i) * a.ldo + 8 * ch) = ov; }
    }
}
__device__ __forceinline__ void tr_item(const float* W, int N, bf16_t* WT, int item, int lane, LAS float* scr, int fox, const float* gk) {
    const int nblk = (N + 31) >> 5, kb = item / nblk, nb = item - kb * nblk, k0 = 64 * kb, n0 = 32 * nb;
    const int nq = lane & 7, kr = lane >> 3, nc = n0 + 4 * nq;
    f32x4 wv[8];
#pragma unroll
    for (int i = 0; i < 8; ++i) wv[i] = (nc < N) ? *(const f32x4*)(W + (size_t)(k0 + kr + 8 * i) * N + nc) : (f32x4){0.f, 0.f, 0.f, 0.f};
#pragma unroll
    for (int i = 0; i < 8; ++i) { const int kk = kr + 8 * i; const float gg = gk ? gk[k0 + kk] : 1.f;
#pragma unroll
        for (int e2 = 0; e2 < 4; ++e2) scr[kk * 33 + 4 * nq + e2] = wv[i][e2] * gg; }
    asm volatile("s_waitcnt lgkmcnt(0)" ::: "memory");
    const int c = lane & 7;
#pragma unroll
    for (int j = 0; j < 4; ++j) { const int nl = (lane >> 3) + 8 * j, n = n0 + nl; const LAS float* s = scr + (8 * c) * 33 + nl;
        if (n < N) { int nd = n; if (fox) { if (n >= 4620) nd = n - 12; else if (n >= 4608) nd = n - 4608 + 7168; }
            u32x4 o; o.x = pk2(s[0 * 33], s[1 * 33]); o.y = pk2(s[2 * 33], s[3 * 33]); o.z = pk2(s[4 * 33], s[5 * 33]); o.w = pk2(s[6 * 33], s[7 * 33]);
            *(u32x4*)(WT + (size_t)nd * DM + k0 + 8 * c) = o; } }
    asm volatile("s_waitcnt lgkmcnt(0)" ::: "memory");
}
__device__ __forceinline__ void rms_row_to_bf16(const float* xrow, const float* g, bf16_t* orow, int lane) {
    const f32x4* xr = (const f32x4*)xrow + lane; const f32x4* gr = (const f32x4*)g + lane;
    f32x4 v[8]; float s = 0.f;
#pragma unroll
    for (int j = 0; j < 8; ++j) { v[j] = xr[64 * j]; s += (v[j][0] * v[j][0] + v[j][1] * v[j][1]) + (v[j][2] * v[j][2] + v[j][3] * v[j][3]); }
    const float rstd = rsqrtf(wave_sum(s) * (1.f / DM) + EPS);
    u32x2* o8 = (u32x2*)orow + lane;
#pragma unroll
    for (int j = 0; j < 8; ++j) { const f32x4 gg = gr[64 * j]; u32x2 w; w.x = pk2(v[j][0] * rstd * gg[0], v[j][1] * rstd * gg[1]); w.y = pk2(v[j][2] * rstd * gg[2], v[j][3] * rstd * gg[3]); o8[64 * j] = w; }
}
__device__ __forceinline__ void row_to_bf16_ssq(const float* xrow, bf16_t* orow, float* ssq, int lane) {
    const f32x4* xr = (const f32x4*)xrow + lane; u32x2* o8 = (u32x2*)orow + lane; float s = 0.f;
#pragma unroll
    for (int j = 0; j < 8; ++j) { const f32x4 v = xr[64 * j]; s += (v[0] * v[0] + v[1] * v[1]) + (v[2] * v[2] + v[3] * v[3]);
        u32x2 w; w.x = pk2(v[0], v[1]); w.y = pk2(v[2], v[3]); o8[64 * j] = w; }
    s = wave_sum(s);
    if (lane == 0) *ssq = s;
}
template <int W>
__device__ __forceinline__ void seg_norm512(bf16_t* p, const float* g, int lane) {
    u32x4 w = *(const u32x4*)(p + 8 * lane);
    float f[8] = {bflo(w.x), bfhi(w.x), bflo(w.y), bfhi(w.y), bflo(w.z), bfhi(w.z), bflo(w.w), bfhi(w.w)};
    float s = 0.f;
#pragma unroll
    for (int j = 0; j < 8; ++j) s += f[j] * f[j];
#pragma unroll
    for (int o = 1; o < W / 8; o <<= 1) s += __shfl_xor(s, o);
    const float rstd = rsqrtf(s * (1.f / W) + EPS);
    const float* gp = g + ((8 * lane) & (W - 1));
    const f32x4 g0 = *(const f32x4*)gp, g1 = *(const f32x4*)(gp + 4);
    w.x = pk2(f[0] * rstd * g0[0], f[1] * rstd * g0[1]); w.y = pk2(f[2] * rstd * g0[2], f[3] * rstd * g0[3]);
    w.z = pk2(f[4] * rstd * g1[0], f[5] * rstd * g1[1]); w.w = pk2(f[6] * rstd * g1[2], f[7] * rstd * g1[3]);
    *(u32x4*)(p + 8 * lane) = w;
}

__device__ __forceinline__ void gmlp_item(LAS unsigned char* lds, const bf16_t* Zt  , bf16_t* BRt  , const bf16_t* wsb, const float* bs_, const float* lng, const float* lnb, const int tid) {
    const int wave = __builtin_amdgcn_readfirstlane(tid >> 6), lane = tid & 63, r = lane & 31, h = lane >> 5;
    LAS float* st = (LAS float*)(lds + 131072);
    __syncthreads();
    for (int tq = 0; tq < 4; ++tq) {
        u32x4 w[4][3];
#pragma unroll
        for (int u = 0; u < 4; ++u)
#pragma unroll
            for (int c = 0; c < 3; ++c) w[u][c] = *(const u32x4*)(Zt + (size_t)(16 * wave + 4 * tq + u) * NZ0 + 1536 + 8 * (lane + 64 * c));
#pragma unroll
        for (int u = 0; u < 4; ++u) { float s = 0.f, s2 = 0.f;
#pragma unroll
            for (int c = 0; c < 3; ++c) { const float f[8] = {bflo(w[u][c].x), bfhi(w[u][c].x), bflo(w[u][c].y), bfhi(w[u][c].y), bflo(w[u][c].z), bfhi(w[u][c].z), bflo(w[u][c].w), bfhi(w[u][c].w)};
#pragma unroll
                for (int j = 0; j < 8; ++j) { s += f[j]; s2 += f[j] * f[j]; } }
            s = wave_sum(s); s2 = wave_sum(s2);
            const float mean = s * (1.f / 1536.f), var = fmaxf(s2 * (1.f / 1536.f) - mean * mean, 0.f);
            const int tok = 16 * wave + 4 * tq + u;
            if (lane == 0) { st[2 * tok] = mean; st[2 * tok + 1] = rsqrtf(var + EPS); } } }
    __syncthreads();
    const int tt = wave & 3, cp = wave >> 2;
    const unsigned q = (lane & 15) >> 2, p = lane & 3, blk = (lane >> 4) & 1;
    unsigned aaddr[8], baddr[2][2];
#pragma unroll
    for (int ks = 0; ks < 8; ++ks) aaddr[ks] = tt * 8192 + off_b(r, 2 * ks + h);
#pragma unroll
    for (int cc = 0; cc < 2; ++cc)
#pragma unroll
        for (int t2 = 0; t2 < 2; ++t2) baddr[cc][t2] = 32768u + off_b(8 * h + 4 * t2 + q, 4 * (2 * cp + cc) + 2 * blk + (p >> 1)) + 8u * (p & 1);
    u32x4 wb[4], vw[4], uu[4], gg4[4];
#define GM_LOAD(gq) do { const bf16_t* Wq = wsb + (size_t)(gq) * 16384; const int ch_ = tid & 15, t0_ = tid >> 4; _Pragma("unroll") for (int i = 0; i < 4; ++i) { const int t = t0_ + 32 * i; \
        wb[i] = *(const u32x4*)(Wq + t * 128 + 8 * ch_); \
        vw[i] = *(const u32x4*)(Zt + (size_t)t * NZ0 + 1536 + (gq) * 128 + 8 * ch_); \
        uu[i] = *(const u32x4*)(Zt + (size_t)t * NZ0 + (gq) * 128 + 8 * ch_); gg4[i] = *(const u32x4*)(Zt + (size_t)t * NZ0 + 3584 + (gq) * 128 + 8 * ch_); } } while (0)
    for (int g = 0; g < 12; ++g) {
        GM_LOAD(g);
        { const int ch = tid & 15, t0 = tid >> 4;
          if (g > 0) {
#pragma unroll
              for (int i = 0; i < 4; ++i) { const int t = t0 + 32 * i; const u32x4 ov = *(const LAS u32x4*)(lds + 65536 + off_b(t, ch)); *(u32x4*)(BRt + (size_t)t * DM + (g - 1) * 128 + 8 * ch) = ov; } }
          const float* gp = lng + g * 128 + 8 * ch; const float* bp = lnb + g * 128 + 8 * ch;
          const f32x4 g0 = *(const f32x4*)gp, g1 = *(const f32x4*)(gp + 4), b0 = *(const f32x4*)bp, b1 = *(const f32x4*)(bp + 4);
#pragma unroll
          for (int i = 0; i < 4; ++i) { const int t = t0 + 32 * i;
              *(LAS u32x4*)(lds + off_b(t, ch)) = wb[i];
              const float mean = st[2 * t], rstd = st[2 * t + 1];
              u32x4 o;
              o.x = pk2((bflo(vw[i].x) - mean) * rstd * g0[0] + b0[0], (bfhi(vw[i].x) - mean) * rstd * g0[1] + b0[1]);
              o.y = pk2((bflo(vw[i].y) - mean) * rstd * g0[2] + b0[2], (bfhi(vw[i].y) - mean) * rstd * g0[3] + b0[3]);
              o.z = pk2((bflo(vw[i].z) - mean) * rstd * g1[0] + b1[0], (bfhi(vw[i].z) - mean) * rstd * g1[1] + b1[1]);
              o.w = pk2((bflo(vw[i].w) - mean) * rstd * g1[2] + b1[2], (bfhi(vw[i].w) - mean) * rstd * g1[3] + b1[3]);
              *(LAS u32x4*)(lds + 32768 + off_b(t, ch)) = o;
              *(LAS u32x4*)(lds + 65536 + off_b(t, ch)) = uu[i]; *(LAS u32x4*)(lds + 98304 + off_b(t, ch)) = gg4[i]; } }
        __syncthreads();
        f32x16 acc[2];
#pragma unroll
        for (int i = 0; i < 16; ++i) { acc[0][i] = 0.f; acc[1][i] = 0.f; }
#pragma unroll
        for (int ks = 0; ks < 8; ++ks) {
            const bf16x8 af = *(LAS bf16x8*)(lds + aaddr[ks]);
#pragma unroll
            for (int cc = 0; cc < 2; ++cc) {
                const s16x4 lo = __builtin_amdgcn_ds_read_tr16_b64_v4i16((LAS s16x4*)(lds + baddr[cc][0] + ks * 4096));
                const s16x4 hi = __builtin_amdgcn_ds_read_tr16_b64_v4i16((LAS s16x4*)(lds + baddr[cc][1] + ks * 4096));
                const bf16x8 bfv = __builtin_shufflevector(lo, hi, 0, 1, 2, 3, 4, 5, 6, 7);
                acc[cc] = MFMA32(bfv, af, acc[cc]); }
        }
        int r2 = r, h2 = h; asm volatile("" : "+v"(r2), "+v"(h2));
        { const int t = 32 * tt + r2; const float bsv = bs_[g * 128 + t];
#pragma unroll
          for (int k8 = 0; k8 < 8; ++k8) { const int cc = k8 >> 2, q4 = k8 & 3;
              const unsigned ad = off_b(t, 4 * (2 * cp + cc) + q4) + 8u * h2;
              const u32x2 uw = *(const LAS u32x2*)(lds + 65536 + ad), gw = *(const LAS u32x2*)(lds + 98304 + ad);
              const float v0 = bflo(uw.x) * (acc[cc][4 * q4 + 0] + bsv) * silu_f(bflo(gw.x)), v1 = bfhi(uw.x) * (acc[cc][4 * q4 + 1] + bsv) * silu_f(bfhi(gw.x));
              const float v2 = bflo(uw.y) * (acc[cc][4 * q4 + 2] + bsv) * silu_f(bflo(gw.y)), v3 = bfhi(uw.y) * (acc[cc][4 * q4 + 3] + bsv) * silu_f(bfhi(gw.y));
              u32x2 w; w.x = pk2(v0, v1); w.y = pk2(v2, v3);
              *(LAS u32x2*)(lds + 65536 + ad) = w; } }
        __syncthreads();
    }
    { const int ch = tid & 15, t0 = tid >> 4;
#pragma unroll
      for (int i = 0; i < 4; ++i) { const int t = t0 + 32 * i; const u32x4 ov = *(const LAS u32x4*)(lds + 65536 + off_b(t, ch)); *(u32x4*)(BRt + (size_t)t * DM + 11 * 128 + 8 * ch) = ov; } }
}
#undef GM_LOAD
constexpr int NPHASE = 1 + 3 * NLAYER;
#ifndef MK_PER_PHASE
#define MK_PER_PHASE 0
#endif

__device__ __forceinline__ void grid_bar(unsigned* base, unsigned k  , int tid) {
    __syncthreads();
    if (tid == 0) {
        __builtin_amdgcn_fence(__ATOMIC_RELEASE, "agent");
        const unsigned G = gridDim.x, x = blockIdx.x & 7u, gsize = (G - x + 7u) >> 3, ngroups = G < 8u ? G : 8u;
        const unsigned prev = __hip_atomic_fetch_add(base + 64 * (1 + x), 1u, __ATOMIC_RELAXED, __HIP_MEMORY_SCOPE_AGENT);
        if (prev + 1u == k * gsize) __hip_atomic_fetch_add(base, 1u, __ATOMIC_RELAXED, __HIP_MEMORY_SCOPE_AGENT);
        while (__hip_atomic_load(base, __ATOMIC_RELAXED, __HIP_MEMORY_SCOPE_AGENT) < k * ngroups) __builtin_amdgcn_s_sleep(1);
        __builtin_amdgcn_fence(__ATOMIC_ACQUIRE, "agent");
    }
    __syncthreads();
}

__global__ void __launch_bounds__(512) mk_fwd(Params P) {
    extern __shared__ __attribute__((aligned(16))) unsigned char shm[];
    LAS unsigned char* lds = (LAS unsigned char*)shm;
    cg::grid_group grid = cg::this_grid();
    const int G = gridDim.x, NGW = G * 8;
    int redo = 0; (void)redo;
    for (int ph = P.ph_lo; ph < P.ph_hi; ++ph) {
        int tid = threadIdx.x; asm volatile("" : "+v"(tid));
        const int wave = __builtin_amdgcn_readfirstlane(tid >> 6), lane = tid & 63, gw = blockIdx.x * 8 + wave;
        unsigned char* ws = P.ws; asm volatile("" : "+s"(ws));
        bf16_t* const WOUT = (bf16_t*)(ws + WS_WOUT); bf16_t* const WKV = (bf16_t*)(ws + WS_WKV); bf16_t* const MEMN = (bf16_t*)(ws + WS_MEMN);
        bf16_t* const KVM = (bf16_t*)(ws + WS_KVM); float* const LS = (float*)(ws + WS_LS); float* const SSQ = (float*)(ws + WS_SSQ);
        bf16_t* const HB = (bf16_t*)(ws + WS_HB); bf16_t* const BR = (bf16_t*)(ws + WS_BR); bf16_t* const Z = (bf16_t*)(ws + WS_Z);

        if (ph == 0) {
            LAS float* scr = (LAS float*)(lds + wave * 16384);
            constexpr int I0 = 32 * 176, I1 = 32 * 225, I2 = 32 * 224, IO = 32 * 64, IK = 32 * 32;
            constexpr int NIT = 2 * I0 + I1 + I2 + 4 * IO + 4 * IK;
            for (int it = gw; it < NIT; it += NGW) {
                int r = it;
                if (r < I0) { tr_item(P.a_w_in, NZ0, (bf16_t*)(ws + WS_WIN0), r, lane, scr, 0, P.norm_g); continue; } r -= I0;
                if (r < I1) { tr_item(P.b_w_in, NSRC1, (bf16_t*)(ws + WS_WIN1), r, lane, scr, 1, P.norm_g + DM); continue; } r -= I1;
                if (r < I2) { tr_item(P.c_w_in, NZ2, (bf16_t*)(ws + WS_WIN2), r, lane, scr, 0, P.norm_g + 2 * DM); continue; } r -= I2;
                if (r < I0) { tr_item(P.a_w_in + (size_t)DM * NZ0, NZ0, (bf16_t*)(ws + WS_WIN3), r, lane, scr, 0, P.norm_g + 3 * DM); continue; } r -= I0;
                if (r < 4 * IO) { const int L = r / IO; tr_item(P.w_out + (size_t)L * DM * DM, DM, WOUT + (size_t)L * DM * DM, r - L * IO, lane, scr, 0, nullptr); continue; } r -= 4 * IO;
                { const int L = r / IK; tr_item(P.w_mem_kv + (size_t)L * DM * 1024, 1024, WKV + (size_t)L * 1024 * DM, r - L * IK, lane, scr, 0, nullptr); }
            }
            { u32x4* zp = (u32x4*)((bf16_t*)(ws + WS_WIN1) + (size_t)NSRC1 * DM); const int nz = (NZ1 - NSRC1) * DM / 8;
              for (int i = blockIdx.x * 512 + tid; i < nz; i += G * 512) zp[i] = (u32x4){0u, 0u, 0u, 0u}; }
            { bf16_t* wsb = (bf16_t*)(ws + WS_GT + 65536);
              for (int i = blockIdx.x * 512 + tid; i < 2 * 12 * 2048; i += G * 512) { const int hd = i >> 11, rem = i & 2047, t = rem >> 4, ch = rem & 15;
                  const float* src = P.a_w_s + (size_t)hd * 16384 + t * 128 + 8 * ch;
                  f32x4 a0 = *(const f32x4*)src, a1 = *(const f32x4*)(src + 4);
                  if (t < 64 && ch >= 8) { a0 = (f32x4){0.f, 0.f, 0.f, 0.f}; a1 = a0; }
                  u32x4 w; w.x = pk2(a0[0], a0[1]); w.y = pk2(a0[2], a0[3]); w.z = pk2(a1[0], a1[1]); w.w = pk2(a1[2], a1[3]);
                  *(u32x4*)(wsb + (size_t)hd * 16384 + t * 128 + 8 * ch) = w; } }
            for (int m = gw; m < NB * NMEM; m += NGW) rms_row_to_bf16(P.mem + (size_t)m * DM, P.mem_norm_g, MEMN + (size_t)m * DM, lane);
            for (int m = gw; m < NTOK; m += NGW) row_to_bf16_ssq(P.x + (size_t)m * DM, HB + (size_t)m * DM, SSQ + m, lane);
            for (int i = blockIdx.x * 512 + tid; i < 3 * NTOK; i += G * 512) SSQ[NTOK + i] = 0.f;
            if (blockIdx.x == 0) { float* gt = (float*)(ws + WS_GT);
                if (tid < 9) { ((unsigned*)(ws + WS_GT))[4096 + 64 * tid] = 0u; ((unsigned*)(ws + WS_GT))[8192 + 64 * tid] = 0u; }
                for (int i = tid; i < 2064; i += 512) { float v = 0.f;
                    if (i < 1536) { const int Lq = i / 384, w = (i % 384) / 128, d = i & 127, kd = Lq % 3;
                        if (w == 2) v = P.mem_q_norm_g[Lq * 128 + d];
                        else if (kd == 1) v = (w == 0 ? P.b_q_norm_g : P.b_k_norm_g)[d];
                        else if (kd == 2) v = (w == 0 ? P.c_q_norm_g : P.c_k_norm_g)[d & 63];
                    } else if (i < 2048) v = P.mem_k_norm_g[i - 1536];
                    else if (i < 2060) v = P.b_b_f[i - 2048];
                    gt[i] = v; }
                if (tid < 19) {
                    float v = 0.f;
                    if (tid < 16) { const int Lq = tid >> 2, w = tid & 3, kd = Lq % 3;
                        if (w == 2) { for (int i = 0; i < 128; ++i) v = fmaxf(v, fabsf(P.mem_q_norm_g[Lq * 128 + i])); }
                        else if (w == 3) { for (int i = 0; i < 128; ++i) v = fmaxf(v, fabsf(P.mem_k_norm_g[Lq * 128 + i])); }
                        else if (kd == 1) { const float* gsrc = (w == 0) ? P.b_q_norm_g : P.b_k_norm_g; for (int i = 0; i < 128; ++i) v = fmaxf(v, fabsf(gsrc[i])); }
                        else if (kd == 2) { const float* gsrc = (w == 0) ? P.c_q_norm_g : P.c_k_norm_g; for (int i = 0; i < 64; ++i) v = fmaxf(v, fabsf(gsrc[i])); }
                    } else if (tid == 16) { for (int i = 0; i < 384; ++i) v = fmaxf(v, P.rel_bias[i]); }
                    else if (tid == 17) { for (int i = 0; i < 64; ++i) v += P.c_lam[i] * P.c_lam[64 + i]; }
                    else { for (int i = 0; i < 64; ++i) v += P.c_lam[128 + i] * P.c_lam[192 + i]; }
                    gt[2080 + tid] = v; } }
        } else {
            const int L = (ph - 1) / 3, sub = (ph - 1) % 3, kind = L % 3;
            const int NZ = (kind == 0) ? NZ0 : (kind == 1 ? NZ1 : NZ2);
            const int memq_off = (kind == 0) ? 3072 : 4608;
            if (sub == 0) {
                for (int jb = (L == 0 ? 0 : 1); jb < 2; ++jb) {
                    pg8::Gemm g; EpiZ E;
                    LAS float* part = (LAS float*)(lds + LDS_PART);
                    if (jb == 0) { g = pg8::Gemm{MEMN, WKV, NB * NMEM, 4096, DM}; E = EpiZ{ws, part, 4096, 3, 0}; }
                    else { bf16_t* wt = (bf16_t*)(ws + (L == 0 ? WS_WIN0 : L == 1 ? WS_WIN1 : L == 2 ? WS_WIN2 : WS_WIN3));
                           g = pg8::Gemm{HB, wt, NTOK, NZ, DM}; E = EpiZ{ws, part, NZ, kind, L}; }
                    pg8::StaticOrder S; S.init(g.M, g.N, G, (int)blockIdx.x);
                    pg8::gemm_phase<EpiZ, pg8::StaticOrder, true, true>(lds, g, S, E, tid);
                }
            } else if (sub == 1) {
                const int gate_off = memq_off + 512;
                const float* gx = (const float*)(ws + WS_GT) + 2080;
                const float gqm = gx[4 * L], gkm = gx[4 * L + 1], gmq = gx[4 * L + 2], gmk = gx[4 * L + 3];
                const float m2_mem = 11.3137085f * gmq * gmk * 1.01f * LOG2E;
                if (kind == 0) {
                    const int j = L / 3;
#ifdef REP_GM
                    for (int rep_ = 0; rep_ < 2; ++rep_)
#endif
                    for (int it = blockIdx.x; it < NTOK / 128; it += G)
                        gmlp_item(lds, Z + (size_t)it * 128 * NZ0, BR + (size_t)it * 128 * DM, (const bf16_t*)(ws + WS_GT + 65536) + (size_t)j * 12 * 16384, P.a_b_s + j * 1536, P.a_ln_g + j * 1536, P.a_ln_b + j * 1536, tid);
                } else if (kind == 1) {
                    for (int it = blockIdx.x; it < 1536; it += G) {
                        const int c = it & 255, rr = it >> 8, bh = rr * 16 + (c & 7) * 2 + (c >> 7); int j = (c >> 3) & 15; if (rr & 1) j = 15 - j;
                        const int b = bh / 12, hh = bh - b * 12;
                        const bf16_t* Zb = Z + (size_t)b * SEQ * NZ1;
                        AttnArgs a; a.Q = Zb + hh * 128; a.K = Zb + 1536 + hh * 128; a.V = Zb + 3072 + hh * 128; a.G = Zb + gate_off + hh * 128; a.O = BR + (size_t)b * SEQ * DM + hh * 128;
                        a.ldq = NZ1; a.ldkv = NZ1; a.ldg = NZ1; a.ldo = DM; a.q0 = 256 * j; a.ntiles = 4 * j + 4; a.c = LS + (size_t)b * SEQ * 16 + hh; a.lutsrc = nullptr; a.subg = nullptr;
                        a.sc = 0.08838834764831845f * LOG2E; a.lam = 0.f; a.outmul = 1.f; a.m2 = 11.3137085f * gqm * gkm * 1.01f * LOG2E;
                        attn_item<1>(lds, a, tid);
                    }
                } else {
                    const float d01 = gx[17], d23 = gx[18];
                    const float lam_init = 0.8f - 0.6f * expf(-0.3f * (float)L);
                    const float lam_val = expf(d01) - expf(d23) + lam_init;
                    const float bmax = gx[16];
                    const float m2_diff = (8.f * gqm * gkm * 1.01f + bmax) * LOG2E;
                    for (int it = blockIdx.x; it < 3072; it += G) {
                        const int c = it & 255, rr = it >> 8, bh = rr * 8 + (c & 7); int j = c >> 3; if (rr & 1) j = 31 - j;
                        const int b = bh / 12, hh = bh - b * 12;
                        const bf16_t* Zb = Z + (size_t)b * SEQ * NZ2;
                        AttnArgs a; a.Q = Zb + hh * 128; a.K = Zb + 1536 + hh * 128; a.V = Zb + 3072 + hh * 128; a.G = Zb + gate_off + hh * 128; a.O = BR + (size_t)b * SEQ * DM + hh * 128;
                        a.ldq = NZ2; a.ldkv = NZ2; a.ldg = NZ2; a.ldo = DM; a.q0 = 128 * j; a.ntiles = 2 * j + 2; a.c = nullptr; a.lutsrc = P.rel_bias + hh; a.subg = P.c_subln_g;
                        a.sc = 0.125f * LOG2E; a.lam = lam_val; a.outmul = 1.f - lam_init; a.m2 = m2_diff;
                        attn_item<2>(lds, a, tid);
                    }
                }
#ifdef REP_MEM
                for (int rep_ = 0; rep_ < 2; ++rep_)
#endif
                for (int it = blockIdx.x; it < 512; it += G) {
                    const int qb = it & 15, hm = (it >> 4) & 3, b = it >> 6;
                    const bf16_t* Zb = Z + (size_t)b * SEQ * NZ;
                    AttnArgs a; a.Q = Zb + memq_off + hm * 128; a.K = KVM + (size_t)b * NMEM * 4096 + L * 1024 + hm * 128; a.V = a.K + 512; a.G = Zb + gate_off + 1536 + hm * 128;
                    a.O = BR + (size_t)b * SEQ * DM + 1536 + hm * 128;
                    a.ldq = NZ; a.ldkv = 4096; a.ldg = NZ; a.ldo = DM; a.q0 = 256 * qb; a.ntiles = 4; a.c = nullptr; a.lutsrc = nullptr; a.subg = nullptr;
                    a.sc = 0.08838834764831845f * LOG2E; a.lam = 0.f; a.outmul = 1.f; a.m2 = m2_mem;
                    attn_item<0>(lds, a, tid);
                }
                __syncthreads();
            } else {
                pg8::Gemm g{BR, WOUT + (size_t)L * DM * DM, NTOK, DM, DM};
                EpiOut E{L == 0 ? P.x : P.out, P.out, HB, (L + 1 < NLAYER) ? SSQ + (size_t)(L + 1) * NTOK : nullptr};
#ifdef REP_OUT0
                if (redo) E.ssq = nullptr;
#endif
                pg8::StaticOrder S; S.init(g.M, g.N, G, (int)blockIdx.x);
                pg8::gemm_phase<EpiOut, pg8::StaticOrder, true, true>(lds, g, S, E, tid);
            }
        }
#ifdef REP_P0
        if (ph == 0 && !redo) { redo = 1; __syncthreads(); --ph; continue; }
        redo = 0;
#endif
#ifdef REP_OUT0
        if (ph == 3 && !redo) { redo = 1; __syncthreads(); --ph; continue; }
        redo = 0;
#endif
#ifdef REP_SUB
        if (ph > 0 && (ph - 1) % 3 == REP_SUB && ((REP_L >> ((ph - 1) / 3)) & 1) && !redo) { redo = 1; __syncthreads(); --ph; continue; }
        redo = 0;
#endif
        if (ph + 1 < P.ph_hi) { if (ph == 0) grid.sync(); else grid_bar((unsigned*)(ws + WS_GT) + 4096, (unsigned)ph, tid); }
#ifdef REP_SYNC
        if (ph == 0) for (int i_ = 0; i_ < 10; ++i_) grid.sync();
#endif
#ifdef REP_BAR
        if (ph == 0) { for (int i_ = 0; i_ < 10; ++i_) grid_bar((unsigned*)(ws + WS_GT) + 8192, (unsigned)(i_ + 1), tid); }
#endif
    }
}

extern "C" void kernel_launch(void* const* d_in, const int* in_sizes, int n_in, void* d_out, int out_size, void* d_ws, size_t ws_size, hipStream_t stream) {
    static int grid = 0;
    if (grid == 0) {
        if (n_in != 23 || ws_size < WS_END) { fprintf(stderr, "kernel_launch: unexpected inputs (n_in %d, ws %zu)\n", n_in, ws_size); grid = -1; return; }
        int dev = 0, cus = 0, per_cu = 0;
        hipGetDevice(&dev); hipDeviceGetAttribute(&cus, hipDeviceAttributeMultiprocessorCount, dev);
        if (hipFuncSetAttribute((const void*)mk_fwd, hipFuncAttributeMaxDynamicSharedMemorySize, LDS_BYTES) != hipSuccess) fprintf(stderr, "kernel_launch: hipFuncSetAttribute failed\n");
        if (hipOccupancyMaxActiveBlocksPerMultiprocessor(&per_cu, (const void*)mk_fwd, 512, LDS_BYTES) != hipSuccess || per_cu < 1) { fprintf(stderr, "kernel_launch: occupancy query says %d\n", per_cu); per_cu = 1; }
        (void)hipGetLastError();
        grid = cus * per_cu;
        fprintf(stderr, "kernel_launch: grid %d (cus %d x %d)\n", grid, cus, per_cu);
    }
    if (grid < 0) return;
    Params p{};
    const float** pp = (const float**)&p;
    for (int i = 0; i < 23; ++i) pp[i] = (const float*)d_in[i];
    p.out = (float*)d_out; p.ws = (unsigned char*)d_ws;
#if MK_PER_PHASE
    for (int ph = 0; ph < NPHASE; ++ph) { p.ph_lo = ph; p.ph_hi = ph + 1; hipLaunchKernelGGL(mk_fwd, dim3(grid), dim3(512), LDS_BYTES, stream, p); }
#else
    p.ph_lo = 0; p.ph_hi = NPHASE;
    void* args[] = {&p};
    hipError_t e = hipLaunchCooperativeKernel((void*)mk_fwd, dim3(grid), dim3(512), args, LDS_BYTES, stream);
    if (e != hipSuccess) fprintf(stderr, "cooperative launch failed: %s (grid %d)\n", hipGetErrorString(e), grid);
#endif
}
```

```cpp
#include <hip/hip_runtime.h>
#include <hip/hip_cooperative_groups.h>
#include <cstdio>
#include <cstdint>
namespace cg = cooperative_groups;
namespace pg8 {
#define PG8_LAS __attribute__((address_space(3)))
typedef unsigned short bf16_t;
typedef short bf16x8 __attribute__((ext_vector_type(8)));
typedef float f32x4 __attribute__((ext_vector_type(4)));
typedef unsigned u32x4 __attribute__((ext_vector_type(4)));
constexpr int BM = 256, BK = 64, HALF = 128, HTB = HALF * BK * 2  , STAGE_BYTES = 8 * HTB, NXCD = 8, WGM = 8;

__host__ __device__ __forceinline__ int lds_byte(int r, int c) { const int st = (r >> 4) * 2 + (c >> 5), rr = r & 15, cc = c & 31, ob = rr * 64 + cc * 2; return st * 1024 + (ob ^ (((ob >> 9) & 1) << 5)); }
__host__ __device__ __forceinline__ void stage_rc(int b, int& R, int& C) { const int st = b / 1024, sb = b % 1024, swz = sb ^ (((sb >> 9) & 1) << 5); R = (st >> 1) * 16 + swz / 64; C = (st & 1) * 32 + (swz % 64) / 2; }
__host__ __device__ __forceinline__ int perm32(int rho) { const int n = rho >> 4, i = rho & 15; return 8 * (i >> 2) + 4 * n + (i & 3); }

struct Unit { int pm, pn; };
struct Gemm { const bf16_t* A; const bf16_t* Bt; int M, N, K; };

struct StaticOrder {
    int nM, nN, nwg, G, c;
    __host__ __device__ void init(int M, int N, int G_, int c_) { nM = M / BM; nN = N / BM; nwg = nM * nN; G = G_; c = c_; }
    __host__ __device__ bool next(int i, Unit& u) const {
        const long L = (long)i * G + c; if (L >= nwg) return false;
        int wgid = (int)L; { const int q = nwg / NXCD, r = nwg % NXCD, xcd = wgid % NXCD, off = wgid / NXCD; wgid = (xcd < r ? xcd * (q + 1) : r * (q + 1) + (xcd - r) * q) + off; }
        const int nig = WGM * nN, gid = wgid / nig, fm = gid * WGM, gsz = (nM - fm) < WGM ? (nM - fm) : WGM;
        u.pm = fm + ((wgid % nig) % gsz); u.pn = (wgid % nig) / gsz; return true;
    }
    __device__ __forceinline__ void a_ready(const Unit&) const {}
    __device__ __forceinline__ void done(const Unit&) const {}
};
__device__ __forceinline__ unsigned cvt_pk_bf16(float lo, float hi) { unsigned r; asm volatile("v_cvt_pk_bf16_f32 %0, %1, %2" : "=v"(r) : "v"(lo), "v"(hi)); return r; }
template <class Epi, class Sched, bool ALIGN_EPI = false, bool SP2 = false>
__device__ __forceinline__ void gemm_phase(PG8_LAS unsigned char* lds, const Gemm g, const Sched& S, const Epi& E, const int tid) {
    const int wid = __builtin_amdgcn_readfirstlane(tid >> 6), lane = tid & 63, wr = wid >> 2, wc = wid & 3, fr = lane & 15, fq = lane >> 4;
    const int K = g.K, nt = K / BK;
    unsigned voffA[2], voffB[2];
#pragma unroll
    for (int i = 0; i < 2; ++i) { int R, C; stage_rc(tid * 16 + i * 8192, R, C); const int Rb = Epi::PERM ? ((R & ~31) + perm32(R & 31)) : R;
        voffA[i] = (unsigned)(R * K + C) * 2u; voffB[i] = (unsigned)(Rb * K + C) * 2u; }
    const size_t kstep = (size_t)(BK * 2);
    const size_t hstep = (size_t)HALF * K * 2;
    const size_t tstep = 2 * hstep;
    const unsigned ldsw = (unsigned)wid * 1024u;
    const int aoff = lds_byte(wr * 64 + fr, fq * 8), boff = lds_byte(wc * 32 + fr, fq * 8);
#define PG8_SA(b, h) (((b) * 2 + (h)) * HTB)
#define PG8_SB(b, h) ((4 + (b) * 2 + (h)) * HTB)
#define PG8_STAGE(bufoff, gbase, voff) do { _Pragma("unroll") for (int _i = 0; _i < 2; ++_i) \
        __builtin_amdgcn_global_load_lds((const unsigned*)((const char*)(gbase) + (voff)[_i]), (PG8_LAS unsigned*)(lds + (bufoff) + ldsw + _i * 8192), 16, 0, 0); } while (0)
#define PG8_LDA(dst, b, h) do { _Pragma("unroll") for (int m = 0; m < 4; ++m) _Pragma("unroll") for (int k = 0; k < 2; ++k) dst[m][k] = *(const PG8_LAS bf16x8*)(lds + PG8_SA(b, h) + aoff + m * 2048 + k * 1024); } while (0)
#define PG8_LDB(dst, b, h) do { _Pragma("unroll") for (int n = 0; n < 2; ++n) _Pragma("unroll") for (int k = 0; k < 2; ++k) dst[n][k] = *(const PG8_LAS bf16x8*)(lds + PG8_SB(b, h) + boff + n * 2048 + k * 1024); } while (0)
#define PG8_MMA(ai, bj, At, Bt) do { __builtin_amdgcn_s_setprio(1); _Pragma("unroll") for (int m = 0; m < 4; ++m) _Pragma("unroll") for (int n = 0; n < 2; ++n) _Pragma("unroll") for (int k = 0; k < 2; ++k) \
        acc[ai][bj][m][n] = __builtin_amdgcn_mfma_f32_16x16x32_bf16(Bt[n][k], At[m][k], acc[ai][bj][m][n], 0, 0, 0); __builtin_amdgcn_s_setprio(0); } while (0)
#define PG8_WAIT_V(n) asm volatile("s_waitcnt vmcnt(" #n ")" ::: "memory")
#define PG8_WAIT_L(n) asm volatile("s_waitcnt lgkmcnt(" #n ")" ::: "memory")
#define PG8_BAR __builtin_amdgcn_s_barrier()
#define PG8_SCHED __builtin_amdgcn_sched_barrier(0)
    Unit cur, nxt; int ui = 0;
    if (!S.next(0, cur)) return;
    f32x4 acc[2][2][4][2];
#pragma unroll
    for (int a = 0; a < 2; ++a)
#pragma unroll
        for (int b = 0; b < 2; ++b)
#pragma unroll
            for (int m = 0; m < 4; ++m)
#pragma unroll
                for (int n = 0; n < 2; ++n) acc[a][b][m][n] = (f32x4){0.f, 0.f, 0.f, 0.f};
    bf16x8 At[4][2], B0[2][2], B1[2][2];
    const char* cA = (const char*)g.A + (size_t)cur.pm * tstep; const char* cB = (const char*)g.Bt + (size_t)cur.pn * tstep;
    S.a_ready(cur);
    if constexpr (SP2) {
        PG8_STAGE(PG8_SB(0, 0), cB, voffB); PG8_STAGE(PG8_SB(0, 1), cB + hstep, voffB); PG8_STAGE(PG8_SA(0, 0), cA, voffA); PG8_STAGE(PG8_SA(0, 1), cA + hstep, voffA);
        if (wr == 1) PG8_BAR;
        PG8_WAIT_V(2); PG8_BAR;
        PG8_STAGE(PG8_SB(1, 0), cB + kstep, voffB); PG8_STAGE(PG8_SA(1, 0), cA + kstep, voffA); PG8_STAGE(PG8_SB(1, 1), cB + hstep + kstep, voffB);
        PG8_WAIT_V(6); PG8_BAR;
    } else {
        PG8_STAGE(PG8_SB(0, 0), cB, voffB); PG8_STAGE(PG8_SA(0, 0), cA, voffA); PG8_STAGE(PG8_SB(0, 1), cB + hstep, voffB); PG8_STAGE(PG8_SA(0, 1), cA + hstep, voffA);
        if (wr == 1) PG8_BAR;
        PG8_WAIT_V(4); PG8_BAR;
        PG8_STAGE(PG8_SB(1, 0), cB + kstep, voffB); PG8_STAGE(PG8_SA(1, 0), cA + kstep, voffA); PG8_STAGE(PG8_SB(1, 1), cB + hstep + kstep, voffB);
        PG8_WAIT_V(6); PG8_BAR;
    }
    for (;;) {
        const bool has_next = S.next(ui + 1, nxt);
        const char* nA = has_next ? (const char*)g.A + (size_t)nxt.pm * tstep : cA; const char* nB = has_next ? (const char*)g.Bt + (size_t)nxt.pn * tstep : cB;
        for (int t = 0; t < nt; t += 2) {
            const bool last = (t == nt - 2);
            const char* a1 = cA + (size_t)(t + 1) * kstep;
            const char* a2 = last ? nA : cA + (size_t)(t + 2) * kstep; const char* b2 = last ? nB : cB + (size_t)(t + 2) * kstep;
            const char* a3 = a2 + kstep; const char* b3 = b2 + kstep;
            if (last && has_next) S.a_ready(nxt);
            if constexpr (SP2) {
            PG8_LDB(B0, 0, 0); PG8_LDB(B1, 0, 1); PG8_SCHED; PG8_LDA(At, 0, 0); PG8_STAGE(PG8_SA(1, 1), a1 + hstep, voffA);
            PG8_WAIT_V(8); PG8_WAIT_L(0); PG8_BAR; PG8_MMA(0, 0, At, B0); PG8_MMA(0, 1, At, B1); PG8_BAR; PG8_SCHED;
            PG8_LDA(At, 0, 1); PG8_STAGE(PG8_SB(0, 0), b2, voffB); PG8_STAGE(PG8_SB(0, 1), b2 + hstep, voffB); PG8_STAGE(PG8_SA(0, 0), a2, voffA);
            PG8_WAIT_V(8); PG8_WAIT_L(0); PG8_BAR; PG8_MMA(1, 0, At, B0); PG8_MMA(1, 1, At, B1); PG8_BAR; PG8_SCHED;
            PG8_LDB(B0, 1, 0); PG8_LDB(B1, 1, 1); PG8_SCHED; PG8_LDA(At, 1, 0); PG8_STAGE(PG8_SA(0, 1), a2 + hstep, voffA);
            PG8_WAIT_V(8); PG8_WAIT_L(0); PG8_BAR; PG8_MMA(0, 0, At, B0); PG8_MMA(0, 1, At, B1); PG8_BAR; PG8_SCHED;
            PG8_LDA(At, 1, 1); PG8_STAGE(PG8_SB(1, 0), b3, voffB); PG8_STAGE(PG8_SB(1, 1), b3 + hstep, voffB); PG8_STAGE(PG8_SA(1, 0), a3, voffA);
            PG8_WAIT_V(8); PG8_WAIT_L(0); PG8_BAR; PG8_MMA(1, 0, At, B0); PG8_MMA(1, 1, At, B1); PG8_BAR; PG8_SCHED;
            } else {
            PG8_LDB(B0, 0, 0); PG8_SCHED; PG8_LDA(At, 0, 0); PG8_STAGE(PG8_SA(1, 1), a1 + hstep, voffA);
            PG8_WAIT_L(8); PG8_BAR; PG8_WAIT_L(0); PG8_MMA(0, 0, At, B0); PG8_BAR; PG8_SCHED;
            PG8_LDB(B1, 0, 1); PG8_STAGE(PG8_SB(0, 0), b2, voffB);
            PG8_BAR; PG8_WAIT_L(0); PG8_MMA(0, 1, At, B1); PG8_BAR;
            PG8_LDA(At, 0, 1); PG8_STAGE(PG8_SA(0, 0), a2, voffA);
            PG8_BAR; PG8_WAIT_L(0); PG8_MMA(1, 0, At, B0); PG8_BAR; PG8_SCHED;
            PG8_STAGE(PG8_SB(0, 1), b2 + hstep, voffB);
            PG8_WAIT_V(6); PG8_BAR; PG8_MMA(1, 1, At, B1); PG8_BAR;
            PG8_LDB(B0, 1, 0); PG8_SCHED; PG8_LDA(At, 1, 0); PG8_STAGE(PG8_SA(0, 1), a2 + hstep, voffA);
            PG8_WAIT_L(8); PG8_BAR; PG8_WAIT_L(0); PG8_MMA(0, 0, At, B0); PG8_BAR; PG8_SCHED;
            PG8_LDB(B1, 1, 1); PG8_STAGE(PG8_SB(1, 0), b3, voffB);
            PG8_BAR; PG8_WAIT_L(0); PG8_MMA(0, 1, At, B1); PG8_BAR;
            PG8_LDA(At, 1, 1); PG8_STAGE(PG8_SA(1, 0), a3, voffA);
            PG8_BAR; PG8_WAIT_L(0); PG8_MMA(1, 0, At, B0); PG8_BAR; PG8_SCHED;
            PG8_STAGE(PG8_SB(1, 1), b3 + hstep, voffB);
            PG8_WAIT_V(6); PG8_BAR; PG8_MMA(1, 1, At, B1); PG8_BAR;
            }
        }
        if constexpr (ALIGN_EPI) { if (wr == 0) PG8_BAR; }
        if constexpr (!Epi::AFTER_DRAIN) { E(acc, cur, wr, wc, fr, fq); S.done(cur); }
        if (!has_next) break;
#pragma unroll
        for (int a = 0; a < 2; ++a)
#pragma unroll
            for (int b = 0; b < 2; ++b)
#pragma unroll
                for (int m = 0; m < 4; ++m)
#pragma unroll
                    for (int n = 0; n < 2; ++n) acc[a][b][m][n] = (f32x4){0.f, 0.f, 0.f, 0.f};
        cur = nxt; cA = nA; cB = nB; ++ui;
        if constexpr (ALIGN_EPI) { if (wr == 1) PG8_BAR; }
    }
    PG8_WAIT_V(0);
    if constexpr (!ALIGN_EPI) { if (wr == 0) PG8_BAR; }
    PG8_BAR;
    if constexpr (Epi::AFTER_DRAIN) { E.fused(acc, cur, wr, wc, fr, fq, lds, wid, lane); S.done(cur); }
#undef PG8_SA
#undef PG8_SB
#undef PG8_STAGE
#undef PG8_LDA
#undef PG8_LDB
#undef PG8_MMA
#undef PG8_WAIT_V
#undef PG8_WAIT_L
#undef PG8_BAR
#undef PG8_SCHED
}
}
using pg8::bf16_t; using pg8::bf16x8; using pg8::f32x4; using pg8::u32x4; using pg8::cvt_pk_bf16;
#define LAS __attribute__((address_space(3)))
typedef short s16x4 __attribute__((ext_vector_type(4)));
typedef float f32x16 __attribute__((ext_vector_type(16)));
typedef unsigned u32x2 __attribute__((ext_vector_type(2)));
#define MFMA32(a, b, c) __builtin_amdgcn_mfma_f32_32x32x16_bf16((a), (b), (c), 0, 0, 0)

constexpr int DM = 2048, NB = 8, SEQ = 4096, NTOK = NB * SEQ, NMEM = 256, NLAYER = 4;
constexpr int NZ0 = 5632, NZ1 = 7424, NZ2 = 7168, NSRC1 = 7180;
constexpr float LOG2E = 1.4426950408889634f;
constexpr float EPS = 1e-6f;
constexpr size_t MiB = 1u << 20;
constexpr size_t WS_WIN0 = 0, WS_WIN1 = 22 * MiB, WS_WIN2 = 51 * MiB, WS_WIN3 = 79 * MiB, WS_WOUT = 101 * MiB, WS_WKV = 133 * MiB, WS_MEMN = 149 * MiB,
                 WS_KVM = 157 * MiB, WS_LS = 173 * MiB, WS_SSQ = 175 * MiB, WS_GT = 176 * MiB, WS_HB = 177 * MiB, WS_BR = 305 * MiB, WS_Z = 433 * MiB, WS_END = 897 * MiB;
constexpr int LDS_MISC = 131072;
constexpr int LDS_PART = 131072;
constexpr int LDS_BYTES = 131072 + 8192 + 4096;

struct Params {
    const float *x, *mem, *mem_norm_g, *rel_bias, *norm_g, *w_mem_kv, *mem_q_norm_g, *mem_k_norm_g, *w_out, *a_w_in, *a_ln_g, *a_ln_b, *a_w_s, *a_b_s,
                *b_w_in, *b_b_f, *b_q_norm_g, *b_k_norm_g, *c_w_in, *c_q_norm_g, *c_k_norm_g, *c_lam, *c_subln_g;
    float* out; unsigned char* ws; int ph_lo, ph_hi;
};

__device__ __forceinline__ unsigned off_b(unsigned row, unsigned ch) { return 256u * row + 16u * (ch ^ (((row & 3u) << 2) | ((row >> 2) & 3u))); }
__device__ __forceinline__ float bf2f(unsigned short v) { return __uint_as_float(((unsigned)v) << 16); }
__device__ __forceinline__ float bflo(unsigned w) { return __uint_as_float(w << 16); }
__device__ __forceinline__ float bfhi(unsigned w) { return __uint_as_float(w & 0xffff0000u); }
__device__ __forceinline__ unsigned f2bf(float f) { unsigned u = __float_as_uint(f); return (u + 0x7fffu + ((u >> 16) & 1u)) >> 16; }
typedef float f32x2v __attribute__((ext_vector_type(2)));
typedef __bf16 bf16x2v __attribute__((ext_vector_type(2)));
__device__ __forceinline__ unsigned pk2(float lo, float hi) { const f32x2v v = {lo, hi}; return __builtin_bit_cast(unsigned, __builtin_convertvector(v, bf16x2v)); }
__device__ __forceinline__ float fast_exp2(float x) { return __builtin_amdgcn_exp2f(x); }
__device__ __forceinline__ float fast_rcp(float x) { return __builtin_amdgcn_rcpf(x); }
__device__ __forceinline__ float silu_f(float g) { return g * fast_rcp(1.f + fast_exp2(-g * LOG2E)); }
__device__ __forceinline__ float gelu_tanh_f(float x) { const float u = 0.7978845608028654f * (x + 0.044715f * x * x * x); return x * fast_rcp(1.f + fast_exp2(-2.f * LOG2E * u)); }
__device__ __forceinline__ float wave_sum(float v) {
#pragma unroll
    for (int o = 1; o < 64; o <<= 1) v += __shfl_xor(v, o);
    return v;
}

struct EpiZ {
    static constexpr bool PERM = true, AFTER_DRAIN = false;
    unsigned char* ws; LAS float* part; int ldc; int kind; int L;
    __device__ __forceinline__ void operator()(const f32x4 (&acc)[2][2][4][2], const pg8::Unit& u, int wr, int wc, int fr, int fq) const {
        asm volatile("" : "+v"(fr), "+v"(fq));
        const int lrow0 = wr * 64 + fr, row0 = u.pm * 256 + lrow0, colt = u.pn * 256, pn = u.pn;
        bf16_t* const Z = (bf16_t*)(ws + (kind == 3 ? WS_KVM : WS_Z)); float* const LS = (float*)(ws + WS_LS);
        const float* const ssq = (kind == 3) ? nullptr : (const float*)(ws + WS_SSQ) + (size_t)L * NTOK;
        const float* const gt = (const float*)(ws + WS_GT);
        const float* const bfp = gt + 2048; const float* const gq = gt + 384 * L; const float* const gk = gq + 128; const float* const gm = (kind == 3) ? gt + 1536 : gq + 256;
        if (kind == 1 && pn == 28) {
            if (wc == 0) {
#pragma unroll
                for (int ai = 0; ai < 2; ++ai)
#pragma unroll
                    for (int m = 0; m < 4; ++m) { const int row = row0 + ai * 128 + m * 16;
#pragma unroll
                        for (int n = 0; n < 2; ++n)
#pragma unroll
                            for (int j = 0; j < 4; ++j) { const int col = 8 * fq + 4 * n + j;
                                if (col < 12) { const float xv = acc[ai][0][m][n][j] * rsqrtf(ssq[row] * (1.f / DM) + EPS) + bfp[col]; LS[((size_t)(row >> 12) * 12 + col) * SEQ + (row & (SEQ - 1))] = fminf(xv, 0.f) - log1pf(expf(-fabsf(xv))); } } }
            }
            return;
        }
        int W = 0; const float* g = nullptr;
        if (kind == 0) { if (pn == 12 || pn == 13) { W = 128; g = gm; } }
        else if (kind == 3) { if ((pn & 3) < 2) { W = 128; g = gm + (pn >> 2) * 128; } }
        else { if (pn < 6) { W = (kind == 1) ? 128 : 64; g = gq; } else if (pn < 12) { W = (kind == 1) ? 128 : 64; g = gk; } else if (pn == 18 || pn == 19) { W = 128; g = gm; } }
        const bool act = (kind == 0) && (pn < 12);
        f32x4 g0 = (f32x4){1.f, 1.f, 1.f, 1.f}, g1 = g0;
        if (W) {
#pragma unroll
            for (int ai = 0; ai < 2; ++ai)
#pragma unroll
                for (int m = 0; m < 4; ++m)
#pragma unroll
                    for (int bj = 0; bj < 2; ++bj) { const f32x4 a0 = acc[ai][bj][m][0], a1 = acc[ai][bj][m][1];
                        float ss = (a0[0] * a0[0] + a0[1] * a0[1]) + (a0[2] * a0[2] + a0[3] * a0[3]) + (a1[0] * a1[0] + a1[1] * a1[1]) + (a1[2] * a1[2] + a1[3] * a1[3]);
                        ss += __shfl_xor(ss, 16); ss += __shfl_xor(ss, 32);
                        if (fq == 0) part[(lrow0 + ai * 128 + m * 16) * 8 + bj * 4 + wc] = ss; }
            asm volatile("s_waitcnt lgkmcnt(0)" ::: "memory"); __builtin_amdgcn_s_barrier(); asm volatile("" ::: "memory");
            const float* gp = g + ((32 * wc + 8 * fq) & (W - 1));
            g0 = *(const f32x4*)gp; g1 = *(const f32x4*)(gp + 4);
        }
        const float invW = W ? 1.f / (float)W : 0.f;
        const int col0 = colt + wc * 32 + 8 * fq;
#pragma unroll
        for (int ai = 0; ai < 2; ++ai) {
            float rsv[4];
#pragma unroll
            for (int m = 0; m < 4; ++m) rsv[m] = ssq ? rsqrtf(ssq[row0 + ai * 128 + m * 16] * (1.f / DM) + EPS) : 1.f;
#pragma unroll
            for (int m = 0; m < 4; ++m) { bf16_t* rowp = Z + (size_t)(row0 + ai * 128 + m * 16) * ldc + col0;
                const float rs = rsv[m];
#pragma unroll
                for (int bj = 0; bj < 2; ++bj) { float mm = rs;
                    if (W) { const f32x4 pp = *(const LAS f32x4*)(part + (lrow0 + ai * 128 + m * 16) * 8 + bj * 4);
                        const float tot = (W == 128) ? ((pp[0] + pp[1]) + (pp[2] + pp[3])) : (wc < 2 ? pp[0] + pp[1] : pp[2] + pp[3]);
                        mm = rs * rsqrtf(tot * rs * rs * invW + EPS); }
                    f32x4 v0 = acc[ai][bj][m][0] * mm * g0, v1 = acc[ai][bj][m][1] * mm * g1;
                    if (act) {
#pragma unroll
                        for (int j = 0; j < 4; ++j) { v0[j] = gelu_tanh_f(v0[j]); v1[j] = gelu_tanh_f(v1[j]); } }
                    u32x4 w; w.x = cvt_pk_bf16(v0[0], v0[1]); w.y = cvt_pk_bf16(v0[2], v0[3]); w.z = cvt_pk_bf16(v1[0], v1[1]); w.w = cvt_pk_bf16(v1[2], v1[3]);
                    *(u32x4*)(rowp + bj * 128) = w; } } }
    }
};
struct EpiOut {
    static constexpr bool PERM = false, AFTER_DRAIN = false;
    const float* Xin; float* Out; bf16_t* HBo; float* ssq;
    __device__ __forceinline__ void operator()(const f32x4 (&acc)[2][2][4][2], const pg8::Unit& u, int wr, int wc, int fr, int fq) const {
        asm volatile("" : "+v"(fr), "+v"(fq));
        const int row0 = u.pm * 256 + wr * 64 + fr, col0 = u.pn * 256 + wc * 32 + 4 * fq;
        f32x4 xr[3][4];
#define EO_LOAD(rr, slot) do { const size_t o_ = (size_t)(row0 + ((rr) >> 2) * 128 + ((rr) & 3) * 16) * DM + col0; _Pragma("unroll") for (int q_ = 0; q_ < 4; ++q_) xr[slot][q_] = *(const f32x4*)(Xin + o_ + (q_ >> 1) * 128 + (q_ & 1) * 16); } while (0)
        EO_LOAD(0, 0); EO_LOAD(1, 1);
#pragma unroll
        for (int rr = 0; rr < 8; ++rr) { const int ai = rr >> 2, m = rr & 3, row = row0 + ai * 128 + m * 16; const size_t o = (size_t)row * DM + col0; float s = 0.f;
            if (rr + 2 < 8) EO_LOAD(rr + 2, (rr + 2) % 3);
#pragma unroll
            for (int q = 0; q < 4; ++q) { const int bj = q >> 1, n = q & 1; const size_t idx = o + bj * 128 + n * 16; const f32x4 v = xr[rr % 3][q] + acc[ai][bj][m][n]; *(f32x4*)(Out + idx) = v;
                if (ssq) { u32x2 w; w.x = cvt_pk_bf16(v[0], v[1]); w.y = cvt_pk_bf16(v[2], v[3]); *(u32x2*)(HBo + idx) = w; s += (v[0] * v[0] + v[1] * v[1]) + (v[2] * v[2] + v[3] * v[3]); } }
            if (ssq) { s += __shfl_xor(s, 16); s += __shfl_xor(s, 32); if (fq == 0) atomicAdd(ssq + row, s); } }
#undef EO_LOAD
    }
};
#ifndef AT_KD
#define AT_KD 4
#endif
#ifndef AT_VD
#define AT_VD 3
#endif
struct AttnArgs {
    const bf16_t *Q, *K, *V, *G; bf16_t* O;
    int ldq, ldkv, ldg, ldo, q0, ntiles;
    const float* c;
    const float* lutsrc;
    const float* subg;
    float sc, lam, outmul, m2;
};
constexpr int A_CS = 65536, A_LUT = 65536 + 16384;

template <int MODE>
__device__ __forceinline__ void attn_item(LAS unsigned char* lds, const AttnArgs& a, const int tid) {
    const int wave = __builtin_amdgcn_readfirstlane(tid >> 6), lane = tid & 63, r = lane & 31, h = lane >> 5;
    constexpr int NKS = (MODE == 2) ? 4 : 8;
    const int map = (MODE == 2) ? (wave >> 2) : 0;
    const int qw0 = a.q0 + 32 * ((MODE == 2) ? (wave & 3) : wave);
    const int tw = (MODE == 0) ? (a.ntiles - 1) : (MODE == 1 ? ((qw0 + 31) >> 6) : (qw0 >> 6));
    __syncthreads();
    if (MODE == 2) {
        if (tid < 255) { const int rel = tid - 191; const int n = rel < 0 ? -rel : rel; int bkt;
            if (n < 8) bkt = n; else { const float nf = (float)n; int lg = 8 + (int)(logf(nf / 8.0f) / 2.772588722239781f * 8.0f); bkt = lg < 15 ? lg : 15; }
            if (rel > 0) bkt += 16;
            ((LAS float*)(lds + A_LUT))[tid] = a.lutsrc[bkt * 12] * LOG2E - a.m2; }
    }
    bf16x8 qf[NKS];
    { const bf16_t* qrow = a.Q + (size_t)(qw0 + r) * a.ldq + map * 64 + 8 * h;
#pragma unroll
      for (int ks = 0; ks < NKS; ++ks) qf[ks] = *(const bf16x8*)(qrow + 16 * ks); }
    if (MODE == 1) {
        LAS float* cl = (LAS float*)(lds + A_CS); LAS float* wtot = (LAS float*)(lds + A_LUT);
        const int n = a.q0 + 256; const bool on = 8 * tid < n;
        float v[8]; float run = 0.f;
        const float* lp = a.c + 8 * tid;
        f32x4 x0 = {0.f, 0.f, 0.f, 0.f}, x1 = x0; if (on) { x0 = *(const f32x4*)lp; x1 = *(const f32x4*)(lp + 4); }
#pragma unroll
        for (int e = 0; e < 8; ++e) { run += (e < 4) ? x0[e & 3] : x1[e & 3]; v[e] = run; }
        float incl = run;
#pragma unroll
        for (int o = 1; o < 64; o <<= 1) { const float x = __shfl_up(incl, o); if (lane >= o) incl += x; }
        if (lane == 63) wtot[wave] = incl;
        __syncthreads();
        float pre = incl - run;
        for (int w = 0; w < wave; ++w) pre += wtot[w];
        if (on) {
#pragma unroll
            for (int e = 0; e < 8; ++e) cl[8 * tid + e] = -(pre + v[e]) * LOG2E; }
    }
    unsigned kaddr[NKS];
    { const unsigned X = ((r & 3u) << 2) | ((r >> 2) & 3u);
#pragma unroll
      for (int ks = 0; ks < NKS; ++ks) kaddr[ks] = 256u * r + 16u * ((unsigned)(2 * (map * 4 + ks) + h) ^ X); }
    unsigned vaddr[4][2];
    { const unsigned q = (lane & 15) >> 2, p = lane & 3, blk = (lane >> 4) & 1;
#pragma unroll
      for (int dt = 0; dt < 4; ++dt)
#pragma unroll
          for (int t2 = 0; t2 < 2; ++t2) vaddr[dt][t2] = 16384u + off_b(8 * t2 + 4 * h + q, 4 * dt + 2 * blk + (p >> 1)) + 8u * (p & 1); }
    const unsigned sX = ((unsigned)(lane >> 4) << 2) | (unsigned)(wave & 3);
    const size_t sgoff = (size_t)(4 * wave + (lane >> 4)) * a.ldkv + (size_t)(((unsigned)(lane & 15) ^ sX) * 8u);
    const bf16_t* kg = a.K + sgoff; const bf16_t* vg = a.V + sgoff;
    const size_t tstep = (size_t)64 * a.ldkv, hstep = (size_t)32 * a.ldkv;
#define AT_DMA1(gp, la) asm volatile("s_mov_b32 m0, %1\n\ts_nop 0\n\tglobal_load_lds_dwordx4 %0, off" :: "v"(gp), "s"(la) : "memory", "m0")
#define AT_DMA(t, b) do { const bf16_t* kp = kg + (size_t)(t) * tstep; const bf16_t* vp = vg + (size_t)(t) * tstep; const unsigned la = (unsigned)(size_t)(lds + (b) * 32768 + wave * 1024); \
        AT_DMA1(kp, la); AT_DMA1(kp + hstep, la + 8192u); AT_DMA1(vp, la + 16384u); AT_DMA1(vp + hstep, la + 16384u + 8192u); } while (0)
    float l = 0.f;
    f32x16 o[4];
#pragma unroll
    for (int dt = 0; dt < 4; ++dt)
#pragma unroll
        for (int i = 0; i < 16; ++i) o[dt][i] = 0.f;
    AT_DMA(0, 0);
    asm volatile("s_waitcnt vmcnt(0)" ::: "memory");
    __syncthreads();
#pragma unroll
    for (int ks = 0; ks < NKS; ++ks) asm volatile("" : "+v"(qf[ks]));
    float b15 = 0.f; if (MODE == 2) b15 = ((LAS float*)(lds + A_LUT))[0];
    float addc = -a.m2; if (MODE == 1) addc = -((LAS float*)(lds + A_CS))[qw0 + r] - a.m2; if (MODE == 2) addc = b15;
    const int nt = a.ntiles;
    for (int tt2 = 0; tt2 < nt; tt2 += 2)
#pragma unroll
    for (int bb = 0; bb < 2; ++bb) {
        const int t = tt2 + bb;
        constexpr int dummy_ = 0; (void)dummy_;
        const int b = bb;
        if (t + 1 < nt) AT_DMA(t + 1, b ^ 1);
        if (t <= tw) {
            LAS unsigned char* kb = lds + b * 32768;
            f32x16 s[2];
#pragma unroll
            for (int i = 0; i < 16; ++i) { s[0][i] = 0.f; s[1][i] = 0.f; }
            constexpr int KD = AT_KD, VD = AT_VD;
            bf16x8 kf[KD];
#define AT_KLD(i) (*(LAS bf16x8*)(kb + kaddr[(i) >> 1] + ((i) & 1) * 8192))
#pragma unroll
            for (int i = 0; i < KD; ++i) kf[i] = AT_KLD(i);
#pragma unroll
            for (int i = 0; i < 2 * NKS; ++i) { s[i & 1] = MFMA32(kf[i % KD], qf[i >> 1], s[i & 1]); if (i + KD < 2 * NKS) kf[i % KD] = AT_KLD(i + KD); }
#undef AT_KLD
            bf16x8 vf[VD];
#define AT_VLD(j) do { const s16x4 lo_ = __builtin_amdgcn_ds_read_tr16_b64_v4i16((LAS s16x4*)(kb + vaddr[(j) & 3][0] + (32 * ((j) >> 3) + 16 * (((j) >> 2) & 1)) * 256)); \
                const s16x4 hi_ = __builtin_amdgcn_ds_read_tr16_b64_v4i16((LAS s16x4*)(kb + vaddr[(j) & 3][1] + (32 * ((j) >> 3) + 16 * (((j) >> 2) & 1)) * 256)); \
                vf[(j) % VD] = __builtin_shufflevector(lo_, hi_, 0, 1, 2, 3, 4, 5, 6, 7); } while (0)
#pragma unroll
            for (int j = 0; j < VD; ++j) AT_VLD(j);
            const float sc = a.sc;
            const bool diag = (MODE == 1) && (t * 64 + 63 > qw0);
            const bool near = (MODE == 2) && (t >= tw - 2);
            bf16x8 pf[2];
#pragma unroll
            for (int kt = 0; kt < 2; ++kt) {
                if (MODE == 1) {
                    const LAS float* csb = (const LAS float*)(lds + A_CS) + t * 64 + 32 * kt + 4 * h;
                    const int mb = t * 64 + 32 * kt + 4 * h - (qw0 + r);
#pragma unroll
                    for (int g = 0; g < 4; ++g) { const f32x4 cv = *(const LAS f32x4*)(csb + 8 * g);
#pragma unroll
                        for (int e = 0; e < 4; ++e) { float x = fmaf(s[kt][4 * g + e], sc, addc) + cv[e]; if (diag && (mb + 8 * g + e > 0)) x = -1e30f; s[kt][4 * g + e] = x; } }
                } else if (MODE == 2) {
                    if (near) {
                        const LAS float* lut = (const LAS float*)(lds + A_LUT) + (t * 64 + 32 * kt + 4 * h - (qw0 + r) + 191);
#pragma unroll
                        for (int i = 0; i < 16; ++i) s[kt][i] = fmaf(s[kt][i], sc, lut[8 * (i >> 2) + (i & 3)]);
                    } else {
#pragma unroll
                        for (int i = 0; i < 16; ++i) s[kt][i] = fmaf(s[kt][i], sc, addc);
                    }
                } else {
#pragma unroll
                    for (int i = 0; i < 16; ++i) s[kt][i] = fmaf(s[kt][i], sc, addc);
                }
                float ls = 0.f;
#pragma unroll
                for (int i = 0; i < 16; ++i) { const float pv = fast_exp2(s[kt][i]); s[kt][i] = pv; ls += pv; }
                l += ls;
#pragma unroll
                for (int ss = 0; ss < 2; ++ss) { u32x4 w;
                    w.x = pk2(s[kt][8 * ss + 0], s[kt][8 * ss + 1]); w.y = pk2(s[kt][8 * ss + 2], s[kt][8 * ss + 3]);
                    w.z = pk2(s[kt][8 * ss + 4], s[kt][8 * ss + 5]); w.w = pk2(s[kt][8 * ss + 6], s[kt][8 * ss + 7]);
                    pf[ss] = __builtin_bit_cast(bf16x8, w); }
#pragma unroll
                for (int jj = 0; jj < 8; ++jj) { const int j = 8 * kt + jj;
                    o[jj & 3] = MFMA32(vf[j % VD], pf[jj >> 2], o[jj & 3]);
                    if (j + VD < 16) AT_VLD(j + VD); }
            }
#undef AT_VLD
        }
        asm volatile("s_waitcnt vmcnt(0)" ::: "memory");
        __syncthreads();
    }
#undef AT_DMA
#undef AT_DMA1
    l += __shfl_xor(l, 32);
    const float inv = 1.f / l;
    const size_t qrow = (size_t)(qw0 + r);
    if (MODE != 2) {
        int ch = tid & 15, r0 = tid >> 4, lrow = 32 * wave + r, hh = h;
        asm volatile("" : "+v"(ch), "+v"(r0), "+v"(lrow), "+v"(hh));
#pragma unroll 1
        for (int i0 = 0; i0 < 8; i0 += 4) { u32x4 gv[4];
#pragma unroll
          for (int i = 0; i < 4; ++i) gv[i] = *(const u32x4*)(a.G + (size_t)(a.q0 + r0 + 32 * (i0 + i)) * a.ldg + 8 * ch);
#pragma unroll
          for (int i = 0; i < 4; ++i) *(LAS u32x4*)(lds + off_b(r0 + 32 * (i0 + i), ch)) = gv[i]; }
        __syncthreads();
#pragma unroll
        for (int dt = 0; dt < 4; ++dt)
#pragma unroll
            for (int g = 0; g < 4; ++g) { const unsigned ad = off_b(lrow, 4 * dt + g) + 8u * hh;
                const u32x2 gw = *(const LAS u32x2*)(lds + ad);
                const float v0 = o[dt][4 * g + 0] * inv * silu_f(bflo(gw.x)), v1 = o[dt][4 * g + 1] * inv * silu_f(bfhi(gw.x));
                const float v2 = o[dt][4 * g + 2] * inv * silu_f(bflo(gw.y)), v3 = o[dt][4 * g + 3] * inv * silu_f(bfhi(gw.y));
                u32x2 w; w.x = pk2(v0, v1); w.y = pk2(v2, v3);
                *(LAS u32x2*)(lds + ad) = w; }
        __syncthreads();
#pragma unroll 4
        for (int i = 0; i < 8; ++i) { const u32x4 ov = *(const LAS u32x4*)(lds + off_b(r0 + 32 * i, ch)); *(u32x4*)(a.O + (size_t)(a.q0 + r0 + 32 * i) * a.ldo + 8 * ch) = ov; }
    } else {
        LAS float* xb = (LAS float*)(lds + (wave & 3) * 16384);
        int ch = tid & 15, r0 = tid >> 4, lrow = 32 * (wave & 3) + r, hh = h;
        asm volatile("" : "+v"(ch), "+v"(r0), "+v"(lrow), "+v"(hh));
        { u32x4 gv[4];
#pragma unroll
          for (int i = 0; i < 4; ++i) gv[i] = *(const u32x4*)(a.G + (size_t)(a.q0 + r0 + 32 * i) * a.ldg + 8 * ch);
#pragma unroll
          for (int i = 0; i < 4; ++i) *(LAS u32x4*)(lds + 98304 + off_b(r0 + 32 * i, ch)) = gv[i]; }
        if (map == 1) {
            const float f = inv * a.lam;
#pragma unroll
            for (int dt = 0; dt < 4; ++dt)
#pragma unroll
                for (int i = 0; i < 16; ++i) xb[(dt * 16 + i) * 64 + lane] = o[dt][i] * f;
        }
        __syncthreads();
        if (map == 0) {
            float ssq = 0.f;
#pragma unroll
            for (int dt = 0; dt < 4; ++dt)
#pragma unroll
                for (int i = 0; i < 16; ++i) { const float v = o[dt][i] * inv - xb[(dt * 16 + i) * 64 + lane]; o[dt][i] = v; ssq += v * v; }
            ssq += __shfl_xor(ssq, 32);
            const float rn = rsqrtf(ssq * (1.f / 128.f) + EPS) * a.outmul;
#pragma unroll
            for (int dt = 0; dt < 4; ++dt)
#pragma unroll
                for (int g = 0; g < 4; ++g) { const int dd = 32 * dt + 8 * g + 4 * hh; const unsigned ad = 98304u + off_b(lrow, 4 * dt + g) + 8u * hh;
                    const u32x2 gw = *(const LAS u32x2*)(lds + ad);
                    const f32x4 sg = *(const f32x4*)(a.subg + dd);
                    const float v0 = o[dt][4 * g + 0] * rn * sg[0] * silu_f(bflo(gw.x)), v1 = o[dt][4 * g + 1] * rn * sg[1] * silu_f(bfhi(gw.x));
                    const float v2 = o[dt][4 * g + 2] * rn * sg[2] * silu_f(bflo(gw.y)), v3 = o[dt][4 * g + 3] * rn * sg[3] * silu_f(bfhi(gw.y));
                    u32x2 w; w.x = pk2(v0, v1); w.y = pk2(v2, v3);
                    *(LAS u32x2*)(lds + ad) = w; }
        }
        __syncthreads();
#pragma unroll
        for (int i = 0; i < 4; ++i) { const u32x4 ov = *(const LAS u32x4*)(lds + 98304 + off_b(r0 + 32 * i, ch)); *(u32x4*)(a.O + (size_t)(a.q0 + r0 + 32 * i) * a.ldo + 8 * ch) = ov; }
    }
}
__device__ __forceinline__ void tr_item(const float* W, int N, bf16_t* WT, int item, int lane, LAS float* scr, int fox, const float* gk) {
    const int nblk = (N + 31) >> 5, kb = item / nblk, nb = item - kb * nblk, k0 = 64 * kb, n0 = 32 * nb;
    const int nq = lane & 7, kr = lane >> 3, nc = n0 + 4 * nq;
    f32x4 wv[8];
#pragma unroll
    for (int i = 0; i < 8; ++i) wv[i] = (nc < N) ? *(const f32x4*)(W + (size_t)(k0 + kr + 8 * i) * N + nc) : (f32x4){0.f, 0.f, 0.f, 0.f};
#pragma unroll
    for (int i = 0; i < 8; ++i) { const int kk = kr + 8 * i; const float gg = gk ? gk[k0 + kk] : 1.f;
#pragma unroll
        for (int e2 = 0; e2 < 4; ++e2) scr[kk * 33 + 4 * nq + e2] = wv[i][e2] * gg; }
    asm volatile("s_waitcnt lgkmcnt(0)" ::: "memory");
    const int c = lane & 7;
#pragma unroll
    for (int j = 0; j < 4; ++j) { const int nl = (lane >> 3) + 8 * j, n = n0 + nl; const LAS float* s = scr + (8 * c) * 33 + nl;
        if (n < N) { int nd = n; if (fox) { if (n >= 4620) nd = n - 12; else if (n >= 4608) nd = n - 4608 + 7168; }
            u32x4 o; o.x = pk2(s[0 * 33], s[1 * 33]); o.y = pk2(s[2 * 33], s[3 * 33]); o.z = pk2(s[4 * 33], s[5 * 33]); o.w = pk2(s[6 * 33], s[7 * 33]);
            *(u32x4*)(WT + (size_t)nd * DM + k0 + 8 * c) = o; } }
    asm volatile("s_waitcnt lgkmcnt(0)" ::: "memory");
}
__device__ __forceinline__ void rms_row_to_bf16(const float* xrow, const float* g, bf16_t* orow, int lane) {
    const f32x4* xr = (const f32x4*)xrow + lane; const f32x4* gr = (const f32x4*)g + lane;
    f32x4 v[8]; float s = 0.f;
#pragma unroll
    for (int j = 0; j < 8; ++j) { v[j] = xr[64 * j]; s += (v[j][0] * v[j][0] + v[j][1] * v[j][1]) + (v[j][2] * v[j][2] + v[j][3] * v[j][3]); }
    const float rstd = rsqrtf(wave_sum(s) * (1.f / DM) + EPS);
    u32x2* o8 = (u32x2*)orow + lane;
#pragma unroll
    for (int j = 0; j < 8; ++j) { const f32x4 gg = gr[64 * j]; u32x2 w; w.x = pk2(v[j][0] * rstd * gg[0], v[j][1] * rstd * gg[1]); w.y = pk2(v[j][2] * rstd * gg[2], v[j][3] * rstd * gg[3]); o8[64 * j] = w; }
}
__device__ __forceinline__ void row_to_bf16_ssq(const float* xrow, bf16_t* orow, float* ssq, int lane) {
    const f32x4* xr = (const f32x4*)xrow + lane; u32x2* o8 = (u32x2*)orow + lane; float s = 0.f;
#pragma unroll
    for (int j = 0; j < 8; ++j) { const f32x4 v = xr[64 * j]; s += (v[0] * v[0] + v[1] * v[1]) + (v[2] * v[2] + v[3] * v[3]);
        u32x2 w; w.x = pk2(v[0], v[1]); w.y = pk2(v[2], v[3]); o8[64 * j] = w; }
    s = wave_sum(s);
    if (lane == 0) *ssq = s;
}
template <int W>
__device__ __forceinline__ void seg_norm512(bf16_t* p, const float* g, int lane) {
    u32x4 w = *(const u32x4*)(p + 8 * lane);
    float f[8] = {bflo(w.x), bfhi(w.x), bflo(w.y), bfhi(w.y), bflo(w.z), bfhi(w.z), bflo(w.w), bfhi(w.w)};
    float s = 0.f;
#pragma unroll
    for (int j = 0; j < 8; ++j) s += f[j] * f[j];
#pragma unroll
    for (int o = 1; o < W / 8; o <<= 1) s += __shfl_xor(s, o);
    const float rstd = rsqrtf(s * (1.f / W) + EPS);
    const float* gp = g + ((8 * lane) & (W - 1));
    const f32x4 g0 = *(const f32x4*)gp, g1 = *(const f32x4*)(gp + 4);
    w.x = pk2(f[0] * rstd * g0[0], f[1] * rstd * g0[1]); w.y = pk2(f[2] * rstd * g0[2], f[3] * rstd * g0[3]);
    w.z = pk2(f[4] * rstd * g1[0], f[5] * rstd * g1[1]); w.w = pk2(f[6] * rstd * g1[2], f[7] * rstd * g1[3]);
    *(u32x4*)(p + 8 * lane) = w;
}

__device__ __forceinline__ void gmlp_item(LAS unsigned char* lds, const bf16_t* Zt  , bf16_t* BRt  , const bf16_t* wsb, const float* bs_, const float* lng, const float* lnb, const int tid) {
    const int wave = __builtin_amdgcn_readfirstlane(tid >> 6), lane = tid & 63, r = lane & 31, h = lane >> 5;
    LAS float* st = (LAS float*)(lds + 131072);
    __syncthreads();
    for (int tq = 0; tq < 4; ++tq) {
        u32x4 w[4][3];
#pragma unroll
        for (int u = 0; u < 4; ++u)
#pragma unroll
            for (int c = 0; c < 3; ++c) w[u][c] = *(const u32x4*)(Zt + (size_t)(16 * wave + 4 * tq + u) * NZ0 + 1536 + 8 * (lane + 64 * c));
#pragma unroll
        for (int u = 0; u < 4; ++u) { float s = 0.f, s2 = 0.f;
#pragma unroll
            for (int c = 0; c < 3; ++c) { const float f[8] = {bflo(w[u][c].x), bfhi(w[u][c].x), bflo(w[u][c].y), bfhi(w[u][c].y), bflo(w[u][c].z), bfhi(w[u][c].z), bflo(w[u][c].w), bfhi(w[u][c].w)};
#pragma unroll
                for (int j = 0; j < 8; ++j) { s += f[j]; s2 += f[j] * f[j]; } }
            s = wave_sum(s); s2 = wave_sum(s2);
            const float mean = s * (1.f / 1536.f), var = fmaxf(s2 * (1.f / 1536.f) - mean * mean, 0.f);
            const int tok = 16 * wave + 4 * tq + u;
            if (lane == 0) { st[2 * tok] = mean; st[2 * tok + 1] = rsqrtf(var + EPS); } } }
    __syncthreads();
    const int tt = wave & 3, cp = wave >> 2;
    const unsigned q = (lane & 15) >> 2, p = lane & 3, blk = (lane >> 4) & 1;
    unsigned aaddr[8], baddr[2][2];
#pragma unroll
    for (int ks = 0; ks < 8; ++ks) aaddr[ks] = tt * 8192 + off_b(r, 2 * ks + h);
#pragma unroll
    for (int cc = 0; cc < 2; ++cc)
#pragma unroll
        for (int t2 = 0; t2 < 2; ++t2) baddr[cc][t2] = 32768u + off_b(8 * h + 4 * t2 + q, 4 * (2 * cp + cc) + 2 * blk + (p >> 1)) + 8u * (p & 1);
    u32x4 wb[4], vw[4], uu[4], gg4[4];
#define GM_LOAD(gq) do { const bf16_t* Wq = wsb + (size_t)(gq) * 16384; const int ch_ = tid & 15, t0_ = tid >> 4; _Pragma("unroll") for (int i = 0; i < 4; ++i) { const int t = t0_ + 32 * i; \
        wb[i] = *(const u32x4*)(Wq + t * 128 + 8 * ch_); \
        vw[i] = *(const u32x4*)(Zt + (size_t)t * NZ0 + 1536 + (gq) * 128 + 8 * ch_); \
        uu[i] = *(const u32x4*)(Zt + (size_t)t * NZ0 + (gq) * 128 + 8 * ch_); gg4[i] = *(const u32x4*)(Zt + (size_t)t * NZ0 + 3584 + (gq) * 128 + 8 * ch_); } } while (0)
    for (int g = 0; g < 12; ++g) {
        GM_LOAD(g);
        { const int ch = tid & 15, t0 = tid >> 4;
          if (g > 0) {
#pragma unroll
              for (int i = 0; i < 4; ++i) { const int t = t0 + 32 * i; const u32x4 ov = *(const LAS u32x4*)(lds + 65536 + off_b(t, ch)); *(u32x4*)(BRt + (size_t)t * DM + (g - 1) * 128 + 8 * ch) = ov; } }
          const float* gp = lng + g * 128 + 8 * ch; const float* bp = lnb + g * 128 + 8 * ch;
          const f32x4 g0 = *(const f32x4*)gp, g1 = *(const f32x4*)(gp + 4), b0 = *(const f32x4*)bp, b1 = *(const f32x4*)(bp + 4);
#pragma unroll
          for (int i = 0; i < 4; ++i) { const int t = t0 + 32 * i;
              *(LAS u32x4*)(lds + off_b(t, ch)) = wb[i];
              const float mean = st[2 * t], rstd = st[2 * t + 1];
              u32x4 o;
              o.x = pk2((bflo(vw[i].x) - mean) * rstd * g0[0] + b0[0], (bfhi(vw[i].x) - mean) * rstd * g0[1] + b0[1]);
              o.y = pk2((bflo(vw[i].y) - mean) * rstd * g0[2] + b0[2], (bfhi(vw[i].y) - mean) * rstd * g0[3] + b0[3]);
              o.z = pk2((bflo(vw[i].z) - mean) * rstd * g1[0] + b1[0], (bfhi(vw[i].z) - mean) * rstd * g1[1] + b1[1]);
              o.w = pk2((bflo(vw[i].w) - mean) * rstd * g1[2] + b1[2], (bfhi(vw[i].w) - mean) * rstd * g1[3] + b1[3]);
              *(LAS u32x4*)(lds + 32768 + off_b(t, ch)) = o;
              *(LAS u32x4*)(lds + 65536 + off_b(t, ch)) = uu[i]; *(LAS u32x4*)(lds + 98304 + off_b(t, ch)) = gg4[i]; } }
        __syncthreads();
        f32x16 acc[2];
#pragma unroll
        for (int i = 0; i < 16; ++i) { acc[0][i] = 0.f; acc[1][i] = 0.f; }
#pragma unroll
        for (int ks = 0; ks < 8; ++ks) {
            const bf16x8 af = *(LAS bf16x8*)(lds + aaddr[ks]);
#pragma unroll
            for (int cc = 0; cc < 2; ++cc) {
                const s16x4 lo = __builtin_amdgcn_ds_read_tr16_b64_v4i16((LAS s16x4*)(lds + baddr[cc][0] + ks * 4096));
                const s16x4 hi = __builtin_amdgcn_ds_read_tr16_b64_v4i16((LAS s16x4*)(lds + baddr[cc][1] + ks * 4096));
                const bf16x8 bfv = __builtin_shufflevector(lo, hi, 0, 1, 2, 3, 4, 5, 6, 7);
                acc[cc] = MFMA32(bfv, af, acc[cc]); }
        }
        int r2 = r, h2 = h; asm volatile("" : "+v"(r2), "+v"(h2));
        { const int t = 32 * tt + r2; const float bsv = bs_[g * 128 + t];
#pragma unroll
          for (int k8 = 0; k8 < 8; ++k8) { const int cc = k8 >> 2, q4 = k8 & 3;
              const unsigned ad = off_b(t, 4 * (2 * cp + cc) + q4) + 8u * h2;
              const u32x2 uw = *(const LAS u32x2*)(lds + 65536 + ad), gw = *(const LAS u32x2*)(lds + 98304 + ad);
              const float v0 = bflo(uw.x) * (acc[cc][4 * q4 + 0] + bsv) * silu_f(bflo(gw.x)), v1 = bfhi(uw.x) * (acc[cc][4 * q4 + 1] + bsv) * silu_f(bfhi(gw.x));
              const float v2 = bflo(uw.y) * (acc[cc][4 * q4 + 2] + bsv) * silu_f(bflo(gw.y)), v3 = bfhi(uw.y) * (acc[cc][4 * q4 + 3] + bsv) * silu_f(bfhi(gw.y));
              u32x2 w; w.x = pk2(v0, v1); w.y = pk2(v2, v3);
              *(LAS u32x2*)(lds + 65536 + ad) = w; } }
        __syncthreads();
    }
    { const int ch = tid & 15, t0 = tid >> 4;
#pragma unroll
      for (int i = 0; i < 4; ++i) { const int t = t0 + 32 * i; const u32x4 ov = *(const LAS u32x4*)(lds + 65536 + off_b(t, ch)); *(u32x4*)(BRt + (size_t)t * DM + 11 * 128 + 8 * ch) = ov; } }
}
#undef GM_LOAD
constexpr int NPHASE = 1 + 3 * NLAYER;
#ifndef MK_PER_PHASE
#define MK_PER_PHASE 0
#endif

__device__ __forceinline__ void grid_bar(unsigned* base, unsigned k  , int tid) {
    __syncthreads();
    if (tid == 0) {
        __builtin_amdgcn_fence(__ATOMIC_RELEASE, "agent");
        const unsigned G = gridDim.x, x = blockIdx.x & 7u, gsize = (G - x + 7u) >> 3, ngroups = G < 8u ? G : 8u;
        const unsigned prev = __hip_atomic_fetch_add(base + 64 * (1 + x), 1u, __ATOMIC_RELAXED, __HIP_MEMORY_SCOPE_AGENT);
        if (prev + 1u == k * gsize) __hip_atomic_fetch_add(base, 1u, __ATOMIC_RELAXED, __HIP_MEMORY_SCOPE_AGENT);
        while (__hip_atomic_load(base, __ATOMIC_RELAXED, __HIP_MEMORY_SCOPE_AGENT) < k * ngroups) __builtin_amdgcn_s_sleep(1);
        __builtin_amdgcn_fence(__ATOMIC_ACQUIRE, "agent");
    }
    __syncthreads();
}

__global__ void __launch_bounds__(512) mk_fwd(Params P) {
    extern __shared__ __attribute__((aligned(16))) unsigned char shm[];
    LAS unsigned char* lds = (LAS unsigned char*)shm;
    cg::grid_group grid = cg::this_grid();
    const int G = gridDim.x, NGW = G * 8;
    int redo = 0; (void)redo;
    for (int ph = P.ph_lo; ph < P.ph_hi; ++ph) {
        int tid = threadIdx.x; asm volatile("" : "+v"(tid));
        const int wave = __builtin_amdgcn_readfirstlane(tid >> 6), lane = tid & 63, gw = blockIdx.x * 8 + wave;
        unsigned char* ws = P.ws; asm volatile("" : "+s"(ws));
        bf16_t* const WOUT = (bf16_t*)(ws + WS_WOUT); bf16_t* const WKV = (bf16_t*)(ws + WS_WKV); bf16_t* const MEMN = (bf16_t*)(ws + WS_MEMN);
        bf16_t* const KVM = (bf16_t*)(ws + WS_KVM); float* const LS = (float*)(ws + WS_LS); float* const SSQ = (float*)(ws + WS_SSQ);
        bf16_t* const HB = (bf16_t*)(ws + WS_HB); bf16_t* const BR = (bf16_t*)(ws + WS_BR); bf16_t* const Z = (bf16_t*)(ws + WS_Z);

        if (ph == 0) {
            LAS float* scr = (LAS float*)(lds + wave * 16384);
            constexpr int I0 = 32 * 176, I1 = 32 * 225, I2 = 32 * 224, IO = 32 * 64, IK = 32 * 32;
            constexpr int NIT = 2 * I0 + I1 + I2 + 4 * IO + 4 * IK;
            for (int it = gw; it < NIT; it += NGW) {
                int r = it;
                if (r < I0) { tr_item(P.a_w_in, NZ0, (bf16_t*)(ws + WS_WIN0), r, lane, scr, 0, P.norm_g); continue; } r -= I0;
                if (r < I1) { tr_item(P.b_w_in, NSRC1, (bf16_t*)(ws + WS_WIN1), r, lane, scr, 1, P.norm_g + DM); continue; } r -= I1;
                if (r < I2) { tr_item(P.c_w_in, NZ2, (bf16_t*)(ws + WS_WIN2), r, lane, scr, 0, P.norm_g + 2 * DM); continue; } r -= I2;
                if (r < I0) { tr_item(P.a_w_in + (size_t)DM * NZ0, NZ0, (bf16_t*)(ws + WS_WIN3), r, lane, scr, 0, P.norm_g + 3 * DM); continue; } r -= I0;
                if (r < 4 * IO) { const int L = r / IO; tr_item(P.w_out + (size_t)L * DM * DM, DM, WOUT + (size_t)L * DM * DM, r - L * IO, lane, scr, 0, nullptr); continue; } r -= 4 * IO;
                { const int L = r / IK; tr_item(P.w_mem_kv + (size_t)L * DM * 1024, 1024, WKV + (size_t)L * 1024 * DM, r - L * IK, lane, scr, 0, nullptr); }
            }
            { u32x4* zp = (u32x4*)((bf16_t*)(ws + WS_WIN1) + (size_t)NSRC1 * DM); const int nz = (NZ1 - NSRC1) * DM / 8;
              for (int i = blockIdx.x * 512 + tid; i < nz; i += G * 512) zp[i] = (u32x4){0u, 0u, 0u, 0u}; }
            { bf16_t* wsb = (bf16_t*)(ws + WS_GT + 65536);
              for (int i = blockIdx.x * 512 + tid; i < 2 * 12 * 2048; i += G * 512) { const int hd = i >> 11, rem = i & 2047, t = rem >> 4, ch = rem & 15;
                  const float* src = P.a_w_s + (size_t)hd * 16384 + t * 128 + 8 * ch;
                  f32x4 a0 = *(const f32x4*)src, a1 = *(const f32x4*)(src + 4);
                  if (t < 64 && ch >= 8) { a0 = (f32x4){0.f, 0.f, 0.f, 0.f}; a1 = a0; }
                  u32x4 w; w.x = pk2(a0[0], a0[1]); w.y = pk2(a0[2], a0[3]); w.z = pk2(a1[0], a1[1]); w.w = pk2(a1[2], a1[3]);
                  *(u32x4*)(wsb + (size_t)hd * 16384 + t * 128 + 8 * ch) = w; } }
            for (int m = gw; m < NB * NMEM; m += NGW) rms_row_to_bf16(P.mem + (size_t)m * DM, P.mem_norm_g, MEMN + (size_t)m * DM, lane);
            for (int m = gw; m < NTOK; m += NGW) row_to_bf16_ssq(P.x + (size_t)m * DM, HB + (size_t)m * DM, SSQ + m, lane);
            for (int i = blockIdx.x * 512 + tid; i < 3 * NTOK; i += G * 512) SSQ[NTOK + i] = 0.f;
            if (blockIdx.x == 0) { float* gt = (float*)(ws + WS_GT);
                if (tid < 9) { ((unsigned*)(ws + WS_GT))[4096 + 64 * tid] = 0u; ((unsigned*)(ws + WS_GT))[8192 + 64 * tid] = 0u; }
                for (int i = tid; i < 2064; i += 512) { float v = 0.f;
                    if (i < 1536) { const int Lq = i / 384, w = (i % 384) / 128, d = i & 127, kd = Lq % 3;
                        if (w == 2) v = P.mem_q_norm_g[Lq * 128 + d];
                        else if (kd == 1) v = (w == 0 ? P.b_q_norm_g : P.b_k_norm_g)[d];
                        else if (kd == 2) v = (w == 0 ? P.c_q_norm_g : P.c_k_norm_g)[d & 63];
                    } else if (i < 2048) v = P.mem_k_norm_g[i - 1536];
                    else if (i < 2060) v = P.b_b_f[i - 2048];
                    gt[i] = v; }
                if (tid < 19) {
                    float v = 0.f;
                    if (tid < 16) { const int Lq = tid >> 2, w = tid & 3, kd = Lq % 3;
                        if (w == 2) { for (int i = 0; i < 128; ++i) v = fmaxf(v, fabsf(P.mem_q_norm_g[Lq * 128 + i])); }
                        else if (w == 3) { for (int i = 0; i < 128; ++i) v = fmaxf(v, fabsf(P.mem_k_norm_g[Lq * 128 + i])); }
                        else if (kd == 1) { const float* gsrc = (w == 0) ? P.b_q_norm_g : P.b_k_norm_g; for (int i = 0; i < 128; ++i) v = fmaxf(v, fabsf(gsrc[i])); }
                        else if (kd == 2) { const float* gsrc = (w == 0) ? P.c_q_norm_g : P.c_k_norm_g; for (int i = 0; i < 64; ++i) v = fmaxf(v, fabsf(gsrc[i])); }
                    } else if (tid == 16) { for (int i = 0; i < 384; ++i) v = fmaxf(v, P.rel_bias[i]); }
                    else if (tid == 17) { for (int i = 0; i < 64; ++i) v += P.c_lam[i] * P.c_lam[64 + i]; }
                    else { for (int i = 0; i < 64; ++i) v += P.c_lam[128 + i] * P.c_lam[192 + i]; }
                    gt[2080 + tid] = v; } }
        } else {
            const int L = (ph - 1) / 3, sub = (ph - 1) % 3, kind = L % 3;
            const int NZ = (kind == 0) ? NZ0 : (kind == 1 ? NZ1 : NZ2);
            const int memq_off = (kind == 0) ? 3072 : 4608;
            if (sub == 0) {
                for (int jb = (L == 0 ? 0 : 1); jb < 2; ++jb) {
                    pg8::Gemm g; EpiZ E;
                    LAS float* part = (LAS float*)(lds + LDS_PART);
                    if (jb == 0) { g = pg8::Gemm{MEMN, WKV, NB * NMEM, 4096, DM}; E = EpiZ{ws, part, 4096, 3, 0}; }
                    else { bf16_t* wt = (bf16_t*)(ws + (L == 0 ? WS_WIN0 : L == 1 ? WS_WIN1 : L == 2 ? WS_WIN2 : WS_WIN3));
                           g = pg8::Gemm{HB, wt, NTOK, NZ, DM}; E = EpiZ{ws, part, NZ, kind, L}; }
                    pg8::StaticOrder S; S.init(g.M, g.N, G, (int)blockIdx.x);
                    pg8::gemm_phase<EpiZ, pg8::StaticOrder, true, true>(lds, g, S, E, tid);
                }
            } else if (sub == 1) {
                const int gate_off = memq_off + 512;
                const float* gx = (const float*)(ws + WS_GT) + 2080;
                const float gqm = gx[4 * L], gkm = gx[4 * L + 1], gmq = gx[4 * L + 2], gmk = gx[4 * L + 3];
                const float m2_mem = 11.3137085f * gmq * gmk * 1.01f * LOG2E;
                if (kind == 0) {
                    const int j = L / 3;
#ifdef REP_GM
                    for (int rep_ = 0; rep_ < 2; ++rep_)
#endif
                    for (int it = blockIdx.x; it < NTOK / 128; it += G)
                        gmlp_item(lds, Z + (size_t)it * 128 * NZ0, BR + (size_t)it * 128 * DM, (const bf16_t*)(ws + WS_GT + 65536) + (size_t)j * 12 * 16384, P.a_b_s + j * 1536, P.a_ln_g + j * 1536, P.a_ln_b + j * 1536, tid);
                } else if (kind == 1) {
                    for (int it = blockIdx.x; it < 1536; it += G) {
                        const int c = it & 255, rr = it >> 8, bh = rr * 16 + (c & 7) * 2 + (c >> 7); int j = (c >> 3) & 15; if (rr & 1) j = 15 - j;
                        const int b = bh / 12, hh = bh - b * 12;
                        const bf16_t* Zb = Z + (size_t)b * SEQ * NZ1;
                        AttnArgs a; a.Q = Zb + hh * 128; a.K = Zb + 1536 + hh * 128; a.V = Zb + 3072 + hh * 128; a.G = Zb + gate_off + hh * 128; a.O = BR + (size_t)b * SEQ * DM + hh * 128;
                        a.ldq = NZ1; a.ldkv = NZ1; a.ldg = NZ1; a.ldo = DM; a.q0 = 256 * j; a.ntiles = 4 * j + 4; a.c = LS + (size_t)bh * SEQ; a.lutsrc = nullptr; a.subg = nullptr;
                        a.sc = 0.08838834764831845f * LOG2E; a.lam = 0.f; a.outmul = 1.f; a.m2 = 11.3137085f * gqm * gkm * 1.01f * LOG2E;
                        attn_item<1>(lds, a, tid);
                    }
                } else {
                    const float d01 = gx[17], d23 = gx[18];
                    const float lam_init = 0.8f - 0.6f * expf(-0.3f * (float)L);
                    const float lam_val = expf(d01) - expf(d23) + lam_init;
                    const float bmax = gx[16];
                    const float m2_diff = (8.f * gqm * gkm * 1.01f + bmax) * LOG2E;
                    for (int it = blockIdx.x; it < 3072; it += G) {
                        const int c = it & 255, rr = it >> 8, bh = rr * 8 + (c & 7); int j = c >> 3; if (rr & 1) j = 31 - j;
                        const int b = bh / 12, hh = bh - b * 12;
                        const bf16_t* Zb = Z + (size_t)b * SEQ * NZ2;
                        AttnArgs a; a.Q = Zb + hh * 128; a.K = Zb + 1536 + hh * 128; a.V = Zb + 3072 + hh * 128; a.G = Zb + gate_off + hh * 128; a.O = BR + (size_t)b * SEQ * DM + hh * 128;
                        a.ldq = NZ2; a.ldkv = NZ2; a.ldg = NZ2; a.ldo = DM; a.q0 = 128 * j; a.ntiles = 2 * j + 2; a.c = nullptr; a.lutsrc = P.rel_bias + hh; a.subg = P.c_subln_g;
                        a.sc = 0.125f * LOG2E; a.lam = lam_val; a.outmul = 1.f - lam_init; a.m2 = m2_diff;
                        attn_item<2>(lds, a, tid);
                    }
                }
#ifdef REP_MEM
                for (int rep_ = 0; rep_ < 2; ++rep_)
#endif
                for (int it = blockIdx.x; it < 512; it += G) {
                    const int qb = it & 15, hm = (it >> 4) & 3, b = it >> 6;
                    const bf16_t* Zb = Z + (size_t)b * SEQ * NZ;
                    AttnArgs a; a.Q = Zb + memq_off + hm * 128; a.K = KVM + (size_t)b * NMEM * 4096 + L * 1024 + hm * 128; a.V = a.K + 512; a.G = Zb + gate_off + 1536 + hm * 128;
                    a.O = BR + (size_t)b * SEQ * DM + 1536 + hm * 128;
                    a.ldq = NZ; a.ldkv = 4096; a.ldg = NZ; a.ldo = DM; a.q0 = 256 * qb; a.ntiles = 4; a.c = nullptr; a.lutsrc = nullptr; a.subg = nullptr;
                    a.sc = 0.08838834764831845f * LOG2E; a.lam = 0.f; a.outmul = 1.f; a.m2 = m2_mem;
                    attn_item<0>(lds, a, tid);
                }
                __syncthreads();
            } else {
                pg8::Gemm g{BR, WOUT + (size_t)L * DM * DM, NTOK, DM, DM};
                EpiOut E{L == 0 ? P.x : P.out, P.out, HB, (L + 1 < NLAYER) ? SSQ + (size_t)(L + 1) * NTOK : nullptr};
#ifdef REP_OUT0
                if (redo) E.ssq = nullptr;
#endif
                pg8::StaticOrder S; S.init(g.M, g.N, G, (int)blockIdx.x);
                pg8::gemm_phase<EpiOut, pg8::StaticOrder, true, true>(lds, g, S, E, tid);
            }
        }
#ifdef REP_P0
        if (ph == 0 && !redo) { redo = 1; __syncthreads(); --ph; continue; }
        redo = 0;
#endif
#ifdef REP_OUT0
        if (ph == 3 && !redo) { redo = 1; __syncthreads(); --ph; continue; }
        redo = 0;
#endif
#ifdef REP_SUB
        if (ph > 0 && (ph - 1) % 3 == REP_SUB && ((REP_L >> ((ph - 1) / 3)) & 1) && !redo) { redo = 1; __syncthreads(); --ph; continue; }
        redo = 0;
#endif
        if (ph + 1 < P.ph_hi) { if (ph == 0) grid.sync(); else grid_bar((unsigned*)(ws + WS_GT) + 4096, (unsigned)ph, tid); }
#ifdef REP_SYNC
        if (ph == 0) for (int i_ = 0; i_ < 10; ++i_) grid.sync();
#endif
#ifdef REP_BAR
        if (ph == 0) { for (int i_ = 0; i_ < 10; ++i_) grid_bar((unsigned*)(ws + WS_GT) + 8192, (unsigned)(i_ + 1), tid); }
#endif
    }
}

extern "C" void kernel_launch(void* const* d_in, const int* in_sizes, int n_in, void* d_out, int out_size, void* d_ws, size_t ws_size, hipStream_t stream) {
    static int grid = 0;
    if (grid == 0) {
        if (n_in != 23 || ws_size < WS_END) { fprintf(stderr, "kernel_launch: unexpected inputs (n_in %d, ws %zu)\n", n_in, ws_size); grid = -1; return; }
        int dev = 0, cus = 0, per_cu = 0;
        hipGetDevice(&dev); hipDeviceGetAttribute(&cus, hipDeviceAttributeMultiprocessorCount, dev);
        if (hipFuncSetAttribute((const void*)mk_fwd, hipFuncAttributeMaxDynamicSharedMemorySize, LDS_BYTES) != hipSuccess) fprintf(stderr, "kernel_launch: hipFuncSetAttribute failed\n");
        if (hipOccupancyMaxActiveBlocksPerMultiprocessor(&per_cu, (const void*)mk_fwd, 512, LDS_BYTES) != hipSuccess || per_cu < 1) { fprintf(stderr, "kernel_launch: occupancy query says %d\n", per_cu); per_cu = 1; }
        (void)hipGetLastError();
        grid = cus * per_cu;
        fprintf(stderr, "kernel_launch: grid %d (cus %d x %d)\n", grid, cus, per_cu);
    }
    if (grid < 0) return;
    Params p{};
    const float** pp = (const float**)&p;
    for (int i = 0; i < 23; ++i) pp[i] = (const float*)d_in[i];
    p.out = (float*)d_out; p.ws = (unsigned char*)d_ws;
#if MK_PER_PHASE
    for (int ph = 0; ph < NPHASE; ++ph) { p.ph_lo = ph; p.ph_hi = ph + 1; hipLaunchKernelGGL(mk_fwd, dim3(grid), dim3(512), LDS_BYTES, stream, p); }
#else
    p.ph_lo = 0; p.ph_hi = NPHASE;
    void* args[] = {&p};
    hipError_t e = hipLaunchCooperativeKernel((void*)mk_fwd, dim3(grid), dim3(512), args, LDS_BYTES, stream);
    if (e != hipSuccess) fprintf(stderr, "cooperative launch failed: %s (grid %d)\n", hipGetErrorString(e), grid);
#endif
}
```
